# Optimizing an MI355X kernel written in HIP

```python
import math
import jax
import jax.numpy as jnp
from jax import lax
import numpy as np

D_MODEL = 2048
BATCH = 2
SEQ = 8192
DEPTH = 2

GRID_W = 64
CTX_LEN = 256
EPS = 1e-6
F32 = jnp.float32

ATT_HEADS = 8
NOPE_DIM = 128
ROPE_DIM = 64
V_DIM = 128
QK_DIM = NOPE_DIM + ROPE_DIM
Q_LORA = 768
KV_LORA = 512
ROPE_BASE = 10000.0
Q_BLOCK = 128
ATT_SCALE = 1.0 / math.sqrt(QK_DIM)
ATT_WIDTH = ATT_HEADS * V_DIM

SGU_GROUPS = 4
SGU_CHUNK = 128
SGU_WIDTH = 512

SSD_HEADS = 8
SSD_HEAD_DIM = 64
SSD_INNER = SSD_HEADS * SSD_HEAD_DIM
SSD_STATE = 128
SSD_GROUPS = 2
SSD_CONV = 3
SSD_CHUNK = 128
XBC_WIDTH = SSD_INNER + 2 * SSD_GROUPS * SSD_STATE

MIX_WIDTH = ATT_WIDTH + SGU_WIDTH + SSD_INNER

FFN_DIM = 5632
FFN_CONV = 3

OFF_CKV = Q_LORA
OFF_KR = OFF_CKV + KV_LORA
OFF_SGU = OFF_KR + ROPE_DIM
OFF_Z = OFF_SGU + 2 * SGU_WIDTH
OFF_XBC = OFF_Z + SSD_INNER
OFF_DT = OFF_XBC + XBC_WIDTH
P_IN = OFF_DT + 2 * SSD_HEADS

kernel_name = 'hybrid_mla_sgu_ssd_prefix_dit_block'


def rms_norm(t, g):
    tf = t.astype(F32)
    y = tf * lax.rsqrt(jnp.mean(tf * tf, axis=-1, keepdims=True) + EPS)
    return (y * g.astype(F32)).astype(t.dtype)


def modulate(h, shift, scale):
    return h * (1.0 + scale) + shift


def dwconv_centred(t, w, b):
    k = w.shape[0]
    pad = k // 2
    n = t.shape[1]
    tp = jnp.pad(t, ((0, 0), (pad, pad), (0, 0)))
    out = b + w[0] * tp[:, 0:n]
    for i in range(1, k):
        out = out + w[i] * tp[:, i:i + n]
    return out


def axial_rope_tables(rows):
    row = jnp.repeat(jnp.arange(rows), GRID_W)
    col = jnp.tile(jnp.arange(GRID_W), rows)
    pairs = ROPE_DIM // 4
    freqs = ROPE_BASE ** (-jnp.arange(pairs, dtype=F32) / pairs)
    pos = jnp.stack([row, col], axis=-1).astype(F32)
    ang = pos[:, :, None] * freqs
    return jnp.cos(ang), jnp.sin(ang)


def apply_axial_rope(t, cos, sin):
    b, n, h, _ = t.shape
    t_nope = t[..., :NOPE_DIM]
    r = t[..., NOPE_DIM:].reshape(b, n, h, 2, ROPE_DIM // 2).astype(F32)
    half = ROPE_DIM // 4
    r1, r2 = r[..., :half], r[..., half:]
    cs, sn = cos[None, :, None], sin[None, :, None]
    rot = jnp.concatenate([r1 * cs - r2 * sn, r2 * cs + r1 * sn], axis=-1)
    return jnp.concatenate([t_nope, rot.reshape(b, n, h, ROPE_DIM).astype(t.dtype)], axis=-1)


def mla_qkv(p, q_a_norm, w_uq, kv_a_norm, w_ukv, q_norm, k_norm):
    b, n, _ = p.shape
    cq = rms_norm(p[..., :OFF_CKV], q_a_norm)
    ckv = rms_norm(p[..., OFF_CKV:OFF_KR], kv_a_norm)
    kr = p[..., OFF_KR:OFF_SGU]
    q = (cq @ w_uq).reshape(b, n, ATT_HEADS, QK_DIM)
    kv = (ckv @ w_ukv).reshape(b, n, ATT_HEADS, NOPE_DIM + V_DIM)
    k = jnp.concatenate([kv[..., :NOPE_DIM], jnp.broadcast_to(kr[:, :, None, :], (b, n, ATT_HEADS, ROPE_DIM))], axis=-1)
    v = kv[..., NOPE_DIM:]
    return rms_norm(q, q_norm), rms_norm(k, k_norm), v


def block_attention(q, k, v):
    b, s, h, dq = q.shape
    nb = s // Q_BLOCK
    qb = jnp.swapaxes(q.reshape(b, nb, Q_BLOCK, h, dq), 0, 1)

    def one_block(q_blk):
        sc = jnp.einsum('bqhd,bkhd->bhqk', q_blk, k).astype(F32) * ATT_SCALE
        pr = jax.nn.softmax(sc, axis=-1).astype(v.dtype)
        return jnp.einsum('bhqk,bkhd->bqhd', pr, v)

    o = lax.map(one_block, qb)
    return jnp.swapaxes(o, 0, 1).reshape(b, s, h * v.shape[-1])


def spatial_gating(z, norm_g, w_s, b_s):
    b, n, _ = z.shape
    u, v = z[..., :SGU_WIDTH], z[..., SGU_WIDTH:]
    v = rms_norm(v, norm_g).reshape(b, n // SGU_CHUNK, SGU_CHUNK, SGU_GROUPS, SGU_WIDTH // SGU_GROUPS)
    mixed = jnp.einsum('gij,bcjgd->bcigd', w_s, v) + jnp.swapaxes(b_s, 0, 1)[:, :, None]
    return u * mixed.reshape(b, n, SGU_WIDTH)


def ssd_inputs(p, conv_w, conv_b, dt_bias):
    b, n, _ = p.shape
    z = p[..., OFF_Z:OFF_XBC]
    xbc = jax.nn.silu(dwconv_centred(p[..., OFF_XBC:OFF_DT], conv_w, conv_b))
    xs = xbc[..., :SSD_INNER].reshape(b, n, SSD_HEADS, SSD_HEAD_DIM)
    gn = SSD_GROUPS * SSD_STATE
    rep = SSD_HEADS // SSD_GROUPS
    bm = jnp.repeat(xbc[..., SSD_INNER:SSD_INNER + gn].reshape(b, n, SSD_GROUPS, SSD_STATE), rep, axis=2)
    cm = jnp.repeat(xbc[..., SSD_INNER + gn:].reshape(b, n, SSD_GROUPS, SSD_STATE), rep, axis=2)
    dt = jax.nn.softplus(p[..., OFF_DT:P_IN].reshape(b, n, 2, SSD_HEADS).astype(F32) + dt_bias.astype(F32))
    return z, xs, bm, cm, dt


def ssd_chunked(xs, dt, a_neg, bm, cm):
    b, l, h, p = xs.shape
    n = bm.shape[-1]
    q = SSD_CHUNK
    nc = l // q
    acs = jnp.cumsum((dt * a_neg).reshape(b, nc, q, h), axis=2)
    xdt = (xs * dt[..., None]).reshape(b, nc, q, h, p)
    bm = bm.reshape(b, nc, q, h, n)
    cm = cm.reshape(b, nc, q, h, n)
    lower = jnp.tril(jnp.ones((q, q), dtype=bool))
    seg = acs[:, :, :, None, :] - acs[:, :, None, :, :]
    decay = jnp.exp(jnp.where(lower[None, None, :, :, None], seg, -jnp.inf))
    cb = jnp.einsum('bcihn,bcjhn->bcijh', cm, bm)
    y_diag = jnp.einsum('bcijh,bcjhp->bcihp', cb * decay, xdt)
    to_end = jnp.exp(acs[:, :, -1:, :] - acs)
    states = jnp.einsum('bcqhn,bcqh,bcqhp->bchpn', bm, to_end, xdt)
    chunk_decay = jnp.exp(acs[:, :, -1, :])

    def carry(state, inp):
        st, dec = inp
        return state * dec[:, :, None, None] + st, state

    init = jnp.zeros((b, h, p, n), states.dtype)
    _, entering = lax.scan(carry, init, (jnp.moveaxis(states, 1, 0), jnp.moveaxis(chunk_decay, 1, 0)))
    entering = jnp.moveaxis(entering, 0, 1)
    y_off = jnp.einsum('bcqhn,bchpn->bcqhp', cm, entering) * jnp.exp(acs)[..., None]
    return (y_diag + y_off).reshape(b, l, h, p).astype(xs.dtype)


def merge_groups(att, sgu, ssd, attn_out_norm, gmlp_out_norm, w_out):
    cat = jnp.concatenate([rms_norm(att, attn_out_norm), rms_norm(sgu, gmlp_out_norm), ssd], axis=-1)
    return cat @ w_out


def token_mixers(h_lat, h_ctx, need_ctx, cos, sin, w_in, q_a_norm, w_uq, kv_a_norm, w_ukv, q_norm, k_norm,
                 attn_out_norm, sgu_norm, sgu_w, sgu_b, gmlp_out_norm, ssd_conv_w, ssd_conv_b, ssd_dt_bias,
                 ssd_a_log, ssd_d, ssd_norm, w_out):
    b, s, _ = h_lat.shape
    n_ctx = h_ctx.shape[1]
    p_lat = h_lat @ w_in
    p_ctx = h_ctx @ w_in

    q_l, k_l, v_l = mla_qkv(p_lat, q_a_norm, w_uq, kv_a_norm, w_ukv, q_norm, k_norm)
    q_c, k_c, v_c = mla_qkv(p_ctx, q_a_norm, w_uq, kv_a_norm, w_ukv, q_norm, k_norm)
    q_l = apply_axial_rope(q_l, cos, sin)
    k_l = apply_axial_rope(k_l, cos, sin)
    att_l = block_attention(q_l, jnp.concatenate([k_c, k_l], axis=1), jnp.concatenate([v_c, v_l], axis=1))

    sgu_l = spatial_gating(jax.nn.gelu(p_lat[..., OFF_SGU:OFF_Z]), sgu_norm, sgu_w, sgu_b)

    z_l, xs_l, bm_l, cm_l, dt_l = ssd_inputs(p_lat, ssd_conv_w, ssd_conv_b, ssd_dt_bias)
    z_c, xs_c, bm_c, cm_c, dt_c = ssd_inputs(p_ctx, ssd_conv_w, ssd_conv_b, ssd_dt_bias)
    a_neg = -jnp.exp(ssd_a_log.astype(F32))
    cat = lambda u, w: jnp.concatenate([u, w], axis=1)
    flip = lambda t: jnp.flip(t, axis=1)
    y_f = ssd_chunked(cat(xs_c, xs_l), cat(dt_c[:, :, 0], dt_l[:, :, 0]), a_neg[0],
                      cat(bm_c, bm_l), cat(cm_c, cm_l))
    y_b = ssd_chunked(cat(flip(xs_c), flip(xs_l)), cat(flip(dt_c[:, :, 1]), flip(dt_l[:, :, 1])), a_neg[1],
                      cat(flip(bm_c), flip(bm_l)), cat(flip(cm_c), flip(cm_l)))
    y_l = y_f[:, n_ctx:] + flip(y_b[:, n_ctx:]) + ssd_d[:, None] * xs_l
    ssd_l = rms_norm(y_l.reshape(b, s, SSD_INNER) * jax.nn.silu(z_l), ssd_norm)

    mix_l = merge_groups(att_l, sgu_l, ssd_l, attn_out_norm, gmlp_out_norm, w_out)
    if not need_ctx:
        return mix_l, None

    att_c = block_attention(q_c, k_c, v_c)
    sgu_c = spatial_gating(jax.nn.gelu(p_ctx[..., OFF_SGU:OFF_Z]), sgu_norm, sgu_w, sgu_b)
    y_c = y_f[:, :n_ctx] + flip(y_b[:, :n_ctx]) + ssd_d[:, None] * xs_c
    ssd_c = rms_norm(y_c.reshape(b, n_ctx, SSD_INNER) * jax.nn.silu(z_c), ssd_norm)
    mix_c = merge_groups(att_c, sgu_c, ssd_c, attn_out_norm, gmlp_out_norm, w_out)
    return mix_l, mix_c


def conv_ffn(h, w_gate, w_up, conv_w, conv_b, w_down):
    g = dwconv_centred(h @ w_gate, conv_w, conv_b)
    return (jax.nn.silu(g) * (h @ w_up)) @ w_down


def setup_inputs(seed: int = 0) -> dict:
    key = jax.random.key(seed)
    ks = jax.random.split(key, 40)

    def nrm(i, shape, scale):
        return jax.random.normal(ks[i], shape, F32) * scale

    def gain(i, shape):
        return 1.0 + 0.05 * jax.random.normal(ks[i], shape, F32)

    L, D = DEPTH, D_MODEL
    x = nrm(0, (BATCH, SEQ, D), 1.0)
    c = nrm(1, (BATCH, D), 1.0)
    ctx = nrm(2, (BATCH, CTX_LEN, D), 1.0)
    c_ctx = nrm(3, (D,), 1.0)
    w_mod = nrm(4, (L, D, 6 * D), 0.5 * D ** -0.5)
    b_mod = nrm(5, (L, 6 * D), 0.02)
    norm_mix = gain(6, (L, D))
    norm_ffn = gain(7, (L, D))
    w_in = nrm(8, (L, D, P_IN), D ** -0.5)
    q_a_norm = gain(9, (L, Q_LORA))
    w_uq = nrm(10, (L, Q_LORA, ATT_HEADS * QK_DIM), Q_LORA ** -0.5)
    kv_a_norm = gain(11, (L, KV_LORA))
    w_ukv = nrm(12, (L, KV_LORA, ATT_HEADS * (NOPE_DIM + V_DIM)), KV_LORA ** -0.5)
    q_norm = gain(13, (L, QK_DIM))
    k_norm = gain(14, (L, QK_DIM))
    attn_out_norm = gain(15, (L, ATT_WIDTH))
    sgu_norm = gain(16, (L, SGU_WIDTH))
    sgu_w = nrm(17, (L, SGU_GROUPS, SGU_CHUNK, SGU_CHUNK), SGU_CHUNK ** -0.5)
    sgu_b = nrm(18, (L, SGU_GROUPS, SGU_CHUNK), 0.02)
    gmlp_out_norm = gain(19, (L, SGU_WIDTH))
    ssd_conv_w = nrm(20, (L, SSD_CONV, XBC_WIDTH), SSD_CONV ** -0.5)
    ssd_conv_b = nrm(21, (L, XBC_WIDTH), 0.02)
    dt0 = jnp.exp(jax.random.uniform(ks[22], (L, 2, SSD_HEADS), F32, math.log(1e-3), math.log(1e-1)))
    ssd_dt_bias = dt0 + jnp.log(-jnp.expm1(-dt0))
    ssd_a_log = jnp.log(jax.random.uniform(ks[23], (L, 2, SSD_HEADS), F32, 1.0, 16.0))
    ssd_d = gain(24, (L, SSD_HEADS))
    ssd_norm = gain(25, (L, SSD_INNER))
    w_out = nrm(26, (L, MIX_WIDTH, D), MIX_WIDTH ** -0.5)
    ffn_w_gate = nrm(27, (L, D, FFN_DIM), D ** -0.5)
    ffn_w_up = nrm(28, (L, D, FFN_DIM), D ** -0.5)
    ffn_conv_w = nrm(29, (L, FFN_CONV, FFN_DIM), FFN_CONV ** -0.5)
    ffn_conv_b = nrm(30, (L, FFN_DIM), 0.02)
    ffn_w_down = nrm(31, (L, FFN_DIM, D), FFN_DIM ** -0.5)
    return {'x': x, 'c': c, 'ctx': ctx, 'c_ctx': c_ctx, 'w_mod': w_mod, 'b_mod': b_mod,
            'norm_mix': norm_mix, 'norm_ffn': norm_ffn, 'w_in': w_in, 'q_a_norm': q_a_norm, 'w_uq': w_uq,
            'kv_a_norm': kv_a_norm, 'w_ukv': w_ukv, 'q_norm': q_norm, 'k_norm': k_norm,
            'attn_out_norm': attn_out_norm, 'sgu_norm': sgu_norm, 'sgu_w': sgu_w, 'sgu_b': sgu_b,
            'gmlp_out_norm': gmlp_out_norm, 'ssd_conv_w': ssd_conv_w, 'ssd_conv_b': ssd_conv_b,
            'ssd_dt_bias': ssd_dt_bias, 'ssd_a_log': ssd_a_log, 'ssd_d': ssd_d, 'ssd_norm': ssd_norm,
            'w_out': w_out, 'ffn_w_gate': ffn_w_gate, 'ffn_w_up': ffn_w_up, 'ffn_conv_w': ffn_conv_w,
            'ffn_conv_b': ffn_conv_b, 'ffn_w_down': ffn_w_down}


def reference(x, c, ctx, c_ctx, w_mod, b_mod, norm_mix, norm_ffn, w_in, q_a_norm, w_uq, kv_a_norm, w_ukv,
              q_norm, k_norm, attn_out_norm, sgu_norm, sgu_w, sgu_b, gmlp_out_norm, ssd_conv_w, ssd_conv_b,
              ssd_dt_bias, ssd_a_log, ssd_d, ssd_norm, w_out, ffn_w_gate, ffn_w_up, ffn_conv_w, ffn_conv_b,
              ffn_w_down):
    rows = x.shape[1] // GRID_W
    cos, sin = axial_rope_tables(rows)
    x_lat, x_ctx = x, ctx
    for i in range(DEPTH):
        need_ctx = i < DEPTH - 1
        mods_l = jnp.split(jax.nn.silu(c) @ w_mod[i] + b_mod[i], 6, axis=-1)
        sh1, sc1, g1, sh2, sc2, g2 = [m[:, None, :] for m in mods_l]
        csh1, csc1, cg1, csh2, csc2, cg2 = jnp.split(jax.nn.silu(c_ctx) @ w_mod[i] + b_mod[i], 6, axis=-1)

        h_lat = modulate(rms_norm(x_lat, norm_mix[i]), sh1, sc1)
        h_ctx = modulate(rms_norm(x_ctx, norm_mix[i]), csh1, csc1)
        mix_lat, mix_ctx = token_mixers(
            h_lat, h_ctx, need_ctx, cos, sin, w_in[i], q_a_norm[i], w_uq[i], kv_a_norm[i], w_ukv[i],
            q_norm[i], k_norm[i], attn_out_norm[i], sgu_norm[i], sgu_w[i], sgu_b[i], gmlp_out_norm[i],
            ssd_conv_w[i], ssd_conv_b[i], ssd_dt_bias[i], ssd_a_log[i], ssd_d[i], ssd_norm[i], w_out[i])
        x_lat = x_lat + g1 * mix_lat
        x_lat = x_lat + g2 * conv_ffn(modulate(rms_norm(x_lat, norm_ffn[i]), sh2, sc2),
                                      ffn_w_gate[i], ffn_w_up[i], ffn_conv_w[i], ffn_conv_b[i], ffn_w_down[i])
        if need_ctx:
            x_ctx = x_ctx + cg1 * mix_ctx
            x_ctx = x_ctx + cg2 * conv_ffn(modulate(rms_norm(x_ctx, norm_ffn[i]), csh2, csc2),
                                           ffn_w_gate[i], ffn_w_up[i], ffn_conv_w[i], ffn_conv_b[i], ffn_w_down[i])
    return x_lat
```

```cpp
#include <hip/hip_runtime.h>
#include <hip/hip_cooperative_groups.h>
#include <cstdio>
#include <cstdint>
namespace cg = cooperative_groups;

#ifndef REPEAT_MASK
#define REPEAT_MASK 0
#endif
#ifndef MULTI_LAUNCH
#define MULTI_LAUNCH 0
#endif

typedef unsigned short bf16_t;
using bf16x8 = __attribute__((ext_vector_type(8))) short;
using s16x4  = __attribute__((ext_vector_type(4))) short;
using f32x16 = __attribute__((ext_vector_type(16))) float;
using u32x4  = __attribute__((ext_vector_type(4))) unsigned;
using u32x2  = __attribute__((ext_vector_type(2))) unsigned;

constexpr int NTHR = 512;
constexpr int DM = 2048, SEQ = 8192, CTXL = 256, NB = 2;
constexpr int T_LAT = NB * SEQ;
constexpr int T_ALL = T_LAT + NB * CTXL;
constexpr int PIN = 3920, PLD = 3968, PNP = 4096;
constexpr int OFF_CKV = 768, OFF_KR = 1280, OFF_SGU = 1344, OFF_Z = 2368, OFF_XBC = 2880, OFF_DT = 3904;
constexpr int FFN = 5632;
constexpr int HLD = 2112, WLD = 2112, UKVLD = 768;
constexpr int NKEYS = CTXL + SEQ;
constexpr float EPS = 1e-6f;
constexpr float QSCALE = 0.07216878364870322f * 1.4426950408889634f;

constexpr size_t al256(size_t x) { return (x + 255) / 256 * 256; }
constexpr size_t WS_WIN  = 0;
constexpr size_t WS_WUQ  = WS_WIN  + (size_t)PNP * WLD * 2;
constexpr size_t WS_WUKV = WS_WUQ  + (size_t)1536 * 768 * 2;
constexpr size_t WS_WOUT = WS_WUKV + (size_t)2048 * UKVLD * 2;
constexpr size_t WS_WGU  = WS_WOUT + (size_t)2048 * WLD * 2;
constexpr size_t WS_WDN  = WS_WGU  + (size_t)2 * FFN * WLD * 2;
constexpr size_t WS_X    = WS_WDN  + (size_t)DM * FFN * 2;
constexpr size_t WS_MODS = WS_X    + (size_t)T_ALL * DM * 4;
constexpr size_t WS_ROPE = WS_MODS + (size_t)2 * 3 * 12288 * 4;
constexpr size_t WS_CTR  = WS_ROPE + (size_t)128 * 16 * 2 * 4;
constexpr size_t WS_BAR  = al256(WS_CTR + 256);
constexpr size_t WS_A1   = al256(WS_BAR + 3456 * 4);
constexpr size_t WS_P    = WS_A1;
constexpr size_t WS_DT   = WS_P    + (size_t)T_ALL * PLD * 2;
constexpr size_t WS_RSTD = WS_DT   + (size_t)T_ALL * 16 * 4;
constexpr size_t WS_A2   = al256(WS_RSTD + (size_t)T_ALL * 2 * 4);
constexpr size_t WS_QRAW = WS_A2;
constexpr size_t WS_KVRAW= WS_QRAW + (size_t)T_ALL * 1536 * 2;
constexpr size_t WS_A2END= WS_KVRAW+ (size_t)T_ALL * 2048 * 2;
constexpr size_t WS_ATT  = WS_A2;
constexpr size_t WS_SGUO = WS_ATT  + (size_t)T_ALL * 1024 * 2;
constexpr size_t WS_YF   = WS_SGUO + (size_t)T_ALL * 512 * 2;
constexpr size_t WS_YB   = WS_YF   + (size_t)T_ALL * 512 * 2;
static_assert(WS_YB + (size_t)T_ALL * 512 * 2 <= WS_A2END, "A2 alias overflow");
constexpr size_t WS_XBC  = al256(WS_A2END);
constexpr size_t WS_A4   = al256(WS_XBC + (size_t)T_ALL * 1024 * 2);
constexpr size_t WS_Q    = WS_A4;
constexpr size_t WS_QC   = WS_Q    + (size_t)16 * SEQ * 192 * 2;
constexpr size_t WS_K    = WS_QC   + (size_t)16 * CTXL * 192 * 2;
constexpr size_t WS_V    = WS_K    + (size_t)16 * NKEYS * 192 * 2;
constexpr size_t WS_END0 = al256(WS_V + (size_t)16 * NKEYS * 128 * 2);
constexpr size_t WS_ATT1 = WS_END0;
constexpr size_t WS_ML   = WS_ATT1 + (size_t)T_ALL * 1024 * 2;
constexpr size_t WS_PART = al256(WS_ML + (size_t)2 * T_ALL * 8 * 2 * 4);
constexpr size_t WS_END  = al256(WS_PART + (size_t)4 * 512 * DM * 4);
constexpr size_t WS_H    = WS_A4;
constexpr size_t WS_ACT  = WS_A1;
static_assert(WS_ACT + (size_t)T_ALL * FFN * 2 <= WS_XBC + (size_t)T_ALL * 1024 * 2, "ACT alias overflow");
static_assert((size_t)T_ALL * HLD * 2 <= WS_END - WS_A4, "H alias overflow");

constexpr int LDS_BYTES = 140800;
constexpr int LDS_DYN = LDS_BYTES + 16;

struct Params {
  const float *x, *c, *ctx, *c_ctx, *w_mod, *b_mod, *norm_mix, *norm_ffn, *w_in, *q_a_norm, *w_uq, *kv_a_norm, *w_ukv,
              *q_norm, *k_norm, *attn_out_norm, *sgu_norm, *sgu_w, *sgu_b, *gmlp_out_norm, *ssd_conv_w, *ssd_conv_b,
              *ssd_dt_bias, *ssd_a_log, *ssd_d, *ssd_norm, *w_out, *ffn_w_gate, *ffn_w_up, *ffn_conv_w, *ffn_conv_b, *ffn_w_down;
  float* out; char* ws;
  long long ph_lo, ph_hi;
};

__device__ __forceinline__ int otid() { int t = threadIdx.x; asm volatile("" : "+v"(t)); return t; }
typedef float f32x2_t __attribute__((ext_vector_type(2)));
typedef __bf16 bf16x2_t __attribute__((ext_vector_type(2)));
__device__ __forceinline__ unsigned cvtpk(float lo, float hi) {
  f32x2_t v = {lo, hi}; bf16x2_t r = __builtin_convertvector(v, bf16x2_t);
  return __builtin_bit_cast(unsigned, r);
}
__device__ __forceinline__ bf16_t f2bf(float x) { return __builtin_bit_cast(bf16_t, (__bf16)x); }
__device__ __forceinline__ float bf2f(bf16_t b) { return __uint_as_float(((unsigned)b) << 16); }
__device__ __forceinline__ float bflo(unsigned w) { return __uint_as_float(w << 16); }
__device__ __forceinline__ float bfhi(unsigned w) { return __uint_as_float(w & 0xffff0000u); }
__device__ __forceinline__ void unpack8(u32x4 w, float* f) {
  f[0] = bflo(w[0]); f[1] = bfhi(w[0]); f[2] = bflo(w[1]); f[3] = bfhi(w[1]);
  f[4] = bflo(w[2]); f[5] = bfhi(w[2]); f[6] = bflo(w[3]); f[7] = bfhi(w[3]);
}
__device__ __forceinline__ u32x4 pack8(const float* f) {
  u32x4 w = {cvtpk(f[0], f[1]), cvtpk(f[2], f[3]), cvtpk(f[4], f[5]), cvtpk(f[6], f[7])}; return w;
}
__device__ __forceinline__ float wave_sum(float v) {
#pragma unroll
  for (int o = 32; o > 0; o >>= 1) v += __shfl_xor(v, o);
  return v;
}
__device__ __forceinline__ float silu_f(float x) { return x * __builtin_amdgcn_rcpf(1.f + __builtin_amdgcn_exp2f(-1.4426950408889634f * x)); }
__device__ __forceinline__ float gelu_f(float x) {
  float u = 0.7978845608028654f * (x + 0.044715f * x * x * x);
  float t = 1.f - 2.f * __builtin_amdgcn_rcpf(__builtin_amdgcn_exp2f(2.8853900817779268f * u) + 1.f);
  return 0.5f * x * (1.f + t);
}
__device__ __forceinline__ int crow(int r, int hi) { return (r & 3) + 8 * (r >> 2) + 4 * hi; }
__device__ __forceinline__ f32x16 mfma32(bf16x8 a, bf16x8 b, f32x16 c) { return __builtin_amdgcn_mfma_f32_32x32x16_bf16(a, b, c, 0, 0, 0); }
__device__ __forceinline__ bool seq_start(int t) { return t < T_LAT ? ((t & (SEQ - 1)) == 0) : (((t - T_LAT) & (CTXL - 1)) == 0); }
__device__ __forceinline__ bool seq_end(int t) { return t < T_LAT ? ((t & (SEQ - 1)) == SEQ - 1) : (((t - T_LAT) & (CTXL - 1)) == CTXL - 1); }
__device__ __forceinline__ int mod_idx(int row) { return row < SEQ ? 0 : (row < T_LAT ? 1 : 2); }

#define XB_TMO      128
#define XB_XCNT(j)  (256  + 64 * (j))
#define XB_XSUB(j)  (1280 + 64 * (j))
#define XB_XGEN(j)  (2304 + 64 * (j))
#define XB_TOP      3328
#define XB_TOPGEN   3392
#define XCD_BAR_WORDS 3456
#define XB_SPIN_CAP (1u << 24)
#define LAS __attribute__((address_space(3)))

__device__ __forceinline__ unsigned xb_ld(unsigned* p)              { return __hip_atomic_load(p, __ATOMIC_RELAXED, __HIP_MEMORY_SCOPE_AGENT); }
__device__ __forceinline__ unsigned xb_add(unsigned* p, unsigned v) { return __hip_atomic_fetch_add(p, v, __ATOMIC_RELAXED, __HIP_MEMORY_SCOPE_AGENT); }
__device__ __forceinline__ unsigned xb_xcc_id() { return (unsigned)__builtin_amdgcn_s_getreg((3 << 11) | 20) & 0xFu; }
#define XB_SPIN(cond, bar) do { unsigned _sp = 0; while (cond) { __builtin_amdgcn_s_sleep(1); \
    if ((++_sp & 255u) == 0u) { if (xb_ld(&(bar)[XB_TMO])) break; if (_sp > XB_SPIN_CAP) { atomicAdd(&(bar)[XB_TMO], 1u); break; } } } } while (0)

struct XcdBarrier {
    unsigned* bar; unsigned x;
    volatile LAS unsigned* st;
};

__device__ __forceinline__ XcdBarrier xcd_barrier_post(unsigned* bar, volatile LAS unsigned* st) {
    XcdBarrier b; b.bar = bar; b.x = xb_xcc_id(); b.st = st;
    if (threadIdx.x == 0) (void)xb_add(&bar[XB_XCNT(b.x)], 1u);
    return b;
}
__device__ __forceinline__ void xcd_barrier_complete(unsigned* bar, unsigned x, unsigned& nloc, unsigned& nx) {
    const unsigned G = gridDim.x * gridDim.y * gridDim.z;
    unsigned sum, cnt, mine, sp = 0u;
    for (;;) {
        sum = 0u; cnt = 0u; mine = 0u;
#pragma unroll
        for (unsigned j = 0; j < 16; ++j) { const unsigned c = xb_ld(&bar[XB_XCNT(j)]); sum += c; cnt += (c > 0u) ? 1u : 0u; mine = (j == x) ? c : mine; }
        if (sum == G) break;
        __builtin_amdgcn_s_sleep(1);
        if ((++sp & 255u) == 0u) { if (xb_ld(&bar[XB_TMO])) break; if (sp > XB_SPIN_CAP) { atomicAdd(&bar[XB_TMO], 1u); break; } }
    }
    nloc = mine > 0u ? mine : 1u; nx = cnt > 0u ? cnt : 1u;
}

__device__ __forceinline__ void xcd_barrier(const XcdBarrier& b) {
    asm volatile("s_waitcnt vmcnt(0)" ::: "memory");
    __syncthreads();
    if (threadIdx.x == 0) {
        unsigned* bar = b.bar;
        __builtin_amdgcn_s_waitcnt(0);
        unsigned nloc = b.st[0], nx = b.st[1];
        if (nloc == 0u) { xcd_barrier_complete(bar, b.x, nloc, nx); b.st[0] = nloc; b.st[1] = nx; }
        const unsigned old = xb_add(&bar[XB_XSUB(b.x)], 1u);
        const unsigned gen = old / nloc;
        if (old + 1u == (gen + 1u) * nloc) {
            __builtin_amdgcn_fence(__ATOMIC_RELEASE, "agent");
            asm volatile("s_waitcnt vmcnt(0)" ::: "memory");
            const unsigned og = xb_add(&bar[XB_TOP], 1u);
            const unsigned tg = og / nx;
            if (og + 1u == (tg + 1u) * nx) xb_add(&bar[XB_TOPGEN], 1u);
            else XB_SPIN(xb_ld(&bar[XB_TOPGEN]) == tg, bar);
            __builtin_amdgcn_fence(__ATOMIC_ACQUIRE, "agent");
            xb_add(&bar[XB_XGEN(b.x)], 1u);
            asm volatile("s_waitcnt vmcnt(0)" ::: "memory");
        } else {
            XB_SPIN(xb_ld(&bar[XB_XGEN(b.x)]) == gen, bar);
            __builtin_amdgcn_fence(__ATOMIC_ACQUIRE, "agent");
            asm volatile("s_waitcnt vmcnt(0)" ::: "memory");
        }
    }
    __syncthreads();
}


__device__ __forceinline__ void convert_tile(const float* __restrict__ src, int K, int N, bf16_t* __restrict__ dst, int ldd, int mode, const float* __restrict__ kscale,
                             int tk, int tn, char* lds) {
  const int tid = otid();
  bf16_t* s = (bf16_t*)lds;
  __syncthreads();
  float v[16];
#pragma unroll
  for (int e = 0; e < 16; ++e) {
    const int id = tid + e * NTHR; const int n = id & 127, k = id >> 7;
    const int gk = tk * 64 + k, gn = tn * 128 + n;
    v[e] = gn < N ? src[(size_t)gk * N + gn] : 0.f;
    if (kscale) v[e] *= kscale[gk];
  }
#pragma unroll
  for (int e = 0; e < 16; ++e) { const int id = tid + e * NTHR; const int n = id & 127, k = id >> 7; s[n * 68 + k] = f2bf(v[e]); }
  __syncthreads();
#pragma unroll
  for (int e = 0; e < 2; ++e) {
    int id = tid + e * NTHR; int n = id >> 3, c = id & 7;
    int gn = tn * 128 + n; int drow;
    if (mode == 0) drow = gn;
    else { drow = (gn >> 7) * 256 + (mode == 2 ? 128 : 0) + (gn & 127); }
    const u32x2 a = *reinterpret_cast<const u32x2*>(s + n * 68 + c * 8), b = *reinterpret_cast<const u32x2*>(s + n * 68 + c * 8 + 4);
    u32x4 w = {a[0], a[1], b[0], b[1]};
    *reinterpret_cast<u32x4*>(dst + (size_t)drow * ldd + tk * 64 + c * 8) = w;
  }
}

__device__ __forceinline__ void convert_weights(const Params& p, int layer, char* lds) {
  char* ws = p.ws;
  const int n_in = 32 * 32, n_uq = 12 * 12, n_ukv = 8 * 16, n_out = 32 * 16, n_g = 32 * 44, n_dn = 88 * 16;
  const int total = n_in + n_uq + n_ukv + n_out + 2 * n_g + n_dn;
  for (int it = blockIdx.x; it < total; it += gridDim.x) {
    int i = it;
    if (i < n_in) { convert_tile(p.w_in + (size_t)layer * DM * PIN, DM, PIN, (bf16_t*)(ws + WS_WIN), WLD, 0, nullptr, i & 31, i >> 5, lds); continue; } i -= n_in;
    if (i < n_uq) { convert_tile(p.w_uq + (size_t)layer * 768 * 1536, 768, 1536, (bf16_t*)(ws + WS_WUQ), 768, 0, p.q_a_norm + layer * 768, i % 12, i / 12, lds); continue; } i -= n_uq;
    if (i < n_ukv) { convert_tile(p.w_ukv + (size_t)layer * 512 * 2048, 512, 2048, (bf16_t*)(ws + WS_WUKV), UKVLD, 0, p.kv_a_norm + layer * 512, i & 7, i >> 3, lds); continue; } i -= n_ukv;
    if (i < n_out) { convert_tile(p.w_out + (size_t)layer * DM * DM, DM, DM, (bf16_t*)(ws + WS_WOUT), WLD, 0, nullptr, i & 31, i >> 5, lds); continue; } i -= n_out;
    if (i < n_g) { convert_tile(p.ffn_w_gate + (size_t)layer * DM * FFN, DM, FFN, (bf16_t*)(ws + WS_WGU), WLD, 1, nullptr, i & 31, i >> 5, lds); continue; } i -= n_g;
    if (i < n_g) { convert_tile(p.ffn_w_up + (size_t)layer * DM * FFN, DM, FFN, (bf16_t*)(ws + WS_WGU), WLD, 2, nullptr, i & 31, i >> 5, lds); continue; } i -= n_g;
    convert_tile(p.ffn_w_down + (size_t)layer * FFN * DM, FFN, DM, (bf16_t*)(ws + WS_WDN), FFN, 0, nullptr, i % 88, i / 88, lds);
  }
}

__device__ __forceinline__ void sincos_small(float x, float& s, float& c) {
  float kf = rintf(x * 0.6366197723675814f); int k = (int)kf;
  float r = fmaf(-kf, 1.5707963705062866f, x); r = fmaf(-kf, -4.371139000186241e-8f, r);
  float r2 = r * r;
  float sp = r + r * r2 * (-1.6666654611e-1f + r2 * (8.3321608736e-3f + r2 * (-1.9515295891e-4f)));
  float cp = 1.f + r2 * (-0.5f + r2 * (4.166664568298827e-2f + r2 * (-1.388731625493765e-3f + r2 * 2.443315711809948e-5f)));
  int q = k & 3;
  float ss = (q & 1) ? cp : sp, cc = (q & 1) ? sp : cp;
  s = (q & 2) ? -ss : ss; c = ((q + 1) & 2) ? -cc : cc;
}

__device__ __forceinline__ void phase_prep(const Params& p, char* lds) {
  const int tid = otid(), lane = tid & 63, wid = tid >> 6;
  char* ws = p.ws;
  if (blockIdx.x == 0) {
    int* ctr = (int*)(ws + WS_CTR);
    if (tid < 64) ctr[tid] = 0;
    float* rope = (float*)(ws + WS_ROPE);
    for (int i = tid; i < 128 * 16; i += NTHR) {
      int pos = i >> 4, j = i & 15;
      float freq = exp2f(-(float)j * (13.287712379549449f / 16.f));
      float ang = (float)pos * freq; float s, c; sincos_small(ang, s, c);
      rope[i * 2] = c; rope[i * 2 + 1] = s;
    }
  }
  float* sc = (float*)lds;
  float* red = sc + 3 * 2048;
  __syncthreads();
  for (int i = tid; i < 3 * 2048; i += NTHR) {
    int j = i >> 11, k = i & 2047;
    float v = (j < 2) ? p.c[j * DM + k] : p.c_ctx[k];
    sc[i] = silu_f(v);
  }
  __syncthreads();
  float* mods = (float*)(ws + WS_MODS);
  for (int it = blockIdx.x; it < 2 * 192; it += gridDim.x) {
    int layer = it / 192, cg_ = it % 192; int n = cg_ * 64 + lane;
    const float* w = p.w_mod + (size_t)layer * DM * 12288 + n;
    float a0 = 0.f, a1 = 0.f, a2 = 0.f;
    int k0 = wid * 256;
    for (int kb = k0; kb < k0 + 256; kb += 32) {
      float wv[32];
#pragma unroll
      for (int u = 0; u < 32; ++u) wv[u] = w[(size_t)(kb + u) * 12288];
#pragma unroll
      for (int u = 0; u < 32; ++u) { a0 = fmaf(sc[kb + u], wv[u], a0); a1 = fmaf(sc[2048 + kb + u], wv[u], a1); a2 = fmaf(sc[4096 + kb + u], wv[u], a2); }
    }
    red[(wid * 3 + 0) * 64 + lane] = a0; red[(wid * 3 + 1) * 64 + lane] = a1; red[(wid * 3 + 2) * 64 + lane] = a2;
    __syncthreads();
    if (tid < 192) {
      int j = tid >> 6, l = tid & 63; float s = 0.f;
#pragma unroll
      for (int w8 = 0; w8 < 8; ++w8) s += red[(w8 * 3 + j) * 64 + l];
      int nn = cg_ * 64 + l;
      mods[(size_t)(layer * 3 + j) * 12288 + nn] = s + p.b_mod[layer * 12288 + nn];
    }
    __syncthreads();
  }
  convert_weights(p, 0, lds);
}

__device__ __forceinline__ void phase_norm_mod(const Params& p, int layer, int which, int nrows) {
  const int tid = otid(), lane = tid & 63, wid = tid >> 6;
  char* ws = p.ws;
  const float* gain = (which ? p.norm_ffn : p.norm_mix) + layer * DM;
  const float* mods = (const float*)(ws + WS_MODS) + (size_t)layer * 3 * 12288;
  const float* X = (const float*)(ws + WS_X);
  bf16_t* H = (bf16_t*)(ws + WS_H);
  for (int row = blockIdx.x * 8 + wid; row < nrows; row += gridDim.x * 8) {
    const float* src = (layer == 0 && which == 0) ? (row < T_LAT ? p.x + (size_t)row * DM : p.ctx + (size_t)(row - T_LAT) * DM) : X + (size_t)row * DM;
    const float* sh = mods + mod_idx(row) * 12288 + (which ? 3 : 0) * DM; const float* scl = sh + DM;
    float4 v[8]; float ss = 0.f;
    const bool comb = row >= T_LAT && ((layer == 0 && which == 1) || (layer == 1 && which == 0));
    if (comb) { src = which ? p.ctx + (size_t)(row - T_LAT) * DM : X + (size_t)row * DM; }
    const float* gate = (const float*)(ws + WS_MODS) + 2 * 12288 + (which ? 2 : 5) * DM;
    const float* part = (const float*)(ws + WS_PART) + (size_t)(row - T_LAT) * DM;
#pragma unroll
    for (int i = 0; i < 8; ++i) { v[i] = reinterpret_cast<const float4*>(src)[i * 64 + lane];
      if (comb) { const int n4 = i * 64 + lane; const float4 g4 = reinterpret_cast<const float4*>(gate)[n4];
        float4 s4 = reinterpret_cast<const float4*>(part)[n4];
#pragma unroll
        for (int q = 1; q < 4; ++q) { const float4 t4 = reinterpret_cast<const float4*>(part + (size_t)q * 512 * DM)[n4]; s4.x += t4.x; s4.y += t4.y; s4.z += t4.z; s4.w += t4.w; }
        v[i].x += g4.x * s4.x; v[i].y += g4.y * s4.y; v[i].z += g4.z * s4.z; v[i].w += g4.w * s4.w;
        if (which) reinterpret_cast<float4*>((float*)(ws + WS_X) + (size_t)row * DM)[n4] = v[i]; }
      ss += v[i].x * v[i].x + v[i].y * v[i].y + v[i].z * v[i].z + v[i].w * v[i].w; }
    ss = wave_sum(ss);
    float rstd = rsqrtf(ss * (1.f / DM) + EPS);
#pragma unroll
    for (int i = 0; i < 8; ++i) {
      int n = (i * 64 + lane) * 4;
      float4 g = *reinterpret_cast<const float4*>(gain + n), s4 = *reinterpret_cast<const float4*>(scl + n), h4 = *reinterpret_cast<const float4*>(sh + n);
      float y0 = v[i].x * rstd * g.x * (1.f + s4.x) + h4.x, y1 = v[i].y * rstd * g.y * (1.f + s4.y) + h4.y;
      float y2 = v[i].z * rstd * g.z * (1.f + s4.z) + h4.z, y3 = v[i].w * rstd * g.w * (1.f + s4.w) + h4.w;
      u32x2 o = {cvtpk(y0, y1), cvtpk(y2, y3)};
      *reinterpret_cast<u32x2*>(H + (size_t)row * HLD + n) = o;
    }
  }
}

template <int NTW, class Epi>
__device__ __forceinline__ void gemm_tile(const bf16_t* __restrict__ A, int lda, int arow0, int amax,
                                          const bf16_t* __restrict__ Bt, int ldb, int K, char* lds, Epi epi) {
  constexpr int NBL = 2 * NTW;
  constexpr int ABYTES = 256 * 128, BBYTES = 128 * NTW * 128, STAGE = ABYTES + BBYTES;
  const int tid = otid(), lane = tid & 63, wid = tid >> 6, l31 = lane & 31, hi = lane >> 5;
  const int wm = wid >> 2, wn = wid & 3;
  f32x16 acc[4][NTW];
#pragma unroll
  for (int i = 0; i < 4; ++i)
#pragma unroll
    for (int j = 0; j < NTW; ++j)
#pragma unroll
      for (int r = 0; r < 16; ++r) acc[i][j][r] = 0.f;
  const int lc = tid & 7, lr = tid >> 3;
  unsigned aoff[4], boff[NBL];
#pragma unroll
  for (int i = 0; i < 4; ++i) { int gr = arow0 + lr + 64 * i; gr = gr < 0 ? 0 : (gr > amax ? amax : gr); aoff[i] = (unsigned)gr * (unsigned)lda + (unsigned)(lc * 8); }
#pragma unroll
  for (int i = 0; i < NBL; ++i) boff[i] = (unsigned)(lr + 64 * i) * (unsigned)ldb + (unsigned)(lc * 8);
  const int wofs = lr * 128 + ((lc ^ ((lr >> 1) & 7)) << 4);
  u32x4 ra[4], rb[NBL];
  const int nk = K >> 6;
#pragma unroll
  for (int i = 0; i < 4; ++i) ra[i] = *reinterpret_cast<const u32x4*>(A + aoff[i]);
#pragma unroll
  for (int i = 0; i < NBL; ++i) rb[i] = *reinterpret_cast<const u32x4*>(Bt + boff[i]);
  __syncthreads();
#pragma unroll
  for (int i = 0; i < 4; ++i) *reinterpret_cast<u32x4*>(lds + wofs + i * 8192) = ra[i];
#pragma unroll
  for (int i = 0; i < NBL; ++i) *reinterpret_cast<u32x4*>(lds + ABYTES + wofs + i * 8192) = rb[i];
  __syncthreads();
  const int rsw = (l31 >> 1) & 7;
  const int a_base = (wm * 128 + l31) * 128, b_base = ABYTES + (wn * 32 * NTW + l31) * 128;
  for (int kt = 0; kt < nk; ++kt) {
    if (kt + 1 < nk) {
      const int ko = (kt + 1) * 64;
#pragma unroll
      for (int i = 0; i < 4; ++i) ra[i] = *reinterpret_cast<const u32x4*>(A + ko + aoff[i]);
#pragma unroll
      for (int i = 0; i < NBL; ++i) rb[i] = *reinterpret_cast<const u32x4*>(Bt + ko + boff[i]);
    }
    __builtin_amdgcn_sched_barrier(0);
    const char* st = lds + (kt & 1) * STAGE;
    bf16x8 af[4], bfv[2][NTW];
#define CO_(S) ((((S) * 2 + hi) ^ rsw) << 4)
#define LDA_(MT, S) af[MT] = *reinterpret_cast<const bf16x8*>(st + a_base + (MT) * 4096 + CO_(S))
#define LDB_(BUF, S) do { _Pragma("unroll") for (int nt = 0; nt < NTW; ++nt) bfv[BUF][nt] = *reinterpret_cast<const bf16x8*>(st + b_base + nt * 4096 + CO_(S)); } while (0)
    LDB_(0, 0);
#pragma unroll
    for (int mt = 0; mt < 4; ++mt) LDA_(mt, 0);
#pragma unroll
    for (int s = 0; s < 4; ++s) {
      if (s < 3) LDB_((s + 1) & 1, s + 1);
#pragma unroll
      for (int mt = 0; mt < 4; ++mt) {
        __builtin_amdgcn_sched_barrier(0);
#pragma unroll
        for (int nt = 0; nt < NTW; ++nt) acc[mt][nt] = mfma32(af[mt], bfv[s & 1][nt], acc[mt][nt]);
        if (s < 3) LDA_(mt, s + 1);
      }
      __builtin_amdgcn_sched_barrier(0);
    }
#undef CO_
#undef LDA_
#undef LDB_
    if (kt + 1 < nk) {
      char* sw = lds + ((kt + 1) & 1) * STAGE;
#pragma unroll
      for (int i = 0; i < 4; ++i) *reinterpret_cast<u32x4*>(sw + wofs + i * 8192) = ra[i];
#pragma unroll
      for (int i = 0; i < NBL; ++i) *reinterpret_cast<u32x4*>(sw + ABYTES + wofs + i * 8192) = rb[i];
    }
    __syncthreads();
  }
  epi(acc, wm, wn, l31, hi);
}


__device__ __forceinline__ int block_L(int r) { const int G = gridDim.x, slots = G >> 3, b = blockIdx.x; return (r * 8 + (b & 7)) * slots + (b >> 3); }
__device__ __forceinline__ void grouped_mn(int L, int MT, int NT, int& mt, int& nt) {
  const int pg_ = 4 * NT; const int g = L / pg_, rem = L - g * pg_; const int gsz = (MT - 4 * g) < 4 ? (MT - 4 * g) : 4;
  nt = rem / gsz; mt = 4 * g + rem - nt * gsz;
}
__device__ __forceinline__ bool tile_of(int r, int MT, int NT, int& mt, int& nt) {
  const int G = gridDim.x, slots = G >> 3, b = blockIdx.x, x = b & 7, s = b >> 3;
  const int total = MT * NT, per = (total + 7) >> 3;
  const int start = x * per; int cnt = total - start; cnt = cnt > per ? per : cnt;
  const int idx = r * slots + s; if (idx >= cnt) return false;
  grouped_mn(start + idx, MT, NT, mt, nt); return true;
}

namespace pg {
using f32x4 = __attribute__((ext_vector_type(4))) float;
constexpr int HTB = 128 * 64 * 2;
__device__ __forceinline__ int lds_byte(int r, int c) { const int st = (r >> 4) * 2 + (c >> 5), rr = r & 15, cc = c & 31, ob = rr * 64 + cc * 2; return st * 1024 + (ob ^ (((ob >> 9) & 1) << 5)); }
__device__ __forceinline__ void stage_rc(int b, int& R, int& C) { const int st = b / 1024, sb = b % 1024, swz = sb ^ (((sb >> 9) & 1) << 5); R = (st >> 1) * 16 + swz / 64; C = (st & 1) * 32 + (swz % 64) / 2; }
__device__ __forceinline__ int perm32(int rho) { const int n = rho >> 4, i = rho & 15; return 8 * (i >> 2) + 4 * n + (i & 3); }
struct Unit { const char* a; const char* b; int nt, m0, n0, tag; };

template <bool PERM, class Sched, class Epi>
__device__ __forceinline__ void gemm_phase(LAS unsigned char* lds, int lda, int ldb, const Sched& S, const Epi& E) {
    const int tid = otid(), wid = __builtin_amdgcn_readfirstlane(tid >> 6), lane = tid & 63, wr = wid >> 2, wc = wid & 3, fr = lane & 15, fq = lane >> 4;
    unsigned voffA[2], voffB[2];
#pragma unroll
    for (int i = 0; i < 2; ++i) { int R, C; stage_rc(tid * 16 + i * 8192, R, C); const int Rb = PERM ? ((R & ~31) + perm32(R & 31)) : R;
        voffA[i] = (unsigned)(R * lda + C) * 2u; voffB[i] = (unsigned)(Rb * ldb + C) * 2u; }
    const size_t kstep = 128;
    const size_t hstepA = (size_t)128 * lda * 2, hstepB = (size_t)128 * ldb * 2;
    const unsigned ldsw = (unsigned)wid * 1024u;
    const int aoff = lds_byte(wr * 64 + fr, fq * 8), boff = lds_byte(wc * 32 + fr, fq * 8);
#define PG8_SA(b, h) (((b) * 2 + (h)) * HTB)
#define PG8_SB(b, h) ((4 + (b) * 2 + (h)) * HTB)
#define PG8_STAGE(bufoff, gbase, voff) do { _Pragma("unroll") for (int _i = 0; _i < 2; ++_i) \
        __builtin_amdgcn_global_load_lds((const unsigned*)((const char*)(gbase) + (voff)[_i]), (LAS unsigned*)(lds + (bufoff) + ldsw + _i * 8192), 16, 0, 0); } while (0)
#define PG8_LDA(dst, b, h) do { _Pragma("unroll") for (int m = 0; m < 4; ++m) _Pragma("unroll") for (int k = 0; k < 2; ++k) dst[m][k] = *(const LAS bf16x8*)(lds + PG8_SA(b, h) + aoff + m * 2048 + k * 1024); } while (0)
#define PG8_LDB(dst, b, h) do { _Pragma("unroll") for (int n = 0; n < 2; ++n) _Pragma("unroll") for (int k = 0; k < 2; ++k) dst[n][k] = *(const LAS bf16x8*)(lds + PG8_SB(b, h) + boff + n * 2048 + k * 1024); } while (0)
#define PG8_MMA(ai, bj, At, Bt) do { __builtin_amdgcn_s_setprio(1); _Pragma("unroll") for (int m = 0; m < 4; ++m) _Pragma("unroll") for (int n = 0; n < 2; ++n) _Pragma("unroll") for (int k = 0; k < 2; ++k) \
        acc[ai][bj][m][n] = __builtin_amdgcn_mfma_f32_16x16x32_bf16(Bt[n][k], At[m][k], acc[ai][bj][m][n], 0, 0, 0); __builtin_amdgcn_s_setprio(0); } while (0)
#define PG8_WAIT_V(n) asm volatile("s_waitcnt vmcnt(" #n ")" ::: "memory")
#define PG8_WAIT_L(n) asm volatile("s_waitcnt lgkmcnt(" #n ")" ::: "memory")
#define PG8_BAR __builtin_amdgcn_s_barrier()
#define PG8_SCHED __builtin_amdgcn_sched_barrier(0)
    Unit cur, nxt; int ui = 0;
    if (!S.next(0, cur)) return;
    f32x4 acc[2][2][4][2];
#pragma unroll
    for (int a = 0; a < 2; ++a)
#pragma unroll
        for (int b = 0; b < 2; ++b)
#pragma unroll
            for (int m = 0; m < 4; ++m)
#pragma unroll
                for (int n = 0; n < 2; ++n) acc[a][b][m][n] = (f32x4){0.f, 0.f, 0.f, 0.f};
    bf16x8 At[4][2], B0[2][2], B1[2][2];
    const char* cA = cur.a; const char* cB = cur.b;
    PG8_STAGE(PG8_SB(0, 0), cB, voffB); PG8_STAGE(PG8_SA(0, 0), cA, voffA); PG8_STAGE(PG8_SB(0, 1), cB + hstepB, voffB); PG8_STAGE(PG8_SA(0, 1), cA + hstepA, voffA);
    if (wr == 1) PG8_BAR;
    PG8_WAIT_V(4); PG8_BAR;
    PG8_STAGE(PG8_SB(1, 0), cB + kstep, voffB); PG8_STAGE(PG8_SA(1, 0), cA + kstep, voffA); PG8_STAGE(PG8_SB(1, 1), cB + hstepB + kstep, voffB);
    PG8_WAIT_V(6); PG8_BAR;
    for (;;) {
        const bool has_next = S.next(ui + 1, nxt);
        const char* nA = has_next ? nxt.a : cA; const char* nB = has_next ? nxt.b : cB;
        const int nt = cur.nt;
        for (int t = 0; t < nt; t += 2) {
            const bool last = (t == nt - 2);
            const char* a1 = cA + (size_t)(t + 1) * kstep;
            const char* a2 = last ? nA : cA + (size_t)(t + 2) * kstep; const char* b2 = last ? nB : cB + (size_t)(t + 2) * kstep;
            const char* a3 = a2 + kstep; const char* b3 = b2 + kstep;
            PG8_LDB(B0, 0, 0); PG8_SCHED; PG8_LDA(At, 0, 0); PG8_STAGE(PG8_SA(1, 1), a1 + hstepA, voffA);
            PG8_WAIT_L(8); PG8_BAR; PG8_WAIT_L(0); PG8_MMA(0, 0, At, B0); PG8_BAR; PG8_SCHED;
            PG8_LDB(B1, 0, 1); PG8_STAGE(PG8_SB(0, 0), b2, voffB);
            PG8_BAR; PG8_WAIT_L(0); PG8_MMA(0, 1, At, B1); PG8_BAR;
            PG8_LDA(At, 0, 1); PG8_STAGE(PG8_SA(0, 0), a2, voffA);
            PG8_BAR; PG8_WAIT_L(0); PG8_MMA(1, 0, At, B0); PG8_BAR; PG8_SCHED;
            PG8_STAGE(PG8_SB(0, 1), b2 + hstepB, voffB);
            PG8_WAIT_V(6); PG8_BAR; PG8_MMA(1, 1, At, B1); PG8_BAR;
            PG8_LDB(B0, 1, 0); PG8_SCHED; PG8_LDA(At, 1, 0); PG8_STAGE(PG8_SA(0, 1), a2 + hstepA, voffA);
            PG8_WAIT_L(8); PG8_BAR; PG8_WAIT_L(0); PG8_MMA(0, 0, At, B0); PG8_BAR; PG8_SCHED;
            PG8_LDB(B1, 1, 1); PG8_STAGE(PG8_SB(1, 0), b3, voffB);
            PG8_BAR; PG8_WAIT_L(0); PG8_MMA(0, 1, At, B1); PG8_BAR;
            PG8_LDA(At, 1, 1); PG8_STAGE(PG8_SA(1, 0), a3, voffA);
            PG8_BAR; PG8_WAIT_L(0); PG8_MMA(1, 0, At, B0); PG8_BAR; PG8_SCHED;
            PG8_STAGE(PG8_SB(1, 1), b3 + hstepB, voffB);
            PG8_WAIT_V(6); PG8_BAR; PG8_MMA(1, 1, At, B1); PG8_BAR;
        }
        E(acc, cur, wr, wc, fr, fq);
        if (!has_next) break;
#pragma unroll
        for (int a = 0; a < 2; ++a)
#pragma unroll
            for (int b = 0; b < 2; ++b)
#pragma unroll
                for (int m = 0; m < 4; ++m)
#pragma unroll
                    for (int n = 0; n < 2; ++n) acc[a][b][m][n] = (f32x4){0.f, 0.f, 0.f, 0.f};
        cur = nxt; cA = nA; cB = nB; ++ui;
    }
    PG8_WAIT_V(0);
    if (wr == 0) PG8_BAR;
    PG8_BAR;
#undef PG8_SA
#undef PG8_SB
#undef PG8_STAGE
#undef PG8_LDA
#undef PG8_LDB
#undef PG8_MMA
#undef PG8_WAIT_V
#undef PG8_WAIT_L
#undef PG8_BAR
#undef PG8_SCHED
}
}


struct SchedMN {
  const char* A; const char* B; int lda, ldb, MT, NT, nt;
  __device__ __forceinline__ bool next(int i, pg::Unit& u) const {
    int mt, ntl; if (!tile_of(i, MT, NT, mt, ntl)) return false;
    u.m0 = mt * 256; u.n0 = ntl * 256; u.a = A + (size_t)u.m0 * lda * 2; u.b = B + (size_t)u.n0 * ldb * 2; u.nt = nt; u.tag = 0; return true; }
};
struct SchedRes {
  const char* A; const char* B; int lda, ldb, ntk, nctx;
  __device__ __forceinline__ bool next(int i, pg::Unit& u) const {
    const int L = block_L(i);
    if (L < 512) { int mt, ntl; grouped_mn(L, 64, 8, mt, ntl); u.m0 = mt * 256; u.n0 = ntl * 256; u.a = A + (size_t)u.m0 * lda * 2; u.b = B + (size_t)u.n0 * ldb * 2; u.nt = ntk; u.tag = 0; return true; }
    const int s = L - 512; if (s >= nctx * 4) return false;
    const int cu = s >> 2, ks = s & 3, kt = ntk >> 2;
    u.m0 = (64 + (cu >> 3)) * 256; u.n0 = (cu & 7) * 256; u.nt = kt; u.tag = 1 + ks;
    u.a = A + ((size_t)u.m0 * lda + (size_t)ks * kt * 64) * 2; u.b = B + ((size_t)u.n0 * ldb + (size_t)ks * kt * 64) * 2; return true; }
};
struct SchedQKV {
  const char* P; const char* Wq; const char* Wkv; int MT;
  __device__ __forceinline__ bool next(int i, pg::Unit& u) const {
    int mt, ntv; if (!tile_of(i, MT, 14, mt, ntv)) return false;
    const bool isq = ntv < 6; const int ntl = isq ? ntv : ntv - 6;
    u.m0 = mt * 256; u.n0 = ntl * 256; u.tag = isq ? 0 : 1; u.nt = isq ? 12 : 8;
    u.a = P + ((size_t)u.m0 * PLD + (isq ? 0 : OFF_CKV)) * 2; u.b = (isq ? Wq : Wkv) + (size_t)u.n0 * 768 * 2; return true; }
};

__device__ __forceinline__ void phase_gemm_in(const Params& p, char* lds) {
  char* ws = p.ws;
  bf16_t* P = (bf16_t*)(ws + WS_P); float* DT = (float*)(ws + WS_DT);
  SchedMN S{ws + WS_H, ws + WS_WIN, HLD, WLD, T_ALL / 256, PNP / 256, DM / 64};
  auto epi = [=](const pg::f32x4 (&acc)[2][2][4][2], const pg::Unit& u, int wr, int wc, int fr, int fq) {
    const int row0 = u.m0 + wr * 64 + fr;
#pragma unroll
    for (int ai = 0; ai < 2; ++ai)
#pragma unroll
      for (int m = 0; m < 4; ++m) { const int row = row0 + ai * 128 + m * 16;
#pragma unroll
        for (int bj = 0; bj < 2; ++bj) { const int c = u.n0 + bj * 128 + wc * 32 + 8 * fq;
          const pg::f32x4 v0 = acc[ai][bj][m][0], v1 = acc[ai][bj][m][1];
          if (c < PLD) { u32x4 w = {cvtpk(v0[0], v0[1]), cvtpk(v0[2], v0[3]), cvtpk(v1[0], v1[1]), cvtpk(v1[2], v1[3])}; *reinterpret_cast<u32x4*>(P + (size_t)row * PLD + c) = w; }
          if (c >= OFF_DT && c < PIN) { *reinterpret_cast<pg::f32x4*>(DT + (size_t)row * 16 + (c - OFF_DT)) = v0; *reinterpret_cast<pg::f32x4*>(DT + (size_t)row * 16 + (c - OFF_DT) + 4) = v1; } } }
  };
  pg::gemm_phase<true>((LAS unsigned char*)lds, HLD, WLD, S, epi);
}

__device__ __forceinline__ void phase_qkv_gemm_and_post(const Params& p, int layer, char* lds) {
  char* ws = p.ws;
  const bf16_t* P = (const bf16_t*)(ws + WS_P);
  { SchedQKV S{ws + WS_P, ws + WS_WUQ, ws + WS_WUKV, T_ALL / 256};
    bf16_t* dq = (bf16_t*)(ws + WS_QRAW); bf16_t* dkv = (bf16_t*)(ws + WS_KVRAW);
    auto epi = [=](const pg::f32x4 (&acc)[2][2][4][2], const pg::Unit& u, int wr, int wc, int fr, int fq) {
      bf16_t* dst = u.tag ? dkv : dq; const int ldd = u.tag ? 2048 : 1536;
      const int row0 = u.m0 + wr * 64 + fr;
#pragma unroll
      for (int ai = 0; ai < 2; ++ai)
#pragma unroll
        for (int m = 0; m < 4; ++m) { const int row = row0 + ai * 128 + m * 16;
#pragma unroll
          for (int bj = 0; bj < 2; ++bj) { const int c = u.n0 + bj * 128 + wc * 32 + 8 * fq;
            const pg::f32x4 v0 = acc[ai][bj][m][0], v1 = acc[ai][bj][m][1];
            u32x4 w = {cvtpk(v0[0], v0[1]), cvtpk(v0[2], v0[3]), cvtpk(v1[0], v1[1]), cvtpk(v1[2], v1[3])};
            *reinterpret_cast<u32x4*>(dst + (size_t)row * ldd + c) = w; } }
    };
    pg::gemm_phase<true>((LAS unsigned char*)lds, PLD, 768, S, epi); }
  const int tid = otid(), lane = tid & 63, wid = tid >> 6;
  float* RSTD = (float*)(ws + WS_RSTD); float* DT = (float*)(ws + WS_DT); bf16_t* XBC = (bf16_t*)(ws + WS_XBC);
  const float* cw = p.ssd_conv_w + (size_t)layer * 3 * 1024; const float* cb = p.ssd_conv_b + layer * 1024;
  for (int t = blockIdx.x * 8 + wid; t < T_ALL; t += gridDim.x * 8) {
    const bf16_t* pr = P + (size_t)t * PLD;
    float sq = 0.f, skv = 0.f; float f[8];
    for (int c = lane; c < 96; c += 64) { unpack8(*reinterpret_cast<const u32x4*>(pr + c * 8), f);
#pragma unroll
      for (int e = 0; e < 8; ++e) sq += f[e] * f[e]; }
    { unpack8(*reinterpret_cast<const u32x4*>(pr + OFF_CKV + lane * 8), f);
#pragma unroll
      for (int e = 0; e < 8; ++e) skv += f[e] * f[e]; }
    sq = wave_sum(sq); skv = wave_sum(skv);
    if (lane == 0) { RSTD[t * 2] = rsqrtf(sq * (1.f / 768.f) + EPS); RSTD[t * 2 + 1] = rsqrtf(skv * (1.f / 512.f) + EPS); }
    if (lane < 16) { float v = DT[(size_t)t * 16 + lane] + p.ssd_dt_bias[layer * 16 + lane]; DT[(size_t)t * 16 + lane] = v > 20.f ? v : log1pf(__expf(v)); }
    const bool s0 = seq_start(t), s1 = seq_end(t);
#pragma unroll
    for (int cc = 0; cc < 2; ++cc) {
      const int c0 = (cc * 64 + lane) * 8;
      float fm[8], fc[8], fp[8];
      unpack8(*reinterpret_cast<const u32x4*>(pr + OFF_XBC + c0), fc);
      if (!s0) unpack8(*reinterpret_cast<const u32x4*>(pr - PLD + OFF_XBC + c0), fm);
      if (!s1) unpack8(*reinterpret_cast<const u32x4*>(pr + PLD + OFF_XBC + c0), fp);
      float o[8];
#pragma unroll
      for (int e = 0; e < 8; ++e) {
        float a = cb[c0 + e] + cw[1024 + c0 + e] * fc[e];
        if (!s0) a += cw[c0 + e] * fm[e];
        if (!s1) a += cw[2048 + c0 + e] * fp[e];
        o[e] = silu_f(a);
      }
      *reinterpret_cast<u32x4*>(XBC + (size_t)t * 1024 + c0) = pack8(o);
    }
  }
}

__device__ __forceinline__ void phase_build_qkv(const Params& p, int layer) {
  char* ws = p.ws;
  const int tid = otid(), lane = tid & 63, wid = tid >> 6;
  const bf16_t* P = (const bf16_t*)(ws + WS_P); const bf16_t* QR = (const bf16_t*)(ws + WS_QRAW); const bf16_t* KVR = (const bf16_t*)(ws + WS_KVRAW);
  const float* RSTD = (const float*)(ws + WS_RSTD); const float* rope = (const float*)(ws + WS_ROPE);
  bf16_t* Q = (bf16_t*)(ws + WS_Q); bf16_t* QC = (bf16_t*)(ws + WS_QC); bf16_t* Kb = (bf16_t*)(ws + WS_K); bf16_t* Vb = (bf16_t*)(ws + WS_V);
  const float* qn = p.q_norm + layer * 192; const float* kn = p.k_norm + layer * 192;
  const float qg0 = qn[lane], qg1 = qn[64 + lane], qg2 = qn[128 + lane];
  const float kg0 = kn[lane], kg1 = kn[64 + lane], kg2 = kn[128 + lane];
  const int ax = lane >> 5, jj = lane & 15, second = (lane >> 4) & 1;
  for (int t = blockIdx.x * 8 + wid; t < T_ALL; t += gridDim.x * 8) {
    const bool lat = t < T_LAT;
    const int b = lat ? (t >> 13) : ((t - T_LAT) >> 8);
    const int pos = lat ? (t & (SEQ - 1)) : ((t - T_LAT) & (CTXL - 1));
    const int kpos = lat ? (CTXL + pos) : pos;
    const float rq = RSTD[t * 2], rkv = RSTD[t * 2 + 1];
    float cs = 1.f, sn = 0.f;
    if (lat) { const int pa = ax ? (pos & 63) : (pos >> 6); cs = rope[(pa * 16 + jj) * 2]; sn = rope[(pa * 16 + jj) * 2 + 1]; }
    const float krv = bf2f(P[(size_t)t * PLD + OFF_KR + lane]);
    for (int h = 0; h < 8; ++h) {
      const bf16_t* qs = QR + (size_t)t * 1536 + h * 192;
      float v0 = bf2f(qs[lane]) * rq, v1 = bf2f(qs[64 + lane]) * rq, v2 = bf2f(qs[128 + lane]) * rq;
      float ss = wave_sum(v0 * v0 + v1 * v1 + v2 * v2);
      float r = rsqrtf(ss * (1.f / 192.f) + EPS);
      v0 *= r * qg0; v1 *= r * qg1; v2 *= r * qg2;
      if (lat) { float pr = __shfl_xor(v2, 16); v2 = second ? (v2 * cs + pr * sn) : (v2 * cs - pr * sn); }
      bf16_t* qd = lat ? Q + ((size_t)(b * 8 + h) * SEQ + pos) * 192 : QC + ((size_t)(b * 8 + h) * CTXL + pos) * 192;
      qd[lane] = f2bf(v0 * QSCALE); qd[64 + lane] = f2bf(v1 * QSCALE); qd[128 + lane] = f2bf(v2 * QSCALE);
      const bf16_t* ks = KVR + (size_t)t * 2048 + h * 256;
      float k0 = bf2f(ks[lane]) * rkv, k1 = bf2f(ks[64 + lane]) * rkv, k2 = krv;
      float vv0 = bf2f(ks[128 + lane]) * rkv, vv1 = bf2f(ks[192 + lane]) * rkv;
      float ks2 = wave_sum(k0 * k0 + k1 * k1 + k2 * k2);
      float rk = rsqrtf(ks2 * (1.f / 192.f) + EPS);
      k0 *= rk * kg0; k1 *= rk * kg1; k2 *= rk * kg2;
      if (lat) { float pr = __shfl_xor(k2, 16); k2 = second ? (k2 * cs + pr * sn) : (k2 * cs - pr * sn); }
      bf16_t* kd = Kb + ((size_t)(b * 8 + h) * NKEYS + kpos) * 192;
      kd[lane] = f2bf(k0); kd[64 + lane] = f2bf(k1); kd[128 + lane] = f2bf(k2);
      bf16_t* vd = Vb + ((size_t)(b * 8 + h) * NKEYS + kpos) * 128;
      vd[lane] = f2bf(vv0); vd[64 + lane] = f2bf(vv1);
    }
  }
}

#define KSWZ(row, colB) ((row) * 384 + ((colB) ^ ((((row) >> 1) & 7) << 4)))
__device__ __forceinline__ int v_st(int k, int c) { const int kk = (k & ~0xC) | ((k & 4) << 1) | ((k & 8) >> 1); return ((kk >> 3) * 4 + (c >> 5)) * 512 + ((kk & 7) * 32 + (c & 31)) * 2; }
__device__ __forceinline__ int v_rd_base(int lane) { return ((lane & 3) << 3) | (((lane >> 2) & 3) << 6) | (((lane >> 4) & 1) << 5) | (((lane >> 5) & 1) << 8); }
constexpr int v_rd_off(int d0, int ks, int half) { return d0 * 512 + ks * 4096 + half * 2048; }
template <int OFF> __device__ __forceinline__ s16x4 tr_read(int vb) {
  s16x4 r; asm volatile("ds_read_b64_tr_b16 %0, %1 offset:%2" : "=&v"(r) : "v"(vb), "i"(OFF) : "memory"); return r;
}
struct VFrag { s16x4 l0, h0, l1, h1, l2, h2, l3, h3; };
template <int D0> __device__ __forceinline__ void pv_read(VFrag& f, int vb) {
  f.l0 = tr_read<v_rd_off(D0, 0, 0)>(vb); f.h0 = tr_read<v_rd_off(D0, 0, 1)>(vb); f.l1 = tr_read<v_rd_off(D0, 1, 0)>(vb); f.h1 = tr_read<v_rd_off(D0, 1, 1)>(vb);
  f.l2 = tr_read<v_rd_off(D0, 2, 0)>(vb); f.h2 = tr_read<v_rd_off(D0, 2, 1)>(vb); f.l3 = tr_read<v_rd_off(D0, 3, 0)>(vb); f.h3 = tr_read<v_rd_off(D0, 3, 1)>(vb);
}
__device__ __forceinline__ void pv_mma(f32x16& od, const VFrag& f, bf16x8 pa0, bf16x8 pa1, bf16x8 pa2, bf16x8 pa3) {
#define PK(L, H) (bf16x8){L[0], L[1], L[2], L[3], H[0], H[1], H[2], H[3]}
  od = mfma32(pa0, PK(f.l0, f.h0), od); od = mfma32(pa1, PK(f.l1, f.h1), od); od = mfma32(pa2, PK(f.l2, f.h2), od); od = mfma32(pa3, PK(f.l3, f.h3), od);
#undef PK
}
__device__ __forceinline__ void pv_all(f32x16* o, int vb, bf16x8 pa0, bf16x8 pa1, bf16x8 pa2, bf16x8 pa3) {
  VFrag fa, fb;
  pv_read<0>(fa, vb); pv_read<1>(fb, vb);
  asm volatile("s_waitcnt lgkmcnt(8)" : "+v"(fa.l0), "+v"(fa.h0), "+v"(fa.l1), "+v"(fa.h1), "+v"(fa.l2), "+v"(fa.h2), "+v"(fa.l3), "+v"(fa.h3) :: "memory"); __builtin_amdgcn_sched_barrier(0);
  pv_mma(o[0], fa, pa0, pa1, pa2, pa3); __builtin_amdgcn_sched_barrier(0);
  pv_read<2>(fa, vb);
  asm volatile("s_waitcnt lgkmcnt(8)" : "+v"(fb.l0), "+v"(fb.h0), "+v"(fb.l1), "+v"(fb.h1), "+v"(fb.l2), "+v"(fb.h2), "+v"(fb.l3), "+v"(fb.h3) :: "memory"); __builtin_amdgcn_sched_barrier(0);
  pv_mma(o[1], fb, pa0, pa1, pa2, pa3); __builtin_amdgcn_sched_barrier(0);
  pv_read<3>(fb, vb);
  asm volatile("s_waitcnt lgkmcnt(8)" : "+v"(fa.l0), "+v"(fa.h0), "+v"(fa.l1), "+v"(fa.h1), "+v"(fa.l2), "+v"(fa.h2), "+v"(fa.l3), "+v"(fa.h3) :: "memory"); __builtin_amdgcn_sched_barrier(0);
  pv_mma(o[2], fa, pa0, pa1, pa2, pa3); __builtin_amdgcn_sched_barrier(0);
  asm volatile("s_waitcnt lgkmcnt(0)" : "+v"(fb.l0), "+v"(fb.h0), "+v"(fb.l1), "+v"(fb.h1), "+v"(fb.l2), "+v"(fb.h2), "+v"(fb.l3), "+v"(fb.h3) :: "memory"); __builtin_amdgcn_sched_barrier(0);
  pv_mma(o[3], fb, pa0, pa1, pa2, pa3);
}

constexpr int ATT_V = 0, ATT_K = 32768, ATT_WS = 32768 + 49152;
__device__ __forceinline__ void attn_item(const bf16_t* __restrict__ Qb, const bf16_t* __restrict__ Kh, const bf16_t* __restrict__ Vh, int nkeys,
                          bf16_t* __restrict__ Ob, float* __restrict__ ml, char* lds) {
  constexpr float THR = 8.f;
  const int tid = otid(), wid = tid >> 6, lane = tid & 63, r32 = lane & 31, hi = lane >> 5;
  char* V_lds = lds + ATT_V; char* K_lds = lds + ATT_K;
  float* wsf = (float*)(lds + ATT_WS) + wid * 64; float* li_l = wsf; float* al_l = wsf + 32;
  float m_reg = 0.f, l_reg = 0.f;
  f32x16 o[4];
#pragma unroll
  for (int d = 0; d < 4; ++d)
#pragma unroll
    for (int r = 0; r < 16; ++r) o[d][r] = 0.f;
  bf16x8 qr[12];
  const bf16_t* Qw = Qb + (size_t)(wid * 32 + r32) * 192 + hi * 8;
#pragma unroll
  for (int d0 = 0; d0 < 12; ++d0) qr[d0] = *reinterpret_cast<const bf16x8*>(Qw + d0 * 16);
  const int sr = tid >> 4, sc = (tid & 15) * 8, vst0 = v_st(sr, sc), vst1 = v_st(32 + sr, sc);
  const int vb0 = (int)(uintptr_t)V_lds + v_rd_base(lane);
#define krow(i) ((tid + (i) * NTHR) / 24)
#define kch(i) ((tid + (i) * NTHR) % 24)
  int klow[4];
#pragma unroll
  for (int q = 0; q < 4; ++q) klow[q] = r32 * 384 + ((q * 32 + hi * 16) ^ (((r32 >> 1) & 7) << 4));
  const int wu = __builtin_amdgcn_readfirstlane(wid);
  unsigned koff[3], voff[2];
#pragma unroll
  for (int i = 0; i < 3; ++i) { const int ofs = (i * 8 + wid) * 1024 + lane * 16; const int row = ofs / 384, cpos = (ofs - row * 384) >> 4;
    const int c = (cpos & ~7) | ((cpos ^ (row >> 1)) & 7); koff[i] = (unsigned)(row * 192 + c * 8); }
#pragma unroll
  for (int i = 0; i < 2; ++i) { const int ofs = (i * 8 + wid) * 1024 + lane * 16; const int st = ofs >> 9, wv = ofs & 511;
    const int kk = (st >> 2) * 8 + (wv >> 6), c = (st & 3) * 32 + ((wv & 63) >> 1); const int k = (kk & ~0xC) | ((kk & 4) << 1) | ((kk & 8) >> 1);
    voff[i] = (unsigned)(k * 128 + c); }
#define SDMA(k0, b) do { const bf16_t* Vt = Vh + (size_t)(k0) * 128; const bf16_t* Kt = Kh + (size_t)(k0) * 192; \
    _Pragma("unroll") for (int i = 0; i < 2; ++i) __builtin_amdgcn_global_load_lds((const unsigned*)(Vt + voff[i]), (LAS unsigned*)(V_lds + (b) * 16384 + (i * 8 + wu) * 1024), 16, 0, 0); \
    _Pragma("unroll") for (int i = 0; i < 3; ++i) __builtin_amdgcn_global_load_lds((const unsigned*)(Kt + koff[i]), (LAS unsigned*)(K_lds + (b) * 24576 + (i * 8 + wu) * 1024), 16, 0, 0); } while (0)
#define SLOAD(k0) do { } while (0)
#define SWRITE(b) do { } while (0)
  const int NT = nkeys >> 6;
  __syncthreads();
  SDMA(0, 0); asm volatile("s_waitcnt vmcnt(0)" ::: "memory"); __syncthreads();
  for (int j = 0; j < NT; ++j) {
    if (j + 1 < NT) SDMA((j + 1) * 64, (j + 1) & 1);
    __builtin_amdgcn_sched_barrier(0);
    const char* Ks = K_lds + (j & 1) * 24576;
    f32x16 p0, p1;
#pragma unroll
    for (int r = 0; r < 16; ++r) { p0[r] = -m_reg; p1[r] = -m_reg; }
    bf16x8 kb0[3], kb1[3];
#define LDK_(D, SL) do { const char* kp_ = Ks + klow[(D) & 3] + ((D) >> 2) * 128; kb0[SL] = *reinterpret_cast<const bf16x8*>(kp_); kb1[SL] = *reinterpret_cast<const bf16x8*>(kp_ + 32 * 384); } while (0)
    LDK_(0, 0); LDK_(1, 1);
#pragma unroll
    for (int d0 = 0; d0 < 12; ++d0) {
      if (d0 + 2 < 12) LDK_(d0 + 2, (d0 + 2) % 3);
      __builtin_amdgcn_sched_barrier(0);
      p0 = mfma32(kb0[d0 % 3], qr[d0], p0); p1 = mfma32(kb1[d0 % 3], qr[d0], p1);
      __builtin_amdgcn_sched_barrier(0);
    }
#undef LDK_
    float pmax = p0[0];
#pragma unroll
    for (int r = 1; r < 16; ++r) pmax = fmaxf(pmax, p0[r]);
#pragma unroll
    for (int r = 0; r < 16; ++r) pmax = fmaxf(pmax, p1[r]);
    { auto rr = __builtin_amdgcn_permlane32_swap(__float_as_uint(pmax), __float_as_uint(pmax), false, false);
      pmax = fmaxf(__uint_as_float(rr[0]), __uint_as_float(rr[1])); }
    float alpha = 1.f;
    if (!__all(pmax <= THR)) {
      const float delta = fmaxf(pmax, 0.f); alpha = __builtin_amdgcn_exp2f(-delta); m_reg += delta;
#pragma unroll
      for (int r = 0; r < 16; ++r) { p0[r] -= delta; p1[r] -= delta; }
    }
    float ps = 0.f;
#pragma unroll
    for (int r = 0; r < 16; ++r) { p0[r] = __builtin_amdgcn_exp2f(p0[r]); ps += p0[r]; }
#pragma unroll
    for (int r = 0; r < 16; ++r) { p1[r] = __builtin_amdgcn_exp2f(p1[r]); ps += p1[r]; }
    { auto rr = __builtin_amdgcn_permlane32_swap(__float_as_uint(ps), __float_as_uint(ps), false, false);
      ps = __uint_as_float(rr[0]) + __uint_as_float(rr[1]); }
    l_reg = l_reg * alpha + ps;
    bf16x8 pa0, pa1, pa2, pa3;
#define PK4(P, BASE, OUT) do { unsigned a0 = cvtpk(P[BASE + 0], P[BASE + 1]), a1 = cvtpk(P[BASE + 2], P[BASE + 3]);   \
    unsigned b0_ = cvtpk(P[BASE + 4], P[BASE + 5]), b1_ = cvtpk(P[BASE + 6], P[BASE + 7]);                              \
    auto r0 = __builtin_amdgcn_permlane32_swap(a0, b0_, false, false); auto r1 = __builtin_amdgcn_permlane32_swap(a1, b1_, false, false); \
    u32x4 w = {r0[0], r1[0], r0[1], r1[1]}; OUT = *reinterpret_cast<bf16x8*>(&w); } while (0)
    PK4(p0, 0, pa0); PK4(p0, 8, pa1); PK4(p1, 0, pa2); PK4(p1, 8, pa3);
#undef PK4
    if (__any(alpha < 1.f)) {
      if (hi == 0) al_l[r32] = alpha;
      asm volatile("s_waitcnt lgkmcnt(0)" ::: "memory");
#pragma unroll
      for (int r = 0; r < 16; ++r) { const float a = al_l[crow(r, hi)];
#pragma unroll
        for (int d = 0; d < 4; ++d) o[d][r] *= a; }
    }
    const int vb = vb0 + (j & 1) * 16384;
    pv_all(o, vb, pa0, pa1, pa2, pa3);
    asm volatile("s_waitcnt vmcnt(0)" ::: "memory");
    __syncthreads();
  }
#undef SDMA
#undef SLOAD
#undef SWRITE
#undef krow
#undef kch
  if (hi == 0) { li_l[r32] = l_reg; float* mp = ml + (size_t)(wid * 32 + r32) * 16; mp[0] = m_reg; mp[1] = l_reg; }
  asm volatile("s_waitcnt lgkmcnt(0)" ::: "memory");
  bf16_t* Ow = Ob + (size_t)(wid * 32) * 1024;
#pragma unroll
  for (int r = 0; r < 16; ++r) {
    const int orow = crow(r, hi); const float rl = 1.f / li_l[orow];
#pragma unroll
    for (int d0 = 0; d0 < 4; ++d0) Ow[(size_t)orow * 1024 + d0 * 32 + r32] = f2bf(o[d0][r] * rl);
  }
}

constexpr int SS_CM = 0, SS_BM = 34816, SS_BW = 69632, SS_XV = 102400, SS_SB = 118784, SS_ACS = 136192, SS_DT = 136704, SS_RAW = 137216;
__device__ __forceinline__ int v_st2(int k, int c) { const int kk = (k & ~0xC) | ((k & 4) << 1) | ((k & 8) >> 1); return ((kk >> 3) * 2 + (c >> 5)) * 512 + ((kk & 7) * 32 + (c & 31)) * 2; }
__device__ __forceinline__ void ssd_item(const Params& p, int layer, int item, char* lds) {
  char* ws = p.ws;
  const int tid = otid(), wid = tid >> 6, lane = tid & 63, l31 = lane & 31, hi = lane >> 5;
  const int b = item >> 4, dir = (item >> 3) & 1, h = item & 7, grp = h >> 2;
  const float a_neg = -__expf(p.ssd_a_log[layer * 16 + dir * 8 + h]);
  const bf16_t* XBC = (const bf16_t*)(ws + WS_XBC); const float* DT = (const float*)(ws + WS_DT);
  bf16_t* Y = (bf16_t*)(ws + (dir ? WS_YB : WS_YF));
  float* sAcs = (float*)(lds + SS_ACS); float* sDt = (float*)(lds + SS_DT); float* sRaw = (float*)(lds + SS_RAW);
  f32x16 S;
#pragma unroll
  for (int r = 0; r < 16; ++r) S[r] = 0.f;
  const int s_pt = wid >> 2, s_nt = wid & 3;
  const int y_it = wid >> 1, y_pt = wid & 1;
  u32x4 rc[4], rbm[4], rx[2]; float rdt = 0.f;
#define SSD_BASE(K) ((K) < 2 ? T_LAT + b * CTXL + 128 * (dir ? (1 - (K)) : (K)) : b * SEQ + 128 * (dir ? (63 - ((K) - 2)) : ((K) - 2)))
#define SSD_LOAD(K) do { const int base_ = SSD_BASE(K); \
    _Pragma("unroll") for (int e = 0; e < 4; ++e) { int id = tid + e * NTHR; int it = id >> 4, c = id & 15; int prow = base_ + (dir ? 127 - it : it); \
      rbm[e] = *reinterpret_cast<const u32x4*>(XBC + (unsigned)(prow * 1024 + 512 + grp * 128 + c * 8)); \
      rc[e]  = *reinterpret_cast<const u32x4*>(XBC + (unsigned)(prow * 1024 + 768 + grp * 128 + c * 8)); } \
    _Pragma("unroll") for (int e = 0; e < 2; ++e) { int id = tid + e * NTHR; int it = id >> 3, c = id & 7; int prow = base_ + (dir ? 127 - it : it); \
      rx[e] = *reinterpret_cast<const u32x4*>(XBC + (unsigned)(prow * 1024 + h * 64 + c * 8)); } \
    if (tid < 128) { int prow = base_ + (dir ? 127 - tid : tid); rdt = DT[(unsigned)(prow * 16 + dir * 8 + h)]; } } while (0)
  for (int k = 0; k < 66; ++k) {
    const int base = SSD_BASE(k);
    __syncthreads();
    SSD_LOAD(k);
    if (tid < 128) { sDt[tid] = rdt; sRaw[tid] = rdt * a_neg; }
    __syncthreads();
    if (tid < 128) {
      float v = sRaw[tid];
#pragma unroll
      for (int o = 1; o < 64; o <<= 1) { float u = __shfl_up(v, o); if (lane >= o) v += u; }
      if (wid == 1) v += wave_sum(sRaw[lane]);
      sAcs[tid] = v;
    }
    __syncthreads();
    const float acs_last = sAcs[127];
#pragma unroll
    for (int e = 0; e < 4; ++e) { int id = tid + e * NTHR; int it = id >> 4, c = id & 15;
      *reinterpret_cast<u32x4*>(lds + SS_CM + it * 272 + c * 16) = rc[e];
      *reinterpret_cast<u32x4*>(lds + SS_BM + it * 272 + c * 16) = rbm[e];
      float f[8]; unpack8(rbm[e], f); const float w = __expf(acs_last - sAcs[it]);
#pragma unroll
      for (int q = 0; q < 8; ++q) f[q] *= w;
      *reinterpret_cast<u32x4*>(lds + SS_BW + (it >> 6) * 16384 + v_st(it & 63, c * 8)) = pack8(f); }
#pragma unroll
    for (int e = 0; e < 2; ++e) { int id = tid + e * NTHR; int it = id >> 3, c = id & 7;
      float f[8]; unpack8(rx[e], f); const float d = sDt[it];
#pragma unroll
      for (int q = 0; q < 8; ++q) f[q] *= d;
      *reinterpret_cast<u32x4*>(lds + SS_XV + (it >> 6) * 8192 + v_st2(it & 63, c * 8)) = pack8(f); }
    { bf16_t* sb = (bf16_t*)(lds + SS_SB);
#pragma unroll
      for (int r = 0; r < 16; ++r) sb[(s_pt * 32 + crow(r, hi)) * 136 + s_nt * 32 + l31] = f2bf(S[r]); }
    __syncthreads();
    f32x16 cbt[2], y;
#pragma unroll
    for (int r = 0; r < 16; ++r) { cbt[0][r] = 0.f; cbt[1][r] = 0.f; y[r] = 0.f; }
#pragma unroll
    for (int s = 0; s < 8; ++s) {
      const int co = (s * 16 + hi * 8) * 2;
      bf16x8 cmy = *reinterpret_cast<const bf16x8*>(lds + SS_CM + (y_it * 32 + l31) * 272 + co);
      bf16x8 sbv = *reinterpret_cast<const bf16x8*>(lds + SS_SB + (y_pt * 32 + l31) * 272 + co);
      y = mfma32(cmy, sbv, y);
#pragma unroll
      for (int u = 0; u < 2; ++u) { const int t_ = wid + u * 8; const int jt = t_ >> 2, it_ = t_ & 3;
        bf16x8 av = *reinterpret_cast<const bf16x8*>(lds + SS_BM + (jt * 32 + l31) * 272 + co);
        bf16x8 bv = *reinterpret_cast<const bf16x8*>(lds + SS_CM + (it_ * 32 + l31) * 272 + co);
        cbt[u] = mfma32(av, bv, cbt[u]); }
      __builtin_amdgcn_sched_barrier(0);
    }
#pragma unroll
    for (int r = 0; r < 16; ++r) y[r] *= __expf(sAcs[y_it * 32 + crow(r, hi)]);
    __syncthreads();
#pragma unroll
    for (int u = 0; u < 2; ++u) { const int t_ = wid + u * 8; const int jt = t_ >> 2, it_ = t_ & 3;
      const int i = it_ * 32 + l31; const float ai = sAcs[i];
#pragma unroll
      for (int q = 0; q < 4; ++q) {
        const int j0 = jt * 32 + 8 * q + 4 * hi; float g[4];
#pragma unroll
        for (int e = 0; e < 4; ++e) { const int j = j0 + e; g[e] = (j <= i) ? cbt[u][4 * q + e] * __expf(ai - sAcs[j]) : 0.f; }
        u32x2 w = {cvtpk(g[0], g[1]), cvtpk(g[2], g[3])};
        *reinterpret_cast<u32x2*>(lds + SS_BM + i * 272 + j0 * 2) = w;
      } }
    __syncthreads();
    const float dec = __expf(acs_last);
#pragma unroll
    for (int r = 0; r < 16; ++r) S[r] *= dec;
    { const int vrb = v_rd_base(lane);
      const int vbx_y = (int)(uintptr_t)(lds + SS_XV) + vrb + y_pt * 512, vbx_s = (int)(uintptr_t)(lds + SS_XV) + vrb + s_pt * 512, vbw_s = (int)(uintptr_t)(lds + SS_BW) + vrb + s_nt * 512;
#define PK_(L, H) (bf16x8){L[0], L[1], L[2], L[3], H[0], H[1], H[2], H[3]}
#define SSD_STEP(T, KS) do { \
      const bf16x8 gv = *reinterpret_cast<const bf16x8*>(lds + SS_BM + (y_it * 32 + l31) * 272 + (((T) * 4 + (KS)) * 16 + hi * 8) * 2); \
      const s16x4 xl = tr_read<(T) * 8192 + (KS) * 2048>(vbx_y), xh = tr_read<(T) * 8192 + (KS) * 2048 + 1024>(vbx_y); \
      const s16x4 al = tr_read<(T) * 8192 + (KS) * 2048>(vbx_s), ah = tr_read<(T) * 8192 + (KS) * 2048 + 1024>(vbx_s); \
      const s16x4 wl = tr_read<(T) * 16384 + (KS) * 4096>(vbw_s), wh = tr_read<(T) * 16384 + (KS) * 4096 + 2048>(vbw_s); \
      asm volatile("s_waitcnt lgkmcnt(0)" ::: "memory"); __builtin_amdgcn_sched_barrier(0); \
      y = mfma32(gv, PK_(xl, xh), y); S = mfma32(PK_(al, ah), PK_(wl, wh), S); } while (0)
      SSD_STEP(0, 0); SSD_STEP(0, 1); SSD_STEP(0, 2); SSD_STEP(0, 3); SSD_STEP(1, 0); SSD_STEP(1, 1); SSD_STEP(1, 2); SSD_STEP(1, 3);
#undef SSD_STEP
#undef PK_
    }
#pragma unroll
    for (int r = 0; r < 16; ++r) { const int i = y_it * 32 + crow(r, hi); const int prow = base + (dir ? 127 - i : i);
      Y[(unsigned)(prow * 512 + h * 64 + y_pt * 32 + l31)] = f2bf(y[r]); }
  }
#undef SSD_LOAD
#undef SSD_BASE
}

__device__ __forceinline__ void sgu_item(const Params& p, int layer, int chunk, char* lds) {
  char* ws = p.ws;
  const int tid = otid(), wid = tid >> 6, lane = tid & 63, l31 = lane & 31, hi = lane >> 5;
  const bf16_t* P = (const bf16_t*)(ws + WS_P); bf16_t* SG = (bf16_t*)(ws + WS_SGUO);
  const int r0 = chunk * 128;
  float* sR = (float*)(lds + 69632);
  __syncthreads();
  { const int row = tid >> 2, q = tid & 3; const bf16_t* pr = P + (size_t)(r0 + row) * PLD + OFF_SGU + 512 + q * 128; float ss = 0.f;
    for (int c = 0; c < 16; ++c) { float f[8]; unpack8(*reinterpret_cast<const u32x4*>(pr + c * 8), f);
#pragma unroll
      for (int e = 0; e < 8; ++e) { float g = gelu_f(f[e]); ss += g * g; } }
    ss += __shfl_xor(ss, 1); ss += __shfl_xor(ss, 2);
    if (q == 0) sR[row] = rsqrtf(ss * (1.f / 512.f) + EPS); }
  __syncthreads();
  const int it = wid >> 1, dt0 = (wid & 1) * 2;
  for (int g = 0; g < 4; ++g) {
    const float* wsrc = p.sgu_w + ((size_t)layer * 4 + g) * 128 * 128;
#pragma unroll
    for (int e = 0; e < 8; ++e) { int id = tid + e * NTHR; int i = id >> 5, j4 = (id & 31) * 4; float4 v = *reinterpret_cast<const float4*>(wsrc + i * 128 + j4);
      u32x2 w = {cvtpk(v.x, v.y), cvtpk(v.z, v.w)}; *reinterpret_cast<u32x2*>(lds + i * 272 + j4 * 2) = w; }
#pragma unroll
    for (int e = 0; e < 4; ++e) { int id = tid + e * NTHR; int j = id >> 4, c = id & 15; float f[8];
      unpack8(*reinterpret_cast<const u32x4*>(P + (size_t)(r0 + j) * PLD + OFF_SGU + 512 + g * 128 + c * 8), f);
      const float rs = sR[j]; bf16_t* bt = (bf16_t*)(lds + 34816);
#pragma unroll
      for (int q = 0; q < 8; ++q) { const int d = c * 8 + q; bt[d * 136 + j] = f2bf(gelu_f(f[q]) * rs * p.sgu_norm[layer * 512 + g * 128 + d]); } }
    __syncthreads();
    f32x16 acc[2];
#pragma unroll
    for (int r = 0; r < 16; ++r) { acc[0][r] = 0.f; acc[1][r] = 0.f; }
#pragma unroll
    for (int s = 0; s < 8; ++s) { const int co = (s * 16 + hi * 8) * 2;
      bf16x8 av = *reinterpret_cast<const bf16x8*>(lds + (it * 32 + l31) * 272 + co);
#pragma unroll
      for (int u = 0; u < 2; ++u) { bf16x8 bv = *reinterpret_cast<const bf16x8*>(lds + 34816 + ((dt0 + u) * 32 + l31) * 272 + co); acc[u] = mfma32(av, bv, acc[u]); } }
#pragma unroll
    for (int u = 0; u < 2; ++u)
#pragma unroll
      for (int r = 0; r < 16; ++r) { const int i = it * 32 + crow(r, hi); const int d = (dt0 + u) * 32 + l31;
        const float uu = gelu_f(bf2f(P[(size_t)(r0 + i) * PLD + OFF_SGU + g * 128 + d]));
        SG[(size_t)(r0 + i) * 512 + g * 128 + d] = f2bf(uu * (acc[u][r] + p.sgu_b[((size_t)layer * 4 + g) * 128 + i])); }
    __syncthreads();
  }
}

__device__ __forceinline__ void phase_mixers(const Params& p, int layer, char* lds, int rep) {
  char* ws = p.ws;
  volatile int* s_item_p = (volatile int*)(lds + LDS_BYTES + 8);
#define s_item (*s_item_p)
  int* cbase = (int*)(ws + WS_CTR) + 16 + (layer * 2 + rep) * 10;
  const int xq = blockIdx.x & 7;
  const int n_attc = layer == 0 ? 16 : 0, n_sgu = layer == 0 ? 132 : 128;
  float* ML = (float*)(ws + WS_ML);
  int stage = 0, kq = 0;
  for (;;) {
    __syncthreads();
    if (threadIdx.x == 0) s_item = atomicAdd(cbase + (stage == 0 ? 0 : (stage == 2 ? 1 : 2 + ((xq + kq) & 7))), 1);
    __syncthreads();
    int it = s_item;
    if (stage == 0) { if (it < 32) ssd_item(p, layer, it, lds); else stage = 1; continue; }
    if (stage == 1) {
      if (it >= 128) { if (++kq == 8) stage = 2; continue; }
      const int q = (xq + kq) & 7;
      const int bh = q + 8 * (it >> 6), sp = (it >> 5) & 1, qb = it & 31, b = bh >> 3, h = bh & 7;
      const size_t t0 = (size_t)b * SEQ + qb * 256;
      attn_item((const bf16_t*)(ws + WS_Q) + ((size_t)bh * SEQ + qb * 256) * 192, (const bf16_t*)(ws + WS_K) + ((size_t)bh * NKEYS + sp * (NKEYS / 2)) * 192,
                (const bf16_t*)(ws + WS_V) + ((size_t)bh * NKEYS + sp * (NKEYS / 2)) * 128, NKEYS / 2,
                (bf16_t*)(ws + (sp ? WS_ATT1 : WS_ATT)) + t0 * 1024 + h * 128, ML + ((size_t)sp * T_ALL + t0) * 16 + h * 2, lds);
      continue; }
    if (it >= n_attc + n_sgu) break;
    if (it < n_attc) {
      const int bh = it, b = bh >> 3, h = bh & 7; const size_t t0 = (size_t)T_LAT + b * CTXL;
      attn_item((const bf16_t*)(ws + WS_QC) + (size_t)bh * CTXL * 192, (const bf16_t*)(ws + WS_K) + (size_t)bh * NKEYS * 192,
                (const bf16_t*)(ws + WS_V) + (size_t)bh * NKEYS * 128, CTXL, (bf16_t*)(ws + WS_ATT) + t0 * 1024 + h * 128, ML + t0 * 16 + h * 2, lds);
      { const int tq = otid(); if (tq < 256) { float z_ = 0.f; asm volatile("" : "+v"(z_)); float* mp = ML + ((size_t)T_ALL + t0 + tq) * 16 + h * 2; mp[0] = z_; mp[1] = z_; } }
      continue; }
    sgu_item(p, layer, it - n_attc, lds);
  }
#undef s_item
}

__device__ __forceinline__ void phase_cat(const Params& p, int layer, int nrows) {
  char* ws = p.ws;
  const int tid = otid(), lane = tid & 63, wid = tid >> 6;
  const bf16_t* ATT = (const bf16_t*)(ws + WS_ATT); const bf16_t* SG = (const bf16_t*)(ws + WS_SGUO);
  const bf16_t* YF = (const bf16_t*)(ws + WS_YF); const bf16_t* YB = (const bf16_t*)(ws + WS_YB);
  const bf16_t* XBC = (const bf16_t*)(ws + WS_XBC); const bf16_t* P = (const bf16_t*)(ws + WS_P);
  bf16_t* CAT = (bf16_t*)(ws + WS_H);
  const float* an = p.attn_out_norm + layer * 1024; const float* gn = p.gmlp_out_norm + layer * 512; const float* sn = p.ssd_norm + layer * 512;
  for (int t = blockIdx.x * 8 + wid; t < nrows; t += gridDim.x * 8) {
    float a0[8], a1[8], sg[8], y[8];
    unpack8(*reinterpret_cast<const u32x4*>(ATT + (size_t)t * 1024 + lane * 8), a0);
    unpack8(*reinterpret_cast<const u32x4*>(ATT + (size_t)t * 1024 + 512 + lane * 8), a1);
    {
      const float* ML = (const float*)(ws + WS_ML); const bf16_t* ATT1 = (const bf16_t*)(ws + WS_ATT1);
#pragma unroll
      for (int hh = 0; hh < 2; ++hh) { const int h = hh * 4 + (lane >> 4);
        const float m0 = ML[((size_t)t) * 16 + h * 2], l0 = ML[((size_t)t) * 16 + h * 2 + 1];
        const float m1 = ML[((size_t)T_ALL + t) * 16 + h * 2], l1 = ML[((size_t)T_ALL + t) * 16 + h * 2 + 1];
        if (l1 > 0.f) { const float M = fmaxf(m0, m1); const float w0 = l0 * __builtin_amdgcn_exp2f(m0 - M), w1 = l1 * __builtin_amdgcn_exp2f(m1 - M);
          const float inv = 1.f / (w0 + w1); float b1[8];
          unpack8(*reinterpret_cast<const u32x4*>(ATT1 + (size_t)t * 1024 + hh * 512 + lane * 8), b1);
          float* av = hh ? a1 : a0;
#pragma unroll
          for (int e = 0; e < 8; ++e) av[e] = (av[e] * w0 + b1[e] * w1) * inv; } } }
    unpack8(*reinterpret_cast<const u32x4*>(SG + (size_t)t * 512 + lane * 8), sg);
    float xs[8], z[8];
    unpack8(*reinterpret_cast<const u32x4*>(XBC + (size_t)t * 1024 + lane * 8), xs);
    unpack8(*reinterpret_cast<const u32x4*>(P + (size_t)t * PLD + OFF_Z + lane * 8), z);
    const float dsk = p.ssd_d[layer * 8 + (lane >> 3)];
    float yf[8], yb[8];
    unpack8(*reinterpret_cast<const u32x4*>(YF + (size_t)t * 512 + lane * 8), yf);
    unpack8(*reinterpret_cast<const u32x4*>(YB + (size_t)t * 512 + lane * 8), yb);
    float sa = 0.f, ssg = 0.f, sy = 0.f;
#pragma unroll
    for (int e = 0; e < 8; ++e) {
      y[e] = (yf[e] + yb[e] + dsk * xs[e]) * silu_f(z[e]);
      sa += a0[e] * a0[e] + a1[e] * a1[e]; ssg += sg[e] * sg[e]; sy += y[e] * y[e];
    }
    sa = wave_sum(sa); ssg = wave_sum(ssg); sy = wave_sum(sy);
    const float ra = rsqrtf(sa * (1.f / 1024.f) + EPS), rg = rsqrtf(ssg * (1.f / 512.f) + EPS), ry = rsqrtf(sy * (1.f / 512.f) + EPS);
#pragma unroll
    for (int e = 0; e < 8; ++e) {
      a0[e] *= ra * an[lane * 8 + e]; a1[e] *= ra * an[512 + lane * 8 + e];
      sg[e] *= rg * gn[lane * 8 + e]; y[e] *= ry * sn[lane * 8 + e];
    }
    bf16_t* cr = CAT + (size_t)t * HLD;
    *reinterpret_cast<u32x4*>(cr + lane * 8) = pack8(a0);
    *reinterpret_cast<u32x4*>(cr + 512 + lane * 8) = pack8(a1);
    *reinterpret_cast<u32x4*>(cr + 1024 + lane * 8) = pack8(sg);
    *reinterpret_cast<u32x4*>(cr + 1536 + lane * 8) = pack8(y);
  }
}

__device__ __forceinline__ void phase_gemm_out(const Params& p, int layer, int nrows, char* lds) {
  char* ws = p.ws;
  float* X = (float*)(ws + WS_X);
  const float* mods = (const float*)(ws + WS_MODS) + (size_t)layer * 3 * 12288 + 2 * DM;
  const float* xin = p.x; const float* cin = p.ctx;
  SchedRes S{ws + WS_H, ws + WS_WOUT, HLD, WLD, DM / 64, nrows > T_LAT ? 16 : 0};
  float* PART = (float*)(ws + WS_PART);
  auto epi = [=](const pg::f32x4 (&acc)[2][2][4][2], const pg::Unit& u, int wr, int wc, int fr, int fq) {
    const float* g1 = mods + mod_idx(u.m0) * 12288;
    const float* xsrc = layer == 0 ? (u.m0 < T_LAT ? xin : cin - (size_t)T_LAT * DM) : X;
    const int row0 = u.m0 + wr * 64 + fr;
#pragma unroll
    for (int bj = 0; bj < 2; ++bj)
#pragma unroll
      for (int n = 0; n < 2; ++n) { const int c = u.n0 + bj * 128 + wc * 32 + n * 16 + 4 * fq;
        const pg::f32x4 g = *reinterpret_cast<const pg::f32x4*>(g1 + c);
#pragma unroll
        for (int ai = 0; ai < 2; ++ai)
#pragma unroll
          for (int m = 0; m < 4; ++m) { const size_t o = (size_t)(row0 + ai * 128 + m * 16) * DM + c;
            if (u.tag) *reinterpret_cast<pg::f32x4*>(PART + o + (size_t)((u.tag - 1) * 512 - T_LAT) * DM) = acc[ai][bj][m][n];
            else { const pg::f32x4 xo = *reinterpret_cast<const pg::f32x4*>(xsrc + o);
              *reinterpret_cast<pg::f32x4*>(X + o) = xo + g * acc[ai][bj][m][n]; } } }
  };
  pg::gemm_phase<false>((LAS unsigned char*)lds, HLD, WLD, S, epi);
}

struct SchedFFN1 {
  const char* H2; const char* W; int MT;
  __device__ __forceinline__ bool next(int i, pg::Unit& u) const {
    int mt, ntl; if (!tile_of(i, MT, 44, mt, ntl)) return false;
    u.m0 = mt * 254 - 1; u.n0 = ntl * 256; u.a = H2 + (long)u.m0 * (HLD * 2); u.b = W + (size_t)u.n0 * WLD * 2; u.nt = DM / 64; u.tag = 0; return true; }
};
__device__ __forceinline__ float dpp_ror1(float v) { return __int_as_float(__builtin_amdgcn_update_dpp(0, __float_as_int(v), 0x121, 0xf, 0xf, false)); }
__device__ __forceinline__ float dpp_ror15(float v) { return __int_as_float(__builtin_amdgcn_update_dpp(0, __float_as_int(v), 0x12f, 0xf, 0xf, false)); }
__device__ __forceinline__ void phase_gemm_ffn1(const Params& p, int layer, int nrows, char* lds) {
  char* ws = p.ws;
  bf16_t* ACT = (bf16_t*)(ws + WS_ACT);
  const float* cw = p.ffn_conv_w + (size_t)layer * 3 * FFN; const float* cb = p.ffn_conv_b + (size_t)layer * FFN;
  SchedFFN1 S{ws + WS_H, ws + WS_WGU, (nrows + 253) / 254};
  float* EX = (float*)(lds + 131072);
  auto epi = [=](const pg::f32x4 (&acc)[2][2][4][2], const pg::Unit& u, int wr, int wc, int fr, int fq) {
    const int ccb = 32 * wc + 8 * fq;
#pragma unroll
    for (int ai = 0; ai < 2; ++ai) { const int q = 2 * ai + wr;
      if (fr == 0) {
#pragma unroll
        for (int n = 0; n < 2; ++n) *reinterpret_cast<pg::f32x4*>(EX + (q * 2 + 0) * 128 + ccb + 4 * n) = acc[ai][0][0][n]; }
      if (fr == 15) {
#pragma unroll
        for (int n = 0; n < 2; ++n) *reinterpret_cast<pg::f32x4*>(EX + (q * 2 + 1) * 128 + ccb + 4 * n) = acc[ai][0][3][n]; } }
    asm volatile("s_waitcnt lgkmcnt(0)" ::: "memory");
    __builtin_amdgcn_s_barrier(); asm volatile("" ::: "memory");
    __builtin_amdgcn_s_barrier(); asm volatile("" ::: "memory");
    const int ch0 = (u.n0 >> 1) + ccb;
#pragma unroll
    for (int n = 0; n < 2; ++n) {
      const pg::f32x4 w0 = *reinterpret_cast<const pg::f32x4*>(cw + ch0 + 4 * n), w1 = *reinterpret_cast<const pg::f32x4*>(cw + FFN + ch0 + 4 * n);
      const pg::f32x4 w2 = *reinterpret_cast<const pg::f32x4*>(cw + 2 * FFN + ch0 + 4 * n), bb = *reinterpret_cast<const pg::f32x4*>(cb + ch0 + 4 * n);
#pragma unroll
      for (int ai = 0; ai < 2; ++ai) { const int q = 2 * ai + wr;
        float o[4][4]; bool zp[4], zn[4];
#pragma unroll
        for (int m = 0; m < 4; ++m) { const int t = u.m0 + 128 * ai + 64 * wr + 16 * m + fr; const bool tv = t >= 0 && t < nrows;
          zp[m] = !tv || seq_start(t); zn[m] = !tv || seq_end(t); }
#pragma unroll
        for (int j = 0; j < 4; ++j) {
          float R[4], L[4];
#pragma unroll
          for (int m = 0; m < 4; ++m) { R[m] = dpp_ror1(acc[ai][0][m][n][j]); L[m] = dpp_ror15(acc[ai][0][m][n][j]); }
          const float exp_ = q > 0 ? EX[((q - 1) * 2 + 1) * 128 + ccb + 4 * n + j] : 0.f;
          const float exn_ = q < 3 ? EX[((q + 1) * 2 + 0) * 128 + ccb + 4 * n + j] : 0.f;
#pragma unroll
          for (int m = 0; m < 4; ++m) {
            float pv = fr > 0 ? R[m] : (m > 0 ? R[m > 0 ? m - 1 : 0] : exp_);
            float nv = fr < 15 ? L[m] : (m < 3 ? L[m < 3 ? m + 1 : 3] : exn_);
            pv = zp[m] ? 0.f : pv; nv = zn[m] ? 0.f : nv;
            const float cv = bb[j] + w0[j] * pv + w1[j] * acc[ai][0][m][n][j] + w2[j] * nv;
            o[m][j] = cv * __builtin_amdgcn_rcpf(1.f + __builtin_amdgcn_exp2f(-1.4426950408889634f * cv)) * acc[ai][1][m][n][j];
          } }
#pragma unroll
        for (int m = 0; m < 4; ++m) { const int e = 128 * ai + 64 * wr + 16 * m + fr; const int t = u.m0 + e;
          if (e >= 1 && e <= 254 && t < nrows) { u32x2 w = {cvtpk(o[m][0], o[m][1]), cvtpk(o[m][2], o[m][3])}; *reinterpret_cast<u32x2*>(ACT + (size_t)t * FFN + ch0 + 4 * n) = w; } }
        __builtin_amdgcn_sched_barrier(0);
      }
    }
  };
  pg::gemm_phase<true>((LAS unsigned char*)lds, HLD, WLD, S, epi);
}

__device__ __forceinline__ void phase_gemm_down(const Params& p, int layer, int nrows, char* lds) {
  char* ws = p.ws;
  float* X = (float*)(ws + WS_X); float* out = p.out;
  const float* mods = (const float*)(ws + WS_MODS) + (size_t)layer * 3 * 12288 + 5 * DM;
  SchedRes S{ws + WS_ACT, ws + WS_WDN, FFN, FFN, FFN / 64, nrows > T_LAT ? 16 : 0};
  float* PART = (float*)(ws + WS_PART);
  auto epi = [=](const pg::f32x4 (&acc)[2][2][4][2], const pg::Unit& u, int wr, int wc, int fr, int fq) {
    const float* g2 = mods + mod_idx(u.m0) * 12288;
    float* dst = layer == 0 ? X : out;
    const int row0 = u.m0 + wr * 64 + fr;
#pragma unroll
    for (int bj = 0; bj < 2; ++bj)
#pragma unroll
      for (int n = 0; n < 2; ++n) { const int c = u.n0 + bj * 128 + wc * 32 + n * 16 + 4 * fq;
        const pg::f32x4 g = *reinterpret_cast<const pg::f32x4*>(g2 + c);
#pragma unroll
        for (int ai = 0; ai < 2; ++ai)
#pragma unroll
          for (int m = 0; m < 4; ++m) { const size_t o = (size_t)(row0 + ai * 128 + m * 16) * DM + c;
            if (u.tag) *reinterpret_cast<pg::f32x4*>(PART + o + (size_t)((u.tag - 1) * 512 - T_LAT) * DM) = acc[ai][bj][m][n];
            else { const pg::f32x4 xo = *reinterpret_cast<const pg::f32x4*>(X + o);
              *reinterpret_cast<pg::f32x4*>(dst + o) = xo + g * acc[ai][bj][m][n]; } } }
  };
  pg::gemm_phase<false>((LAS unsigned char*)lds, FFN, FFN, S, epi);
}

#ifndef DBG_NAN
#define DBG_NAN 0
#endif
#if DBG_NAN
__device__ __forceinline__ void nan_scan(const Params& p, size_t off, size_t n, int isbf, int code) {
  int* flags = (int*)(p.ws + WS_CTR) + 8;
  const char* base = p.ws + off; bool bad = false;
  for (size_t i = (size_t)blockIdx.x * NTHR + threadIdx.x; i < n; i += (size_t)gridDim.x * NTHR) {
    float v = isbf ? bf2f(((const bf16_t*)base)[i]) : ((const float*)base)[i];
    if (!(fabsf(v) < 1e30f)) bad = true;
  }
  if (bad) atomicMin(flags, code);
}
__device__ __forceinline__ void dbg_scan(const Params& p, int ph) {
  const int k = (ph + 1) * 10;
  if (ph == 0) { nan_scan(p, WS_MODS, 2 * 3 * 12288, 0, k); nan_scan(p, WS_ROPE, 4096, 0, k + 1); nan_scan(p, WS_WIN, (size_t)49152000, 1, k + 2); return; }
  const int layer = (ph - 1) / 10, s = (ph - 1) % 10; const size_t nr = layer == 0 ? T_ALL : T_LAT;
  switch (s) {
    case 0: nan_scan(p, WS_H, (size_t)T_ALL * DM, 1, k); break;
    case 1: nan_scan(p, WS_P, (size_t)T_ALL * PLD, 1, k); nan_scan(p, WS_DT, (size_t)T_ALL * 16, 0, k + 1); break;
    case 2: nan_scan(p, WS_QRAW, (size_t)T_ALL * 1536, 1, k); nan_scan(p, WS_KVRAW, (size_t)T_ALL * 2048, 1, k + 1); nan_scan(p, WS_RSTD, (size_t)T_ALL * 2, 0, k + 2);
            nan_scan(p, WS_XBC, (size_t)T_ALL * 1024, 1, k + 3); nan_scan(p, WS_DT, (size_t)T_ALL * 16, 0, k + 4); break;
    case 3: nan_scan(p, WS_Q, (size_t)16 * SEQ * 192, 1, k); nan_scan(p, WS_K, (size_t)16 * NKEYS * 192, 1, k + 1); nan_scan(p, WS_V, (size_t)16 * NKEYS * 128, 1, k + 2); break;
    case 4: nan_scan(p, WS_ATT, (size_t)T_LAT * 1024, 1, k); nan_scan(p, WS_SGUO, (size_t)T_LAT * 512, 1, k + 1); nan_scan(p, WS_YF, (size_t)T_ALL * 512, 0, k + 2); nan_scan(p, WS_YB, (size_t)T_ALL * 512, 0, k + 3); break;
    case 5: nan_scan(p, WS_H, nr * DM, 1, k); break;
    case 6: nan_scan(p, WS_X, nr * DM, 0, k); break;
    case 7: nan_scan(p, WS_H, nr * DM, 1, k); break;
    case 8: nan_scan(p, WS_ACT, nr * FFN, 1, k); break;
    default: if (layer == 0) nan_scan(p, WS_X, nr * DM, 0, k); break;
  }
}
#endif
typedef const __attribute__((address_space(4))) Params* KArgP;
__device__ __forceinline__ Params load_params() {
#if defined(__HIP_DEVICE_COMPILE__)
  KArgP q = (KArgP)__builtin_amdgcn_kernarg_segment_ptr(); asm volatile("" : "+s"(q));
  Params r; __builtin_memcpy(&r, q, sizeof(Params)); return r;
#else
  return Params{};
#endif
}
__device__ __forceinline__ void run_phase(int ph, char* lds, int rep) {
  if (ph == 0) { const Params p = load_params(); phase_prep(p, lds); return; }
  const int layer = (ph - 1) / 10, s = (ph - 1) % 10;
  const int nrows2 = layer == 0 ? T_ALL : T_LAT;
  switch (s) {
    case 0: { const Params p = load_params(); phase_norm_mod(p, layer, 0, T_ALL); if (layer == 1) convert_weights(p, 1, lds); } break;
    case 1: { const Params p = load_params(); phase_gemm_in(p, lds); } break;
    case 2: { const Params p = load_params(); phase_qkv_gemm_and_post(p, layer, lds); } break;
    case 3: { const Params p = load_params(); phase_build_qkv(p, layer); } break;
    case 4: { const Params p = load_params(); phase_mixers(p, layer, lds, rep); } break;
    case 5: { const Params p = load_params(); phase_cat(p, layer, nrows2); } break;
    case 6: { const Params p = load_params(); phase_gemm_out(p, layer, nrows2, lds); } break;
    case 7: { const Params p = load_params(); phase_norm_mod(p, layer, 1, nrows2); } break;
    case 8: { const Params p = load_params(); phase_gemm_ffn1(p, layer, nrows2, lds); } break;
    default: { const Params p = load_params(); phase_gemm_down(p, layer, nrows2, lds); } break;
  }
}

__global__ void __launch_bounds__(NTHR) mega_fwd(Params p) {
  extern __shared__ __attribute__((aligned(16))) char lds[];
#if MULTI_LAUNCH
  run_phase((int)p.ph_lo, lds, 0);
#else
  cg::grid_group grid = cg::this_grid();
  unsigned* bar_st = (unsigned*)(lds + LDS_BYTES);
  if (threadIdx.x < 4) bar_st[threadIdx.x] = 0u;
  __syncthreads();
  XcdBarrier xb = xcd_barrier_post((unsigned*)(p.ws + WS_BAR), (volatile LAS unsigned*)bar_st);
  for (int ph = 0; ph < 21; ++ph) {
#if REPEAT_MASK
    if (ph > 0 && ((REPEAT_MASK >> ((ph - 1) % 10)) & 1)) { run_phase(ph, lds, 1); xcd_barrier(xb); }
#endif
    run_phase(ph, lds, 0);
    if (ph == 0) grid.sync();
    else if (ph + 1 < 21) xcd_barrier(xb);
  }
#endif
}


#if DBG_NAN
__global__ void __launch_bounds__(NTHR) dbg_init_k(Params p) { ((int*)(p.ws + WS_CTR))[8] = 100000; }
__global__ void __launch_bounds__(NTHR) dbg_scan_k(Params p) { dbg_scan(p, (int)p.ph_lo); }
__global__ void __launch_bounds__(NTHR) dbg_report_k(Params p) {
  int code = ((int*)(p.ws + WS_CTR))[8];
  if (code < 100000) { float e = (float)(code / 10) * 0.5f; float c = sqrtf(1.27f) * __powf(10.f, e) * (1.f + 0.1f * (float)(code % 10));
    for (size_t i = (size_t)blockIdx.x * NTHR + threadIdx.x; i < (size_t)T_LAT * DM; i += (size_t)gridDim.x * NTHR) p.out[i] = c; }
}
#endif
extern "C" void kernel_launch(void* const* d_in, const int* in_sizes, int n_in, void* d_out, int out_size, void* d_ws, size_t ws_size, hipStream_t stream) {
  static int grid_blocks = 0;
  if (grid_blocks == 0) {
    if (n_in != 32 || out_size != T_LAT * DM || ws_size < WS_END) {
      fprintf(stderr, "kernel_launch: bad shapes: n_in %d out %d ws %zu (need %zu)\n", n_in, out_size, ws_size, (size_t)WS_END); grid_blocks = -1; return; }
    int dev = 0, cus = 0, per_cu = 0;
    hipGetDevice(&dev); hipDeviceGetAttribute(&cus, hipDeviceAttributeMultiprocessorCount, dev);
    hipFuncSetAttribute((const void*)mega_fwd, hipFuncAttributeMaxDynamicSharedMemorySize, LDS_DYN);
    hipOccupancyMaxActiveBlocksPerMultiprocessor(&per_cu, (const void*)mega_fwd, NTHR, LDS_DYN);
    if (per_cu < 1) { fprintf(stderr, "kernel_launch: occupancy query says %d blocks/CU\n", per_cu); per_cu = 1; }
    grid_blocks = cus * per_cu;
  }
  if (grid_blocks < 0) return;
  Params p{};
  const float** pp = (const float**)&p;
  for (int i = 0; i < 32; ++i) pp[i] = (const float*)d_in[i];
  p.out = (float*)d_out; p.ws = (char*)d_ws; p.ph_lo = 0; p.ph_hi = 21;
#if MULTI_LAUNCH
  for (int ph = 0; ph < 21; ++ph) { p.ph_lo = ph; p.ph_hi = ph + 1; hipLaunchKernelGGL(mega_fwd, dim3(grid_blocks), dim3(NTHR), LDS_DYN, stream, p);
#if DBG_NAN
    if (ph == 0) hipLaunchKernelGGL(dbg_init_k, dim3(1), dim3(1), 0, stream, p);
    hipLaunchKernelGGL(dbg_scan_k, dim3(grid_blocks), dim3(NTHR), 0, stream, p);
#endif
  }
#if DBG_NAN
  hipLaunchKernelGGL(dbg_report_k, dim3(grid_blocks), dim3(NTHR), 0, stream, p);
#endif
#else
  hipMemsetAsync((char*)d_ws + WS_BAR, 0, XCD_BAR_WORDS * 4, stream);
  void* args[] = {&p};
  hipError_t e = hipLaunchCooperativeKernel((const void*)mega_fwd, dim3(grid_blocks), dim3(NTHR), args, LDS_DYN, stream);
  if (e != hipSuccess) fprintf(stderr, "cooperative launch failed: %s (grid %d)\n", hipGetErrorString(e), grid_blocks);
#endif
}
```

```cpp
#include <hip/hip_runtime.h>
#include <hip/hip_cooperative_groups.h>
#include <cstdio>
#include <cstdint>
namespace cg = cooperative_groups;

#ifndef REPEAT_MASK
#define REPEAT_MASK 0
#endif
#ifndef MULTI_LAUNCH
#define MULTI_LAUNCH 0
#endif

typedef unsigned short bf16_t;
using bf16x8 = __attribute__((ext_vector_type(8))) short;
using s16x4  = __attribute__((ext_vector_type(4))) short;
using f32x16 = __attribute__((ext_vector_type(16))) float;
using u32x4  = __attribute__((ext_vector_type(4))) unsigned;
using u32x2  = __attribute__((ext_vector_type(2))) unsigned;

constexpr int NTHR = 512;
constexpr int DM = 2048, SEQ = 8192, CTXL = 256, NB = 2;
constexpr int T_LAT = NB * SEQ;
constexpr int T_ALL = T_LAT + NB * CTXL;
constexpr int PIN = 3920, PLD = 3968, PNP = 4096;
constexpr int OFF_CKV = 768, OFF_KR = 1280, OFF_SGU = 1344, OFF_Z = 2368, OFF_XBC = 2880, OFF_DT = 3904;
constexpr int FFN = 5632;
constexpr int HLD = 2112, WLD = 2112, UKVLD = 768;
constexpr int NKEYS = CTXL + SEQ;
constexpr float EPS = 1e-6f;
constexpr float QSCALE = 0.07216878364870322f * 1.4426950408889634f;

constexpr size_t al256(size_t x) { return (x + 255) / 256 * 256; }
constexpr size_t WS_WIN  = 0;
constexpr size_t WS_WUQ  = WS_WIN  + (size_t)PNP * WLD * 2;
constexpr size_t WS_WUKV = WS_WUQ  + (size_t)1536 * 768 * 2;
constexpr size_t WS_WOUT = WS_WUKV + (size_t)2048 * UKVLD * 2;
constexpr size_t WS_WGU  = WS_WOUT + (size_t)2048 * WLD * 2;
constexpr size_t WS_WDN  = WS_WGU  + (size_t)2 * FFN * WLD * 2;
constexpr size_t WS_X    = WS_WDN  + (size_t)DM * FFN * 2;
constexpr size_t WS_MODS = WS_X    + (size_t)T_ALL * DM * 4;
constexpr size_t WS_ROPE = WS_MODS + (size_t)2 * 3 * 12288 * 4;
constexpr size_t WS_CTR  = WS_ROPE + (size_t)128 * 16 * 2 * 4;
constexpr size_t WS_BAR  = al256(WS_CTR + 256);
constexpr size_t WS_A1   = al256(WS_BAR + 3456 * 4);
constexpr size_t WS_P    = WS_A1;
constexpr size_t WS_DT   = WS_P    + (size_t)T_ALL * PLD * 2;
constexpr size_t WS_RSTD = WS_DT   + (size_t)T_ALL * 16 * 4;
constexpr size_t WS_A2   = al256(WS_RSTD + (size_t)T_ALL * 2 * 4);
constexpr size_t WS_QRAW = WS_A2;
constexpr size_t WS_KVRAW= WS_QRAW + (size_t)T_ALL * 1536 * 2;
constexpr size_t WS_A2END= WS_KVRAW+ (size_t)T_ALL * 2048 * 2;
constexpr size_t WS_ATT  = WS_A2;
constexpr size_t WS_SGUO = WS_ATT  + (size_t)T_ALL * 1024 * 2;
constexpr size_t WS_YF   = WS_SGUO + (size_t)T_ALL * 512 * 2;
constexpr size_t WS_YB   = WS_YF   + (size_t)T_ALL * 512 * 2;
static_assert(WS_YB + (size_t)T_ALL * 512 * 2 <= WS_A2END, "A2 alias overflow");
constexpr size_t WS_XBC  = al256(WS_A2END);
constexpr size_t WS_A4   = al256(WS_XBC + (size_t)T_ALL * 1024 * 2);
constexpr size_t WS_Q    = WS_A4;
constexpr size_t WS_QC   = WS_Q    + (size_t)16 * SEQ * 192 * 2;
constexpr size_t WS_K    = WS_QC   + (size_t)16 * CTXL * 192 * 2;
constexpr size_t WS_V    = WS_K    + (size_t)16 * NKEYS * 192 * 2;
constexpr size_t WS_END0 = al256(WS_V + (size_t)16 * NKEYS * 128 * 2);
constexpr size_t WS_ATT1 = WS_END0;
constexpr size_t WS_ML   = WS_ATT1 + (size_t)T_ALL * 1024 * 2;
constexpr size_t WS_PART = al256(WS_ML + (size_t)2 * T_ALL * 8 * 2 * 4);
constexpr size_t WS_END  = al256(WS_PART + (size_t)4 * 512 * DM * 4);
constexpr size_t WS_H    = WS_A4;
constexpr size_t WS_ACT  = WS_A1;
static_assert(WS_ACT + (size_t)T_ALL * FFN * 2 <= WS_XBC + (size_t)T_ALL * 1024 * 2, "ACT alias overflow");
static_assert((size_t)T_ALL * HLD * 2 <= WS_END - WS_A4, "H alias overflow");

constexpr int LDS_BYTES = 140800;
constexpr int LDS_DYN = LDS_BYTES + 16;

struct Params {
  const float *x, *c, *ctx, *c_ctx, *w_mod, *b_mod, *norm_mix, *norm_ffn, *w_in, *q_a_norm, *w_uq, *kv_a_norm, *w_ukv,
              *q_norm, *k_norm, *attn_out_norm, *sgu_norm, *sgu_w, *sgu_b, *gmlp_out_norm, *ssd_conv_w, *ssd_conv_b,
              *ssd_dt_bias, *ssd_a_log, *ssd_d, *ssd_norm, *w_out, *ffn_w_gate, *ffn_w_up, *ffn_conv_w, *ffn_conv_b, *ffn_w_down;
  float* out; char* ws;
  long long ph_lo, ph_hi;
};

__device__ __forceinline__ int otid() { int t = threadIdx.x; asm volatile("" : "+v"(t)); return t; }
typedef float f32x2_t __attribute__((ext_vector_type(2)));
typedef __bf16 bf16x2_t __attribute__((ext_vector_type(2)));
__device__ __forceinline__ unsigned cvtpk(float lo, float hi) {
  f32x2_t v = {lo, hi}; bf16x2_t r = __builtin_convertvector(v, bf16x2_t);
  return __builtin_bit_cast(unsigned, r);
}
__device__ __forceinline__ bf16_t f2bf(float x) { return __builtin_bit_cast(bf16_t, (__bf16)x); }
__device__ __forceinline__ float bf2f(bf16_t b) { return __uint_as_float(((unsigned)b) << 16); }
__device__ __forceinline__ float bflo(unsigned w) { return __uint_as_float(w << 16); }
__device__ __forceinline__ float bfhi(unsigned w) { return __uint_as_float(w & 0xffff0000u); }
__device__ __forceinline__ void unpack8(u32x4 w, float* f) {
  f[0] = bflo(w[0]); f[1] = bfhi(w[0]); f[2] = bflo(w[1]); f[3] = bfhi(w[1]);
  f[4] = bflo(w[2]); f[5] = bfhi(w[2]); f[6] = bflo(w[3]); f[7] = bfhi(w[3]);
}
__device__ __forceinline__ u32x4 pack8(const float* f) {
  u32x4 w = {cvtpk(f[0], f[1]), cvtpk(f[2], f[3]), cvtpk(f[4], f[5]), cvtpk(f[6], f[7])}; return w;
}
__device__ __forceinline__ float wave_sum(float v) {
  { auto rr = __builtin_amdgcn_permlane32_swap(__float_as_uint(v), __float_as_uint(v), false, false); v = __uint_as_float(rr[0]) + __uint_as_float(rr[1]); }
  { auto rr = __builtin_amdgcn_permlane16_swap(__float_as_uint(v), __float_as_uint(v), false, false); v = __uint_as_float(rr[0]) + __uint_as_float(rr[1]); }
  v += __int_as_float(__builtin_amdgcn_update_dpp(0, __float_as_int(v), 0x128, 0xf, 0xf, false));
  v += __int_as_float(__builtin_amdgcn_update_dpp(0, __float_as_int(v), 0x124, 0xf, 0xf, false));
  v += __int_as_float(__builtin_amdgcn_update_dpp(0, __float_as_int(v), 0x122, 0xf, 0xf, false));
  v += __int_as_float(__builtin_amdgcn_update_dpp(0, __float_as_int(v), 0x121, 0xf, 0xf, false));
  return v;
}
__device__ __forceinline__ float lane_xor16(float v, int lane) {
  auto rr = __builtin_amdgcn_permlane16_swap(__float_as_uint(v), __float_as_uint(v), false, false);
  return __uint_as_float(((lane >> 4) & 1) ? rr[0] : rr[1]);
}
__device__ __forceinline__ float silu_f(float x) { return x * __builtin_amdgcn_rcpf(1.f + __builtin_amdgcn_exp2f(-1.4426950408889634f * x)); }
__device__ __forceinline__ float gelu_f(float x) {
  float u = 0.7978845608028654f * (x + 0.044715f * x * x * x);
  float t = 1.f - 2.f * __builtin_amdgcn_rcpf(__builtin_amdgcn_exp2f(2.8853900817779268f * u) + 1.f);
  return 0.5f * x * (1.f + t);
}
__device__ __forceinline__ int crow(int r, int hi) { return (r & 3) + 8 * (r >> 2) + 4 * hi; }
__device__ __forceinline__ f32x16 mfma32(bf16x8 a, bf16x8 b, f32x16 c) { return __builtin_amdgcn_mfma_f32_32x32x16_bf16(a, b, c, 0, 0, 0); }
__device__ __forceinline__ bool seq_start(int t) { return t < T_LAT ? ((t & (SEQ - 1)) == 0) : (((t - T_LAT) & (CTXL - 1)) == 0); }
__device__ __forceinline__ bool seq_end(int t) { return t < T_LAT ? ((t & (SEQ - 1)) == SEQ - 1) : (((t - T_LAT) & (CTXL - 1)) == CTXL - 1); }
__device__ __forceinline__ int mod_idx(int row) { return row < SEQ ? 0 : (row < T_LAT ? 1 : 2); }

#define XB_TMO      128
#define XB_XCNT(j)  (256  + 64 * (j))
#define XB_XSUB(j)  (1280 + 64 * (j))
#define XB_XGEN(j)  (2304 + 64 * (j))
#define XB_TOP      3328
#define XB_TOPGEN   3392
#define XCD_BAR_WORDS 3456
#define XB_SPIN_CAP (1u << 24)
#define LAS __attribute__((address_space(3)))

__device__ __forceinline__ unsigned xb_ld(unsigned* p)              { return __hip_atomic_load(p, __ATOMIC_RELAXED, __HIP_MEMORY_SCOPE_AGENT); }
__device__ __forceinline__ unsigned xb_add(unsigned* p, unsigned v) { return __hip_atomic_fetch_add(p, v, __ATOMIC_RELAXED, __HIP_MEMORY_SCOPE_AGENT); }
__device__ __forceinline__ unsigned xb_xcc_id() { return (unsigned)__builtin_amdgcn_s_getreg((3 << 11) | 20) & 0xFu; }
#define XB_SPIN(cond, bar) do { unsigned _sp = 0; while (cond) { __builtin_amdgcn_s_sleep(1); \
    if ((++_sp & 255u) == 0u) { if (xb_ld(&(bar)[XB_TMO])) break; if (_sp > XB_SPIN_CAP) { atomicAdd(&(bar)[XB_TMO], 1u); break; } } } } while (0)

struct XcdBarrier {
    unsigned* bar; unsigned x;
    volatile LAS unsigned* st;
};

__device__ __forceinline__ XcdBarrier xcd_barrier_post(unsigned* bar, volatile LAS unsigned* st) {
    XcdBarrier b; b.bar = bar; b.x = xb_xcc_id(); b.st = st;
    if (threadIdx.x == 0) (void)xb_add(&bar[XB_XCNT(b.x)], 1u);
    return b;
}
__device__ __forceinline__ void xcd_barrier_complete(unsigned* bar, unsigned x, unsigned& nloc, unsigned& nx) {
    const unsigned G = gridDim.x * gridDim.y * gridDim.z;
    unsigned sum, cnt, mine, sp = 0u;
    for (;;) {
        sum = 0u; cnt = 0u; mine = 0u;
#pragma unroll
        for (unsigned j = 0; j < 16; ++j) { const unsigned c = xb_ld(&bar[XB_XCNT(j)]); sum += c; cnt += (c > 0u) ? 1u : 0u; mine = (j == x) ? c : mine; }
        if (sum == G) break;
        __builtin_amdgcn_s_sleep(1);
        if ((++sp & 255u) == 0u) { if (xb_ld(&bar[XB_TMO])) break; if (sp > XB_SPIN_CAP) { atomicAdd(&bar[XB_TMO], 1u); break; } }
    }
    nloc = mine > 0u ? mine : 1u; nx = cnt > 0u ? cnt : 1u;
}

__device__ __forceinline__ void xcd_barrier(const XcdBarrier& b) {
    asm volatile("s_waitcnt vmcnt(0)" ::: "memory");
    __syncthreads();
    if (threadIdx.x == 0) {
        unsigned* bar = b.bar;
        __builtin_amdgcn_s_waitcnt(0);
        unsigned nloc = b.st[0], nx = b.st[1];
        if (nloc == 0u) { xcd_barrier_complete(bar, b.x, nloc, nx); b.st[0] = nloc; b.st[1] = nx; }
        const unsigned old = xb_add(&bar[XB_XSUB(b.x)], 1u);
        const unsigned gen = old / nloc;
        if (old + 1u == (gen + 1u) * nloc) {
            __builtin_amdgcn_fence(__ATOMIC_RELEASE, "agent");
            asm volatile("s_waitcnt vmcnt(0)" ::: "memory");
            const unsigned og = xb_add(&bar[XB_TOP], 1u);
            const unsigned tg = og / nx;
            if (og + 1u == (tg + 1u) * nx) xb_add(&bar[XB_TOPGEN], 1u);
            else XB_SPIN(xb_ld(&bar[XB_TOPGEN]) == tg, bar);
            __builtin_amdgcn_fence(__ATOMIC_ACQUIRE, "agent");
            xb_add(&bar[XB_XGEN(b.x)], 1u);
            asm volatile("s_waitcnt vmcnt(0)" ::: "memory");
        } else {
            XB_SPIN(xb_ld(&bar[XB_XGEN(b.x)]) == gen, bar);
            __builtin_amdgcn_fence(__ATOMIC_ACQUIRE, "agent");
            asm volatile("s_waitcnt vmcnt(0)" ::: "memory");
        }
    }
    __syncthreads();
}


__device__ __forceinline__ void convert_tile(const float* __restrict__ src, int K, int N, bf16_t* __restrict__ dst, int ldd, int mode, const float* __restrict__ kscale,
                             int tk, int tn, char* lds) {
  const int tid = otid();
  bf16_t* s = (bf16_t*)lds;
  __syncthreads();
  float v[16];
#pragma unroll
  for (int e = 0; e < 16; ++e) {
    const int id = tid + e * NTHR; const int n = id & 127, k = id >> 7;
    const int gk = tk * 64 + k, gn = tn * 128 + n;
    v[e] = gn < N ? src[(size_t)gk * N + gn] : 0.f;
    if (kscale) v[e] *= kscale[gk];
  }
#pragma unroll
  for (int e = 0; e < 16; ++e) { const int id = tid + e * NTHR; const int n = id & 127, k = id >> 7; s[n * 68 + k] = f2bf(v[e]); }
  __syncthreads();
#pragma unroll
  for (int e = 0; e < 2; ++e) {
    int id = tid + e * NTHR; int n = id >> 3, c = id & 7;
    int gn = tn * 128 + n; int drow;
    if (mode == 0) drow = gn;
    else { drow = (gn >> 7) * 256 + (mode == 2 ? 128 : 0) + (gn & 127); }
    const u32x2 a = *reinterpret_cast<const u32x2*>(s + n * 68 + c * 8), b = *reinterpret_cast<const u32x2*>(s + n * 68 + c * 8 + 4);
    u32x4 w = {a[0], a[1], b[0], b[1]};
    *reinterpret_cast<u32x4*>(dst + (size_t)drow * ldd + tk * 64 + c * 8) = w;
  }
}

__device__ __forceinline__ void convert_weights(const Params& p, int layer, char* lds) {
  char* ws = p.ws;
  const int n_in = 32 * 32, n_uq = 12 * 12, n_ukv = 8 * 16, n_out = 32 * 16, n_g = 32 * 44, n_dn = 88 * 16;
  const int total = n_in + n_uq + n_ukv + n_out + 2 * n_g + n_dn;
  for (int it = blockIdx.x; it < total; it += gridDim.x) {
    int i = it;
    if (i < n_in) { convert_tile(p.w_in + (size_t)layer * DM * PIN, DM, PIN, (bf16_t*)(ws + WS_WIN), WLD, 0, nullptr, i & 31, i >> 5, lds); continue; } i -= n_in;
    if (i < n_uq) { convert_tile(p.w_uq + (size_t)layer * 768 * 1536, 768, 1536, (bf16_t*)(ws + WS_WUQ), 768, 0, p.q_a_norm + layer * 768, i % 12, i / 12, lds); continue; } i -= n_uq;
    if (i < n_ukv) { convert_tile(p.w_ukv + (size_t)layer * 512 * 2048, 512, 2048, (bf16_t*)(ws + WS_WUKV), UKVLD, 0, p.kv_a_norm + layer * 512, i & 7, i >> 3, lds); continue; } i -= n_ukv;
    if (i < n_out) { convert_tile(p.w_out + (size_t)layer * DM * DM, DM, DM, (bf16_t*)(ws + WS_WOUT), WLD, 0, nullptr, i & 31, i >> 5, lds); continue; } i -= n_out;
    if (i < n_g) { convert_tile(p.ffn_w_gate + (size_t)layer * DM * FFN, DM, FFN, (bf16_t*)(ws + WS_WGU), WLD, 1, nullptr, i & 31, i >> 5, lds); continue; } i -= n_g;
    if (i < n_g) { convert_tile(p.ffn_w_up + (size_t)layer * DM * FFN, DM, FFN, (bf16_t*)(ws + WS_WGU), WLD, 2, nullptr, i & 31, i >> 5, lds); continue; } i -= n_g;
    convert_tile(p.ffn_w_down + (size_t)layer * FFN * DM, FFN, DM, (bf16_t*)(ws + WS_WDN), FFN, 0, nullptr, i % 88, i / 88, lds);
  }
}

__device__ __forceinline__ void sincos_small(float x, float& s, float& c) {
  float kf = rintf(x * 0.6366197723675814f); int k = (int)kf;
  float r = fmaf(-kf, 1.5707963705062866f, x); r = fmaf(-kf, -4.371139000186241e-8f, r);
  float r2 = r * r;
  float sp = r + r * r2 * (-1.6666654611e-1f + r2 * (8.3321608736e-3f + r2 * (-1.9515295891e-4f)));
  float cp = 1.f + r2 * (-0.5f + r2 * (4.166664568298827e-2f + r2 * (-1.388731625493765e-3f + r2 * 2.443315711809948e-5f)));
  int q = k & 3;
  float ss = (q & 1) ? cp : sp, cc = (q & 1) ? sp : cp;
  s = (q & 2) ? -ss : ss; c = ((q + 1) & 2) ? -cc : cc;
}

__device__ __forceinline__ void phase_prep(const Params& p, char* lds) {
  const int tid = otid(), lane = tid & 63, wid = tid >> 6;
  char* ws = p.ws;
  if (blockIdx.x == 0) {
    int* ctr = (int*)(ws + WS_CTR);
    if (tid < 64) ctr[tid] = 0;
    float* rope = (float*)(ws + WS_ROPE);
    for (int i = tid; i < 128 * 16; i += NTHR) {
      int pos = i >> 4, j = i & 15;
      float freq = exp2f(-(float)j * (13.287712379549449f / 16.f));
      float ang = (float)pos * freq; float s, c; sincos_small(ang, s, c);
      rope[i * 2] = c; rope[i * 2 + 1] = s;
    }
  }
  float* sc = (float*)lds;
  float* red = sc + 3 * 2048;
  __syncthreads();
  for (int i = tid; i < 3 * 2048; i += NTHR) {
    int j = i >> 11, k = i & 2047;
    float v = (j < 2) ? p.c[j * DM + k] : p.c_ctx[k];
    sc[i] = silu_f(v);
  }
  __syncthreads();
  float* mods = (float*)(ws + WS_MODS);
  for (int it = blockIdx.x; it < 2 * 192; it += gridDim.x) {
    int layer = it / 192, cg_ = it % 192; int n = cg_ * 64 + lane;
    const float* w = p.w_mod + (size_t)layer * DM * 12288 + n;
    float a0 = 0.f, a1 = 0.f, a2 = 0.f;
    int k0 = wid * 256;
    for (int kb = k0; kb < k0 + 256; kb += 32) {
      float wv[32];
#pragma unroll
      for (int u = 0; u < 32; ++u) wv[u] = w[(size_t)(kb + u) * 12288];
#pragma unroll
      for (int u = 0; u < 32; ++u) { a0 = fmaf(sc[kb + u], wv[u], a0); a1 = fmaf(sc[2048 + kb + u], wv[u], a1); a2 = fmaf(sc[4096 + kb + u], wv[u], a2); }
    }
    red[(wid * 3 + 0) * 64 + lane] = a0; red[(wid * 3 + 1) * 64 + lane] = a1; red[(wid * 3 + 2) * 64 + lane] = a2;
    __syncthreads();
    if (tid < 192) {
      int j = tid >> 6, l = tid & 63; float s = 0.f;
#pragma unroll
      for (int w8 = 0; w8 < 8; ++w8) s += red[(w8 * 3 + j) * 64 + l];
      int nn = cg_ * 64 + l;
      mods[(size_t)(layer * 3 + j) * 12288 + nn] = s + p.b_mod[layer * 12288 + nn];
    }
    __syncthreads();
  }
  convert_weights(p, 0, lds);
}

__device__ __forceinline__ void phase_norm_mod(const Params& p, int layer, int which, int nrows) {
  const int tid = otid(), lane = tid & 63, wid = tid >> 6;
  char* ws = p.ws;
  const float* gain = (which ? p.norm_ffn : p.norm_mix) + layer * DM;
  const float* mods = (const float*)(ws + WS_MODS) + (size_t)layer * 3 * 12288;
  const float* X = (const float*)(ws + WS_X);
  bf16_t* H = (bf16_t*)(ws + WS_H);
  for (int row = blockIdx.x * 8 + wid; row < nrows; row += gridDim.x * 8) {
    const float* src = (layer == 0 && which == 0) ? (row < T_LAT ? p.x + (size_t)row * DM : p.ctx + (size_t)(row - T_LAT) * DM) : X + (size_t)row * DM;
    const float* sh = mods + mod_idx(row) * 12288 + (which ? 3 : 0) * DM; const float* scl = sh + DM;
    float4 v[8]; float ss = 0.f;
    const bool comb = row >= T_LAT && ((layer == 0 && which == 1) || (layer == 1 && which == 0));
    if (comb) { src = which ? p.ctx + (size_t)(row - T_LAT) * DM : X + (size_t)row * DM; }
    const float* gate = (const float*)(ws + WS_MODS) + 2 * 12288 + (which ? 2 : 5) * DM;
    const float* part = (const float*)(ws + WS_PART) + (size_t)(row - T_LAT) * DM;
#pragma unroll
    for (int i = 0; i < 8; ++i) { v[i] = reinterpret_cast<const float4*>(src)[i * 64 + lane];
      if (comb) { const int n4 = i * 64 + lane; const float4 g4 = reinterpret_cast<const float4*>(gate)[n4];
        float4 s4 = reinterpret_cast<const float4*>(part)[n4];
#pragma unroll
        for (int q = 1; q < 4; ++q) { const float4 t4 = reinterpret_cast<const float4*>(part + (size_t)q * 512 * DM)[n4]; s4.x += t4.x; s4.y += t4.y; s4.z += t4.z; s4.w += t4.w; }
        v[i].x += g4.x * s4.x; v[i].y += g4.y * s4.y; v[i].z += g4.z * s4.z; v[i].w += g4.w * s4.w;
        if (which) reinterpret_cast<float4*>((float*)(ws + WS_X) + (size_t)row * DM)[n4] = v[i]; }
      ss += v[i].x * v[i].x + v[i].y * v[i].y + v[i].z * v[i].z + v[i].w * v[i].w; }
    ss = wave_sum(ss);
    float rstd = rsqrtf(ss * (1.f / DM) + EPS);
#pragma unroll
    for (int i = 0; i < 8; ++i) {
      int n = (i * 64 + lane) * 4;
      float4 g = *reinterpret_cast<const float4*>(gain + n), s4 = *reinterpret_cast<const float4*>(scl + n), h4 = *reinterpret_cast<const float4*>(sh + n);
      float y0 = v[i].x * rstd * g.x * (1.f + s4.x) + h4.x, y1 = v[i].y * rstd * g.y * (1.f + s4.y) + h4.y;
      float y2 = v[i].z * rstd * g.z * (1.f + s4.z) + h4.z, y3 = v[i].w * rstd * g.w * (1.f + s4.w) + h4.w;
      u32x2 o = {cvtpk(y0, y1), cvtpk(y2, y3)};
      *reinterpret_cast<u32x2*>(H + (size_t)row * HLD + n) = o;
    }
  }
}

template <int NTW, class Epi>
__device__ __forceinline__ void gemm_tile(const bf16_t* __restrict__ A, int lda, int arow0, int amax,
                                          const bf16_t* __restrict__ Bt, int ldb, int K, char* lds, Epi epi) {
  constexpr int NBL = 2 * NTW;
  constexpr int ABYTES = 256 * 128, BBYTES = 128 * NTW * 128, STAGE = ABYTES + BBYTES;
  const int tid = otid(), lane = tid & 63, wid = tid >> 6, l31 = lane & 31, hi = lane >> 5;
  const int wm = wid >> 2, wn = wid & 3;
  f32x16 acc[4][NTW];
#pragma unroll
  for (int i = 0; i < 4; ++i)
#pragma unroll
    for (int j = 0; j < NTW; ++j)
#pragma unroll
      for (int r = 0; r < 16; ++r) acc[i][j][r] = 0.f;
  const int lc = tid & 7, lr = tid >> 3;
  unsigned aoff[4], boff[NBL];
#pragma unroll
  for (int i = 0; i < 4; ++i) { int gr = arow0 + lr + 64 * i; gr = gr < 0 ? 0 : (gr > amax ? amax : gr); aoff[i] = (unsigned)gr * (unsigned)lda + (unsigned)(lc * 8); }
#pragma unroll
  for (int i = 0; i < NBL; ++i) boff[i] = (unsigned)(lr + 64 * i) * (unsigned)ldb + (unsigned)(lc * 8);
  const int wofs = lr * 128 + ((lc ^ ((lr >> 1) & 7)) << 4);
  u32x4 ra[4], rb[NBL];
  const int nk = K >> 6;
#pragma unroll
  for (int i = 0; i < 4; ++i) ra[i] = *reinterpret_cast<const u32x4*>(A + aoff[i]);
#pragma unroll
  for (int i = 0; i < NBL; ++i) rb[i] = *reinterpret_cast<const u32x4*>(Bt + boff[i]);
  __syncthreads();
#pragma unroll
  for (int i = 0; i < 4; ++i) *reinterpret_cast<u32x4*>(lds + wofs + i * 8192) = ra[i];
#pragma unroll
  for (int i = 0; i < NBL; ++i) *reinterpret_cast<u32x4*>(lds + ABYTES + wofs + i * 8192) = rb[i];
  __syncthreads();
  const int rsw = (l31 >> 1) & 7;
  const int a_base = (wm * 128 + l31) * 128, b_base = ABYTES + (wn * 32 * NTW + l31) * 128;
  for (int kt = 0; kt < nk; ++kt) {
    if (kt + 1 < nk) {
      const int ko = (kt + 1) * 64;
#pragma unroll
      for (int i = 0; i < 4; ++i) ra[i] = *reinterpret_cast<const u32x4*>(A + ko + aoff[i]);
#pragma unroll
      for (int i = 0; i < NBL; ++i) rb[i] = *reinterpret_cast<const u32x4*>(Bt + ko + boff[i]);
    }
    __builtin_amdgcn_sched_barrier(0);
    const char* st = lds + (kt & 1) * STAGE;
    bf16x8 af[4], bfv[2][NTW];
#define CO_(S) ((((S) * 2 + hi) ^ rsw) << 4)
#define LDA_(MT, S) af[MT] = *reinterpret_cast<const bf16x8*>(st + a_base + (MT) * 4096 + CO_(S))
#define LDB_(BUF, S) do { _Pragma("unroll") for (int nt = 0; nt < NTW; ++nt) bfv[BUF][nt] = *reinterpret_cast<const bf16x8*>(st + b_base + nt * 4096 + CO_(S)); } while (0)
    LDB_(0, 0);
#pragma unroll
    for (int mt = 0; mt < 4; ++mt) LDA_(mt, 0);
#pragma unroll
    for (int s = 0; s < 4; ++s) {
      if (s < 3) LDB_((s + 1) & 1, s + 1);
#pragma unroll
      for (int mt = 0; mt < 4; ++mt) {
        __builtin_amdgcn_sched_barrier(0);
#pragma unroll
        for (int nt = 0; nt < NTW; ++nt) acc[mt][nt] = mfma32(af[mt], bfv[s & 1][nt], acc[mt][nt]);
        if (s < 3) LDA_(mt, s + 1);
      }
      __builtin_amdgcn_sched_barrier(0);
    }
#undef CO_
#undef LDA_
#undef LDB_
    if (kt + 1 < nk) {
      char* sw = lds + ((kt + 1) & 1) * STAGE;
#pragma unroll
      for (int i = 0; i < 4; ++i) *reinterpret_cast<u32x4*>(sw + wofs + i * 8192) = ra[i];
#pragma unroll
      for (int i = 0; i < NBL; ++i) *reinterpret_cast<u32x4*>(sw + ABYTES + wofs + i * 8192) = rb[i];
    }
    __syncthreads();
  }
  epi(acc, wm, wn, l31, hi);
}


__device__ __forceinline__ int block_L(int r) { const int G = gridDim.x, slots = G >> 3, b = blockIdx.x; return (r * 8 + (b & 7)) * slots + (b >> 3); }
__device__ __forceinline__ void grouped_mn(int L, int MT, int NT, int& mt, int& nt) {
  const int pg_ = 4 * NT; const int g = L / pg_, rem = L - g * pg_; const int gsz = (MT - 4 * g) < 4 ? (MT - 4 * g) : 4;
  nt = rem / gsz; mt = 4 * g + rem - nt * gsz;
}
__device__ __forceinline__ bool tile_of(int r, int MT, int NT, int& mt, int& nt) {
  const int G = gridDim.x, slots = G >> 3, b = blockIdx.x, x = b & 7, s = b >> 3;
  const int total = MT * NT, per = (total + 7) >> 3;
  const int start = x * per; int cnt = total - start; cnt = cnt > per ? per : cnt;
  const int idx = r * slots + s; if (idx >= cnt) return false;
  grouped_mn(start + idx, MT, NT, mt, nt); return true;
}

namespace pg {
using f32x4 = __attribute__((ext_vector_type(4))) float;
constexpr int HTB = 128 * 64 * 2;
__device__ __forceinline__ int lds_byte(int r, int c) { const int st = (r >> 4) * 2 + (c >> 5), rr = r & 15, cc = c & 31, ob = rr * 64 + cc * 2; return st * 1024 + (ob ^ (((ob >> 9) & 1) << 5)); }
__device__ __forceinline__ void stage_rc(int b, int& R, int& C) { const int st = b / 1024, sb = b % 1024, swz = sb ^ (((sb >> 9) & 1) << 5); R = (st >> 1) * 16 + swz / 64; C = (st & 1) * 32 + (swz % 64) / 2; }
__device__ __forceinline__ int perm32(int rho) { const int n = rho >> 4, i = rho & 15; return 8 * (i >> 2) + 4 * n + (i & 3); }
struct Unit { const char* a; const char* b; int nt, m0, n0, tag; };

template <bool PERM, class Sched, class Epi>
__device__ __forceinline__ void gemm_phase(LAS unsigned char* lds, int lda, int ldb, const Sched& S, const Epi& E) {
    const int tid = otid(), wid = __builtin_amdgcn_readfirstlane(tid >> 6), lane = tid & 63, wr = wid >> 2, wc = wid & 3, fr = lane & 15, fq = lane >> 4;
    unsigned voffA[2], voffB[2];
#pragma unroll
    for (int i = 0; i < 2; ++i) { int R, C; stage_rc(tid * 16 + i * 8192, R, C); const int Rb = PERM ? ((R & ~31) + perm32(R & 31)) : R;
        voffA[i] = (unsigned)(R * lda + C) * 2u; voffB[i] = (unsigned)(Rb * ldb + C) * 2u; }
    const size_t kstep = 128;
    const size_t hstepA = (size_t)128 * lda * 2, hstepB = (size_t)128 * ldb * 2;
    const unsigned ldsw = (unsigned)wid * 1024u;
    const int aoff = lds_byte(wr * 64 + fr, fq * 8), boff = lds_byte(wc * 32 + fr, fq * 8);
#define PG8_SA(b, h) (((b) * 2 + (h)) * HTB)
#define PG8_SB(b, h) ((4 + (b) * 2 + (h)) * HTB)
#define PG8_STAGE(bufoff, gbase, voff) do { _Pragma("unroll") for (int _i = 0; _i < 2; ++_i) \
        __builtin_amdgcn_global_load_lds((const unsigned*)((const char*)(gbase) + (voff)[_i]), (LAS unsigned*)(lds + (bufoff) + ldsw + _i * 8192), 16, 0, 0); } while (0)
#define PG8_LDA(dst, b, h) do { _Pragma("unroll") for (int m = 0; m < 4; ++m) _Pragma("unroll") for (int k = 0; k < 2; ++k) dst[m][k] = *(const LAS bf16x8*)(lds + PG8_SA(b, h) + aoff + m * 2048 + k * 1024); } while (0)
#define PG8_LDB(dst, b, h) do { _Pragma("unroll") for (int n = 0; n < 2; ++n) _Pragma("unroll") for (int k = 0; k < 2; ++k) dst[n][k] = *(const LAS bf16x8*)(lds + PG8_SB(b, h) + boff + n * 2048 + k * 1024); } while (0)
#define PG8_MMA(ai, bj, At, Bt) do { __builtin_amdgcn_s_setprio(1); _Pragma("unroll") for (int m = 0; m < 4; ++m) _Pragma("unroll") for (int n = 0; n < 2; ++n) _Pragma("unroll") for (int k = 0; k < 2; ++k) \
        acc[ai][bj][m][n] = __builtin_amdgcn_mfma_f32_16x16x32_bf16(Bt[n][k], At[m][k], acc[ai][bj][m][n], 0, 0, 0); __builtin_amdgcn_s_setprio(0); } while (0)
#define PG8_WAIT_V(n) asm volatile("s_waitcnt vmcnt(" #n ")" ::: "memory")
#define PG8_WAIT_L(n) asm volatile("s_waitcnt lgkmcnt(" #n ")" ::: "memory")
#define PG8_BAR __builtin_amdgcn_s_barrier()
#define PG8_SCHED __builtin_amdgcn_sched_barrier(0)
    Unit cur, nxt; int ui = 0;
    if (!S.next(0, cur)) return;
    f32x4 acc[2][2][4][2];
#pragma unroll
    for (int a = 0; a < 2; ++a)
#pragma unroll
        for (int b = 0; b < 2; ++b)
#pragma unroll
            for (int m = 0; m < 4; ++m)
#pragma unroll
                for (int n = 0; n < 2; ++n) acc[a][b][m][n] = (f32x4){0.f, 0.f, 0.f, 0.f};
    bf16x8 At[4][2], B0[2][2], B1[2][2];
    const char* cA = cur.a; const char* cB = cur.b;
    PG8_STAGE(PG8_SB(0, 0), cB, voffB); PG8_STAGE(PG8_SA(0, 0), cA, voffA); PG8_STAGE(PG8_SB(0, 1), cB + hstepB, voffB); PG8_STAGE(PG8_SA(0, 1), cA + hstepA, voffA);
    if (wr == 1) PG8_BAR;
    PG8_WAIT_V(4); PG8_BAR;
    PG8_STAGE(PG8_SB(1, 0), cB + kstep, voffB); PG8_STAGE(PG8_SA(1, 0), cA + kstep, voffA); PG8_STAGE(PG8_SB(1, 1), cB + hstepB + kstep, voffB);
    PG8_WAIT_V(6); PG8_BAR;
    for (;;) {
        const bool has_next = S.next(ui + 1, nxt);
        const char* nA = has_next ? nxt.a : cA; const char* nB = has_next ? nxt.b : cB;
        const int nt = cur.nt;
        for (int t = 0; t < nt; t += 2) {
            const bool last = (t == nt - 2);
            const char* a1 = cA + (size_t)(t + 1) * kstep;
            const char* a2 = last ? nA : cA + (size_t)(t + 2) * kstep; const char* b2 = last ? nB : cB + (size_t)(t + 2) * kstep;
            const char* a3 = a2 + kstep; const char* b3 = b2 + kstep;
            PG8_LDB(B0, 0, 0); PG8_SCHED; PG8_LDA(At, 0, 0); PG8_STAGE(PG8_SA(1, 1), a1 + hstepA, voffA);
            PG8_WAIT_L(8); PG8_BAR; PG8_WAIT_L(0); PG8_MMA(0, 0, At, B0); PG8_BAR; PG8_SCHED;
            PG8_LDB(B1, 0, 1); PG8_STAGE(PG8_SB(0, 0), b2, voffB);
            PG8_BAR; PG8_WAIT_L(0); PG8_MMA(0, 1, At, B1); PG8_BAR;
            PG8_LDA(At, 0, 1); PG8_STAGE(PG8_SA(0, 0), a2, voffA);
            PG8_BAR; PG8_WAIT_L(0); PG8_MMA(1, 0, At, B0); PG8_BAR; PG8_SCHED;
            PG8_STAGE(PG8_SB(0, 1), b2 + hstepB, voffB);
            PG8_WAIT_V(6); PG8_BAR; PG8_MMA(1, 1, At, B1); PG8_BAR;
            PG8_LDB(B0, 1, 0); PG8_SCHED; PG8_LDA(At, 1, 0); PG8_STAGE(PG8_SA(0, 1), a2 + hstepA, voffA);
            PG8_WAIT_L(8); PG8_BAR; PG8_WAIT_L(0); PG8_MMA(0, 0, At, B0); PG8_BAR; PG8_SCHED;
            PG8_LDB(B1, 1, 1); PG8_STAGE(PG8_SB(1, 0), b3, voffB);
            PG8_BAR; PG8_WAIT_L(0); PG8_MMA(0, 1, At, B1); PG8_BAR;
            PG8_LDA(At, 1, 1); PG8_STAGE(PG8_SA(1, 0), a3, voffA);
            PG8_BAR; PG8_WAIT_L(0); PG8_MMA(1, 0, At, B0); PG8_BAR; PG8_SCHED;
            PG8_STAGE(PG8_SB(1, 1), b3 + hstepB, voffB);
            PG8_WAIT_V(6); PG8_BAR; PG8_MMA(1, 1, At, B1); PG8_BAR;
        }
        E(acc, cur, wr, wc, fr, fq);
        if (!has_next) break;
#pragma unroll
        for (int a = 0; a < 2; ++a)
#pragma unroll
            for (int b = 0; b < 2; ++b)
#pragma unroll
                for (int m = 0; m < 4; ++m)
#pragma unroll
                    for (int n = 0; n < 2; ++n) acc[a][b][m][n] = (f32x4){0.f, 0.f, 0.f, 0.f};
        cur = nxt; cA = nA; cB = nB; ++ui;
    }
    PG8_WAIT_V(0);
    if (wr == 0) PG8_BAR;
    PG8_BAR;
#undef PG8_SA
#undef PG8_SB
#undef PG8_STAGE
#undef PG8_LDA
#undef PG8_LDB
#undef PG8_MMA
#undef PG8_WAIT_V
#undef PG8_WAIT_L
#undef PG8_BAR
#undef PG8_SCHED
}
}


struct SchedMN {
  const char* A; const char* B; int lda, ldb, MT, NT, nt;
  __device__ __forceinline__ bool next(int i, pg::Unit& u) const {
    int mt, ntl; if (!tile_of(i, MT, NT, mt, ntl)) return false;
    u.m0 = mt * 256; u.n0 = ntl * 256; u.a = A + (size_t)u.m0 * lda * 2; u.b = B + (size_t)u.n0 * ldb * 2; u.nt = nt; u.tag = 0; return true; }
};
struct SchedRes {
  const char* A; const char* B; int lda, ldb, ntk, nctx;
  __device__ __forceinline__ bool next(int i, pg::Unit& u) const {
    const int L = block_L(i);
    if (L < 512) { int mt, ntl; grouped_mn(L, 64, 8, mt, ntl); u.m0 = mt * 256; u.n0 = ntl * 256; u.a = A + (size_t)u.m0 * lda * 2; u.b = B + (size_t)u.n0 * ldb * 2; u.nt = ntk; u.tag = 0; return true; }
    const int s = L - 512; if (s >= nctx * 4) return false;
    const int cu = s >> 2, ks = s & 3, kt = ntk >> 2;
    u.m0 = (64 + (cu >> 3)) * 256; u.n0 = (cu & 7) * 256; u.nt = kt; u.tag = 1 + ks;
    u.a = A + ((size_t)u.m0 * lda + (size_t)ks * kt * 64) * 2; u.b = B + ((size_t)u.n0 * ldb + (size_t)ks * kt * 64) * 2; return true; }
};
struct SchedQKV {
  const char* P; const char* Wq; const char* Wkv; int MT;
  __device__ __forceinline__ bool next(int i, pg::Unit& u) const {
    int mt, ntv; if (!tile_of(i, MT, 14, mt, ntv)) return false;
    const bool isq = ntv < 6; const int ntl = isq ? ntv : ntv - 6;
    u.m0 = mt * 256; u.n0 = ntl * 256; u.tag = isq ? 0 : 1; u.nt = isq ? 12 : 8;
    u.a = P + ((size_t)u.m0 * PLD + (isq ? 0 : OFF_CKV)) * 2; u.b = (isq ? Wq : Wkv) + (size_t)u.n0 * 768 * 2; return true; }
};

__device__ __forceinline__ void phase_gemm_in(const Params& p, char* lds) {
  char* ws = p.ws;
  bf16_t* P = (bf16_t*)(ws + WS_P); float* DT = (float*)(ws + WS_DT);
  SchedMN S{ws + WS_H, ws + WS_WIN, HLD, WLD, T_ALL / 256, PNP / 256, DM / 64};
  auto epi = [=](const pg::f32x4 (&acc)[2][2][4][2], const pg::Unit& u, int wr, int wc, int fr, int fq) {
    const int row0 = u.m0 + wr * 64 + fr;
#pragma unroll
    for (int ai = 0; ai < 2; ++ai)
#pragma unroll
      for (int m = 0; m < 4; ++m) { const int row = row0 + ai * 128 + m * 16;
#pragma unroll
        for (int bj = 0; bj < 2; ++bj) { const int c = u.n0 + bj * 128 + wc * 32 + 8 * fq;
          const pg::f32x4 v0 = acc[ai][bj][m][0], v1 = acc[ai][bj][m][1];
          if (c < PLD) { u32x4 w = {cvtpk(v0[0], v0[1]), cvtpk(v0[2], v0[3]), cvtpk(v1[0], v1[1]), cvtpk(v1[2], v1[3])}; *reinterpret_cast<u32x4*>(P + (size_t)row * PLD + c) = w; }
          if (c >= OFF_DT && c < PIN) { *reinterpret_cast<pg::f32x4*>(DT + (size_t)row * 16 + (c - OFF_DT)) = v0; *reinterpret_cast<pg::f32x4*>(DT + (size_t)row * 16 + (c - OFF_DT) + 4) = v1; } } }
  };
  pg::gemm_phase<true>((LAS unsigned char*)lds, HLD, WLD, S, epi);
}

__device__ __forceinline__ void phase_qkv_gemm_and_post(const Params& p, int layer, char* lds) {
  char* ws = p.ws;
  const bf16_t* P = (const bf16_t*)(ws + WS_P);
  { SchedQKV S{ws + WS_P, ws + WS_WUQ, ws + WS_WUKV, T_ALL / 256};
    bf16_t* dq = (bf16_t*)(ws + WS_QRAW); bf16_t* dkv = (bf16_t*)(ws + WS_KVRAW);
    auto epi = [=](const pg::f32x4 (&acc)[2][2][4][2], const pg::Unit& u, int wr, int wc, int fr, int fq) {
      bf16_t* dst = u.tag ? dkv : dq; const int ldd = u.tag ? 2048 : 1536;
      const int row0 = u.m0 + wr * 64 + fr;
#pragma unroll
      for (int ai = 0; ai < 2; ++ai)
#pragma unroll
        for (int m = 0; m < 4; ++m) { const int row = row0 + ai * 128 + m * 16;
#pragma unroll
          for (int bj = 0; bj < 2; ++bj) { const int c = u.n0 + bj * 128 + wc * 32 + 8 * fq;
            const pg::f32x4 v0 = acc[ai][bj][m][0], v1 = acc[ai][bj][m][1];
            u32x4 w = {cvtpk(v0[0], v0[1]), cvtpk(v0[2], v0[3]), cvtpk(v1[0], v1[1]), cvtpk(v1[2], v1[3])};
            *reinterpret_cast<u32x4*>(dst + (size_t)row * ldd + c) = w; } }
    };
    pg::gemm_phase<true>((LAS unsigned char*)lds, PLD, 768, S, epi); }
  const int tid = otid(), lane = tid & 63, wid = tid >> 6;
  float* RSTD = (float*)(ws + WS_RSTD); float* DT = (float*)(ws + WS_DT); bf16_t* XBC = (bf16_t*)(ws + WS_XBC);
  const float* cw = p.ssd_conv_w + (size_t)layer * 3 * 1024; const float* cb = p.ssd_conv_b + layer * 1024;
  for (int t = blockIdx.x * 8 + wid; t < T_ALL; t += gridDim.x * 8) {
    const bf16_t* pr = P + (size_t)t * PLD;
    float sq = 0.f, skv = 0.f; float f[8];
    for (int c = lane; c < 96; c += 64) { unpack8(*reinterpret_cast<const u32x4*>(pr + c * 8), f);
#pragma unroll
      for (int e = 0; e < 8; ++e) sq += f[e] * f[e]; }
    { unpack8(*reinterpret_cast<const u32x4*>(pr + OFF_CKV + lane * 8), f);
#pragma unroll
      for (int e = 0; e < 8; ++e) skv += f[e] * f[e]; }
    sq = wave_sum(sq); skv = wave_sum(skv);
    if (lane == 0) { RSTD[t * 2] = rsqrtf(sq * (1.f / 768.f) + EPS); RSTD[t * 2 + 1] = rsqrtf(skv * (1.f / 512.f) + EPS); }
    if (lane < 16) { float v = DT[(size_t)t * 16 + lane] + p.ssd_dt_bias[layer * 16 + lane]; DT[(size_t)t * 16 + lane] = v > 20.f ? v : log1pf(__expf(v)); }
    const bool s0 = seq_start(t), s1 = seq_end(t);
#pragma unroll
    for (int cc = 0; cc < 2; ++cc) {
      const int c0 = (cc * 64 + lane) * 8;
      float fm[8], fc[8], fp[8];
      unpack8(*reinterpret_cast<const u32x4*>(pr + OFF_XBC + c0), fc);
      if (!s0) unpack8(*reinterpret_cast<const u32x4*>(pr - PLD + OFF_XBC + c0), fm);
      if (!s1) unpack8(*reinterpret_cast<const u32x4*>(pr + PLD + OFF_XBC + c0), fp);
      float o[8];
#pragma unroll
      for (int e = 0; e < 8; ++e) {
        float a = cb[c0 + e] + cw[1024 + c0 + e] * fc[e];
        if (!s0) a += cw[c0 + e] * fm[e];
        if (!s1) a += cw[2048 + c0 + e] * fp[e];
        o[e] = silu_f(a);
      }
      *reinterpret_cast<u32x4*>(XBC + (size_t)t * 1024 + c0) = pack8(o);
    }
  }
}

__device__ __forceinline__ void phase_build_qkv(const Params& p, int layer) {
  char* ws = p.ws;
  const int tid = otid(), lane = tid & 63, wid = tid >> 6;
  const bf16_t* P = (const bf16_t*)(ws + WS_P); const bf16_t* QR = (const bf16_t*)(ws + WS_QRAW); const bf16_t* KVR = (const bf16_t*)(ws + WS_KVRAW);
  const float* RSTD = (const float*)(ws + WS_RSTD); const float* rope = (const float*)(ws + WS_ROPE);
  bf16_t* Q = (bf16_t*)(ws + WS_Q); bf16_t* QC = (bf16_t*)(ws + WS_QC); bf16_t* Kb = (bf16_t*)(ws + WS_K); bf16_t* Vb = (bf16_t*)(ws + WS_V);
  const float* qn = p.q_norm + layer * 192; const float* kn = p.k_norm + layer * 192;
  const float qg0 = qn[lane], qg1 = qn[64 + lane], qg2 = qn[128 + lane];
  const float kg0 = kn[lane], kg1 = kn[64 + lane], kg2 = kn[128 + lane];
  const int ax = lane >> 5, jj = lane & 15, second = (lane >> 4) & 1;
  for (int t = blockIdx.x * 8 + wid; t < T_ALL; t += gridDim.x * 8) {
    const bool lat = t < T_LAT;
    const int b = lat ? (t >> 13) : ((t - T_LAT) >> 8);
    const int pos = lat ? (t & (SEQ - 1)) : ((t - T_LAT) & (CTXL - 1));
    const int kpos = lat ? (CTXL + pos) : pos;
    const float rq = RSTD[t * 2], rkv = RSTD[t * 2 + 1];
    float cs = 1.f, sn = 0.f;
    if (lat) { const int pa = ax ? (pos & 63) : (pos >> 6); cs = rope[(pa * 16 + jj) * 2]; sn = rope[(pa * 16 + jj) * 2 + 1]; }
    const float krv = bf2f(P[(size_t)t * PLD + OFF_KR + lane]);
    for (int h = 0; h < 8; ++h) {
      const bf16_t* qs = QR + (size_t)t * 1536 + h * 192;
      float v0 = bf2f(qs[lane]) * rq, v1 = bf2f(qs[64 + lane]) * rq, v2 = bf2f(qs[128 + lane]) * rq;
      float ss = wave_sum(v0 * v0 + v1 * v1 + v2 * v2);
      float r = rsqrtf(ss * (1.f / 192.f) + EPS);
      v0 *= r * qg0; v1 *= r * qg1; v2 *= r * qg2;
      if (lat) { float pr = lane_xor16(v2, lane); v2 = second ? (v2 * cs + pr * sn) : (v2 * cs - pr * sn); }
      bf16_t* qd = lat ? Q + ((size_t)(b * 8 + h) * SEQ + pos) * 192 : QC + ((size_t)(b * 8 + h) * CTXL + pos) * 192;
      qd[lane] = f2bf(v0 * QSCALE); qd[64 + lane] = f2bf(v1 * QSCALE); qd[128 + lane] = f2bf(v2 * QSCALE);
      const bf16_t* ks = KVR + (size_t)t * 2048 + h * 256;
      float k0 = bf2f(ks[lane]) * rkv, k1 = bf2f(ks[64 + lane]) * rkv, k2 = krv;
      float vv0 = bf2f(ks[128 + lane]) * rkv, vv1 = bf2f(ks[192 + lane]) * rkv;
      float ks2 = wave_sum(k0 * k0 + k1 * k1 + k2 * k2);
      float rk = rsqrtf(ks2 * (1.f / 192.f) + EPS);
      k0 *= rk * kg0; k1 *= rk * kg1; k2 *= rk * kg2;
      if (lat) { float pr = lane_xor16(k2, lane); k2 = second ? (k2 * cs + pr * sn) : (k2 * cs - pr * sn); }
      bf16_t* kd = Kb + ((size_t)(b * 8 + h) * NKEYS + kpos) * 192;
      kd[lane] = f2bf(k0); kd[64 + lane] = f2bf(k1); kd[128 + lane] = f2bf(k2);
      bf16_t* vd = Vb + ((size_t)(b * 8 + h) * NKEYS + kpos) * 128;
      vd[lane] = f2bf(vv0); vd[64 + lane] = f2bf(vv1);
    }
  }
}

#define KSWZ(row, colB) ((row) * 384 + ((colB) ^ ((((row) >> 1) & 7) << 4)))
__device__ __forceinline__ int v_st(int k, int c) { const int kk = (k & ~0xC) | ((k & 4) << 1) | ((k & 8) >> 1); return ((kk >> 3) * 4 + (c >> 5)) * 512 + ((kk & 7) * 32 + (c & 31)) * 2; }
__device__ __forceinline__ int v_rd_base(int lane) { return ((lane & 3) << 3) | (((lane >> 2) & 3) << 6) | (((lane >> 4) & 1) << 5) | (((lane >> 5) & 1) << 8); }
constexpr int v_rd_off(int d0, int ks, int half) { return d0 * 512 + ks * 4096 + half * 2048; }
template <int OFF> __device__ __forceinline__ s16x4 tr_read(int vb) {
  s16x4 r; asm volatile("ds_read_b64_tr_b16 %0, %1 offset:%2" : "=&v"(r) : "v"(vb), "i"(OFF) : "memory"); return r;
}
struct VFrag { s16x4 l0, h0, l1, h1, l2, h2, l3, h3; };
template <int D0> __device__ __forceinline__ void pv_read(VFrag& f, int vb) {
  f.l0 = tr_read<v_rd_off(D0, 0, 0)>(vb); f.h0 = tr_read<v_rd_off(D0, 0, 1)>(vb); f.l1 = tr_read<v_rd_off(D0, 1, 0)>(vb); f.h1 = tr_read<v_rd_off(D0, 1, 1)>(vb);
  f.l2 = tr_read<v_rd_off(D0, 2, 0)>(vb); f.h2 = tr_read<v_rd_off(D0, 2, 1)>(vb); f.l3 = tr_read<v_rd_off(D0, 3, 0)>(vb); f.h3 = tr_read<v_rd_off(D0, 3, 1)>(vb);
}
__device__ __forceinline__ void pv_mma(f32x16& od, const VFrag& f, bf16x8 pa0, bf16x8 pa1, bf16x8 pa2, bf16x8 pa3) {
#define PK(L, H) (bf16x8){L[0], L[1], L[2], L[3], H[0], H[1], H[2], H[3]}
  od = mfma32(pa0, PK(f.l0, f.h0), od); od = mfma32(pa1, PK(f.l1, f.h1), od); od = mfma32(pa2, PK(f.l2, f.h2), od); od = mfma32(pa3, PK(f.l3, f.h3), od);
#undef PK
}
__device__ __forceinline__ void pv_all(f32x16* o, int vb, bf16x8 pa0, bf16x8 pa1, bf16x8 pa2, bf16x8 pa3) {
  VFrag fa, fb;
  pv_read<0>(fa, vb); pv_read<1>(fb, vb);
  asm volatile("s_waitcnt lgkmcnt(8)" : "+v"(fa.l0), "+v"(fa.h0), "+v"(fa.l1), "+v"(fa.h1), "+v"(fa.l2), "+v"(fa.h2), "+v"(fa.l3), "+v"(fa.h3) :: "memory"); __builtin_amdgcn_sched_barrier(0);
  pv_mma(o[0], fa, pa0, pa1, pa2, pa3); __builtin_amdgcn_sched_barrier(0);
  pv_read<2>(fa, vb);
  asm volatile("s_waitcnt lgkmcnt(8)" : "+v"(fb.l0), "+v"(fb.h0), "+v"(fb.l1), "+v"(fb.h1), "+v"(fb.l2), "+v"(fb.h2), "+v"(fb.l3), "+v"(fb.h3) :: "memory"); __builtin_amdgcn_sched_barrier(0);
  pv_mma(o[1], fb, pa0, pa1, pa2, pa3); __builtin_amdgcn_sched_barrier(0);
  pv_read<3>(fb, vb);
  asm volatile("s_waitcnt lgkmcnt(8)" : "+v"(fa.l0), "+v"(fa.h0), "+v"(fa.l1), "+v"(fa.h1), "+v"(fa.l2), "+v"(fa.h2), "+v"(fa.l3), "+v"(fa.h3) :: "memory"); __builtin_amdgcn_sched_barrier(0);
  pv_mma(o[2], fa, pa0, pa1, pa2, pa3); __builtin_amdgcn_sched_barrier(0);
  asm volatile("s_waitcnt lgkmcnt(0)" : "+v"(fb.l0), "+v"(fb.h0), "+v"(fb.l1), "+v"(fb.h1), "+v"(fb.l2), "+v"(fb.h2), "+v"(fb.l3), "+v"(fb.h3) :: "memory"); __builtin_amdgcn_sched_barrier(0);
  pv_mma(o[3], fb, pa0, pa1, pa2, pa3);
}

constexpr int ATT_V = 0, ATT_K = 32768, ATT_WS = 32768 + 49152;
__device__ __forceinline__ void attn_item(const bf16_t* __restrict__ Qb, const bf16_t* __restrict__ Kh, const bf16_t* __restrict__ Vh, int nkeys,
                          bf16_t* __restrict__ Ob, float* __restrict__ ml, char* lds) {
  constexpr float THR = 8.f;
  const int tid = otid(), wid = tid >> 6, lane = tid & 63, r32 = lane & 31, hi = lane >> 5;
  char* V_lds = lds + ATT_V; char* K_lds = lds + ATT_K;
  float* wsf = (float*)(lds + ATT_WS) + wid * 64; float* li_l = wsf; float* al_l = wsf + 32;
  float m_reg = 0.f, l_reg = 0.f;
  f32x16 o[4];
#pragma unroll
  for (int d = 0; d < 4; ++d)
#pragma unroll
    for (int r = 0; r < 16; ++r) o[d][r] = 0.f;
  bf16x8 qr[12];
  const bf16_t* Qw = Qb + (size_t)(wid * 32 + r32) * 192 + hi * 8;
#pragma unroll
  for (int d0 = 0; d0 < 12; ++d0) qr[d0] = *reinterpret_cast<const bf16x8*>(Qw + d0 * 16);
  const int sr = tid >> 4, sc = (tid & 15) * 8, vst0 = v_st(sr, sc), vst1 = v_st(32 + sr, sc);
  const int vb0 = (int)(uintptr_t)V_lds + v_rd_base(lane);
#define krow(i) ((tid + (i) * NTHR) / 24)
#define kch(i) ((tid + (i) * NTHR) % 24)
  int klow[4];
#pragma unroll
  for (int q = 0; q < 4; ++q) klow[q] = r32 * 384 + ((q * 32 + hi * 16) ^ (((r32 >> 1) & 7) << 4));
  const int wu = __builtin_amdgcn_readfirstlane(wid);
  unsigned koff[3], voff[2];
#pragma unroll
  for (int i = 0; i < 3; ++i) { const int ofs = (i * 8 + wid) * 1024 + lane * 16; const int row = ofs / 384, cpos = (ofs - row * 384) >> 4;
    const int c = (cpos & ~7) | ((cpos ^ (row >> 1)) & 7); koff[i] = (unsigned)(row * 192 + c * 8); }
#pragma unroll
  for (int i = 0; i < 2; ++i) { const int ofs = (i * 8 + wid) * 1024 + lane * 16; const int st = ofs >> 9, wv = ofs & 511;
    const int kk = (st >> 2) * 8 + (wv >> 6), c = (st & 3) * 32 + ((wv & 63) >> 1); const int k = (kk & ~0xC) | ((kk & 4) << 1) | ((kk & 8) >> 1);
    voff[i] = (unsigned)(k * 128 + c); }
#define SDMA(k0, b) do { const bf16_t* Vt = Vh + (size_t)(k0) * 128; const bf16_t* Kt = Kh + (size_t)(k0) * 192; \
    _Pragma("unroll") for (int i = 0; i < 2; ++i) __builtin_amdgcn_global_load_lds((const unsigned*)(Vt + voff[i]), (LAS unsigned*)(V_lds + (b) * 16384 + (i * 8 + wu) * 1024), 16, 0, 0); \
    _Pragma("unroll") for (int i = 0; i < 3; ++i) __builtin_amdgcn_global_load_lds((const unsigned*)(Kt + koff[i]), (LAS unsigned*)(K_lds + (b) * 24576 + (i * 8 + wu) * 1024), 16, 0, 0); } while (0)
#define SLOAD(k0) do { } while (0)
#define SWRITE(b) do { } while (0)
  const int NT = nkeys >> 6;
  __syncthreads();
  SDMA(0, 0); asm volatile("s_waitcnt vmcnt(0)" ::: "memory"); __syncthreads();
  for (int j = 0; j < NT; ++j) {
    if (j + 1 < NT) SDMA((j + 1) * 64, (j + 1) & 1);
    __builtin_amdgcn_sched_barrier(0);
    const char* Ks = K_lds + (j & 1) * 24576;
    f32x16 p0, p1;
#pragma unroll
    for (int r = 0; r < 16; ++r) { p0[r] = -m_reg; p1[r] = -m_reg; }
    bf16x8 kb0[3], kb1[3];
#define LDK_(D, SL) do { const char* kp_ = Ks + klow[(D) & 3] + ((D) >> 2) * 128; kb0[SL] = *reinterpret_cast<const bf16x8*>(kp_); kb1[SL] = *reinterpret_cast<const bf16x8*>(kp_ + 32 * 384); } while (0)
    LDK_(0, 0); LDK_(1, 1);
#pragma unroll
    for (int d0 = 0; d0 < 12; ++d0) {
      if (d0 + 2 < 12) LDK_(d0 + 2, (d0 + 2) % 3);
      __builtin_amdgcn_sched_barrier(0);
      p0 = mfma32(kb0[d0 % 3], qr[d0], p0); p1 = mfma32(kb1[d0 % 3], qr[d0], p1);
      __builtin_amdgcn_sched_barrier(0);
    }
#undef LDK_
    float pmax = p0[0];
#pragma unroll
    for (int r = 1; r < 16; ++r) pmax = fmaxf(pmax, p0[r]);
#pragma unroll
    for (int r = 0; r < 16; ++r) pmax = fmaxf(pmax, p1[r]);
    { auto rr = __builtin_amdgcn_permlane32_swap(__float_as_uint(pmax), __float_as_uint(pmax), false, false);
      pmax = fmaxf(__uint_as_float(rr[0]), __uint_as_float(rr[1])); }
    float alpha = 1.f;
    if (!__all(pmax <= THR)) {
      const float delta = fmaxf(pmax, 0.f); alpha = __builtin_amdgcn_exp2f(-delta); m_reg += delta;
#pragma unroll
      for (int r = 0; r < 16; ++r) { p0[r] -= delta; p1[r] -= delta; }
    }
    float ps = 0.f;
#pragma unroll
    for (int r = 0; r < 16; ++r) { p0[r] = __builtin_amdgcn_exp2f(p0[r]); ps += p0[r]; }
#pragma unroll
    for (int r = 0; r < 16; ++r) { p1[r] = __builtin_amdgcn_exp2f(p1[r]); ps += p1[r]; }
    { auto rr = __builtin_amdgcn_permlane32_swap(__float_as_uint(ps), __float_as_uint(ps), false, false);
      ps = __uint_as_float(rr[0]) + __uint_as_float(rr[1]); }
    l_reg = l_reg * alpha + ps;
    bf16x8 pa0, pa1, pa2, pa3;
#define PK4(P, BASE, OUT) do { unsigned a0 = cvtpk(P[BASE + 0], P[BASE + 1]), a1 = cvtpk(P[BASE + 2], P[BASE + 3]);   \
    unsigned b0_ = cvtpk(P[BASE + 4], P[BASE + 5]), b1_ = cvtpk(P[BASE + 6], P[BASE + 7]);                              \
    auto r0 = __builtin_amdgcn_permlane32_swap(a0, b0_, false, false); auto r1 = __builtin_amdgcn_permlane32_swap(a1, b1_, false, false); \
    u32x4 w = {r0[0], r1[0], r0[1], r1[1]}; OUT = *reinterpret_cast<bf16x8*>(&w); } while (0)
    PK4(p0, 0, pa0); PK4(p0, 8, pa1); PK4(p1, 0, pa2); PK4(p1, 8, pa3);
#undef PK4
    if (__any(alpha < 1.f)) {
      if (hi == 0) al_l[r32] = alpha;
      asm volatile("s_waitcnt lgkmcnt(0)" ::: "memory");
#pragma unroll
      for (int r = 0; r < 16; ++r) { const float a = al_l[crow(r, hi)];
#pragma unroll
        for (int d = 0; d < 4; ++d) o[d][r] *= a; }
    }
    const int vb = vb0 + (j & 1) * 16384;
    pv_all(o, vb, pa0, pa1, pa2, pa3);
    asm volatile("s_waitcnt vmcnt(0)" ::: "memory");
    __syncthreads();
  }
#undef SDMA
#undef SLOAD
#undef SWRITE
#undef krow
#undef kch
  if (hi == 0) { li_l[r32] = l_reg; float* mp = ml + (size_t)(wid * 32 + r32) * 16; mp[0] = m_reg; mp[1] = l_reg; }
  asm volatile("s_waitcnt lgkmcnt(0)" ::: "memory");
  bf16_t* Ow = Ob + (size_t)(wid * 32) * 1024;
#pragma unroll
  for (int r = 0; r < 16; ++r) {
    const int orow = crow(r, hi); const float rl = 1.f / li_l[orow];
#pragma unroll
    for (int d0 = 0; d0 < 4; ++d0) Ow[(size_t)orow * 1024 + d0 * 32 + r32] = f2bf(o[d0][r] * rl);
  }
}

constexpr int SS_CM = 0, SS_BM = 34816, SS_BW = 69632, SS_XV = 102400, SS_SB = 118784, SS_ACS = 136192, SS_DT = 136704, SS_RAW = 137216;
__device__ __forceinline__ int v_st2(int k, int c) { const int kk = (k & ~0xC) | ((k & 4) << 1) | ((k & 8) >> 1); return ((kk >> 3) * 2 + (c >> 5)) * 512 + ((kk & 7) * 32 + (c & 31)) * 2; }
__device__ __forceinline__ void ssd_item(const Params& p, int layer, int item, char* lds) {
  char* ws = p.ws;
  const int tid = otid(), wid = tid >> 6, lane = tid & 63, l31 = lane & 31, hi = lane >> 5;
  const int b = item >> 4, dir = (item >> 3) & 1, h = item & 7, grp = h >> 2;
  const float a_neg = -__expf(p.ssd_a_log[layer * 16 + dir * 8 + h]);
  const bf16_t* XBC = (const bf16_t*)(ws + WS_XBC); const float* DT = (const float*)(ws + WS_DT);
  bf16_t* Y = (bf16_t*)(ws + (dir ? WS_YB : WS_YF));
  float* sAcs = (float*)(lds + SS_ACS); float* sDt = (float*)(lds + SS_DT); float* sRaw = (float*)(lds + SS_RAW);
  f32x16 S;
#pragma unroll
  for (int r = 0; r < 16; ++r) S[r] = 0.f;
  const int s_pt = wid >> 2, s_nt = wid & 3;
  const int y_it = wid >> 1, y_pt = wid & 1;
  u32x4 rc[4], rbm[4], rx[2]; float rdt = 0.f;
#define SSD_BASE(K) ((K) < 2 ? T_LAT + b * CTXL + 128 * (dir ? (1 - (K)) : (K)) : b * SEQ + 128 * (dir ? (63 - ((K) - 2)) : ((K) - 2)))
#define SSD_LOAD(K) do { const int base_ = SSD_BASE(K); \
    _Pragma("unroll") for (int e = 0; e < 4; ++e) { int id = tid + e * NTHR; int it = id >> 4, c = id & 15; int prow = base_ + (dir ? 127 - it : it); \
      rbm[e] = *reinterpret_cast<const u32x4*>(XBC + (unsigned)(prow * 1024 + 512 + grp * 128 + c * 8)); \
      rc[e]  = *reinterpret_cast<const u32x4*>(XBC + (unsigned)(prow * 1024 + 768 + grp * 128 + c * 8)); } \
    _Pragma("unroll") for (int e = 0; e < 2; ++e) { int id = tid + e * NTHR; int it = id >> 3, c = id & 7; int prow = base_ + (dir ? 127 - it : it); \
      rx[e] = *reinterpret_cast<const u32x4*>(XBC + (unsigned)(prow * 1024 + h * 64 + c * 8)); } \
    if (tid < 128) { int prow = base_ + (dir ? 127 - tid : tid); rdt = DT[(unsigned)(prow * 16 + dir * 8 + h)]; } } while (0)
  for (int k = 0; k < 66; ++k) {
    const int base = SSD_BASE(k);
    __syncthreads();
    SSD_LOAD(k);
    if (tid < 128) { sDt[tid] = rdt; sRaw[tid] = rdt * a_neg; }
    __syncthreads();
    if (tid < 128) {
      float v = sRaw[tid];
#pragma unroll
      for (int o = 1; o < 64; o <<= 1) { float u = __shfl_up(v, o); if (lane >= o) v += u; }
      if (wid == 1) v += wave_sum(sRaw[lane]);
      sAcs[tid] = v;
    }
    __syncthreads();
    const float acs_last = sAcs[127];
#pragma unroll
    for (int e = 0; e < 4; ++e) { int id = tid + e * NTHR; int it = id >> 4, c = id & 15;
      *reinterpret_cast<u32x4*>(lds + SS_CM + it * 272 + c * 16) = rc[e];
      *reinterpret_cast<u32x4*>(lds + SS_BM + it * 272 + c * 16) = rbm[e];
      float f[8]; unpack8(rbm[e], f); const float w = __expf(acs_last - sAcs[it]);
#pragma unroll
      for (int q = 0; q < 8; ++q) f[q] *= w;
      *reinterpret_cast<u32x4*>(lds + SS_BW + (it >> 6) * 16384 + v_st(it & 63, c * 8)) = pack8(f); }
#pragma unroll
    for (int e = 0; e < 2; ++e) { int id = tid + e * NTHR; int it = id >> 3, c = id & 7;
      float f[8]; unpack8(rx[e], f); const float d = sDt[it];
#pragma unroll
      for (int q = 0; q < 8; ++q) f[q] *= d;
      *reinterpret_cast<u32x4*>(lds + SS_XV + (it >> 6) * 8192 + v_st2(it & 63, c * 8)) = pack8(f); }
    { bf16_t* sb = (bf16_t*)(lds + SS_SB);
#pragma unroll
      for (int r = 0; r < 16; ++r) sb[(s_pt * 32 + crow(r, hi)) * 136 + s_nt * 32 + l31] = f2bf(S[r]); }
    __syncthreads();
    f32x16 cbt[2], y;
#pragma unroll
    for (int r = 0; r < 16; ++r) { cbt[0][r] = 0.f; cbt[1][r] = 0.f; y[r] = 0.f; }
#pragma unroll
    for (int s = 0; s < 8; ++s) {
      const int co = (s * 16 + hi * 8) * 2;
      bf16x8 cmy = *reinterpret_cast<const bf16x8*>(lds + SS_CM + (y_it * 32 + l31) * 272 + co);
      bf16x8 sbv = *reinterpret_cast<const bf16x8*>(lds + SS_SB + (y_pt * 32 + l31) * 272 + co);
      y = mfma32(cmy, sbv, y);
#pragma unroll
      for (int u = 0; u < 2; ++u) { const int t_ = wid + u * 8; const int jt = t_ >> 2, it_ = t_ & 3;
        bf16x8 av = *reinterpret_cast<const bf16x8*>(lds + SS_BM + (jt * 32 + l31) * 272 + co);
        bf16x8 bv = *reinterpret_cast<const bf16x8*>(lds + SS_CM + (it_ * 32 + l31) * 272 + co);
        cbt[u] = mfma32(av, bv, cbt[u]); }
      __builtin_amdgcn_sched_barrier(0);
    }
#pragma unroll
    for (int r = 0; r < 16; ++r) y[r] *= __expf(sAcs[y_it * 32 + crow(r, hi)]);
    __syncthreads();
#pragma unroll
    for (int u = 0; u < 2; ++u) { const int t_ = wid + u * 8; const int jt = t_ >> 2, it_ = t_ & 3;
      const int i = it_ * 32 + l31; const float ai = sAcs[i];
#pragma unroll
      for (int q = 0; q < 4; ++q) {
        const int j0 = jt * 32 + 8 * q + 4 * hi; float g[4];
#pragma unroll
        for (int e = 0; e < 4; ++e) { const int j = j0 + e; g[e] = (j <= i) ? cbt[u][4 * q + e] * __expf(ai - sAcs[j]) : 0.f; }
        u32x2 w = {cvtpk(g[0], g[1]), cvtpk(g[2], g[3])};
        *reinterpret_cast<u32x2*>(lds + SS_BM + i * 272 + j0 * 2) = w;
      } }
    __syncthreads();
    const float dec = __expf(acs_last);
#pragma unroll
    for (int r = 0; r < 16; ++r) S[r] *= dec;
    { const int vrb = v_rd_base(lane);
      const int vbx_y = (int)(uintptr_t)(lds + SS_XV) + vrb + y_pt * 512, vbx_s = (int)(uintptr_t)(lds + SS_XV) + vrb + s_pt * 512, vbw_s = (int)(uintptr_t)(lds + SS_BW) + vrb + s_nt * 512;
#define PK_(L, H) (bf16x8){L[0], L[1], L[2], L[3], H[0], H[1], H[2], H[3]}
#define SSD_STEP(T, KS) do { \
      const bf16x8 gv = *reinterpret_cast<const bf16x8*>(lds + SS_BM + (y_it * 32 + l31) * 272 + (((T) * 4 + (KS)) * 16 + hi * 8) * 2); \
      const s16x4 xl = tr_read<(T) * 8192 + (KS) * 2048>(vbx_y), xh = tr_read<(T) * 8192 + (KS) * 2048 + 1024>(vbx_y); \
      const s16x4 al = tr_read<(T) * 8192 + (KS) * 2048>(vbx_s), ah = tr_read<(T) * 8192 + (KS) * 2048 + 1024>(vbx_s); \
      const s16x4 wl = tr_read<(T) * 16384 + (KS) * 4096>(vbw_s), wh = tr_read<(T) * 16384 + (KS) * 4096 + 2048>(vbw_s); \
      asm volatile("s_waitcnt lgkmcnt(0)" ::: "memory"); __builtin_amdgcn_sched_barrier(0); \
      y = mfma32(gv, PK_(xl, xh), y); S = mfma32(PK_(al, ah), PK_(wl, wh), S); } while (0)
      SSD_STEP(0, 0); SSD_STEP(0, 1); SSD_STEP(0, 2); SSD_STEP(0, 3); SSD_STEP(1, 0); SSD_STEP(1, 1); SSD_STEP(1, 2); SSD_STEP(1, 3);
#undef SSD_STEP
#undef PK_
    }
#pragma unroll
    for (int r = 0; r < 16; ++r) { const int i = y_it * 32 + crow(r, hi); const int prow = base + (dir ? 127 - i : i);
      Y[(unsigned)(prow * 512 + h * 64 + y_pt * 32 + l31)] = f2bf(y[r]); }
  }
#undef SSD_LOAD
#undef SSD_BASE
}

__device__ __forceinline__ void sgu_item(const Params& p, int layer, int chunk, char* lds) {
  char* ws = p.ws;
  const int tid = otid(), wid = tid >> 6, lane = tid & 63, l31 = lane & 31, hi = lane >> 5;
  const bf16_t* P = (const bf16_t*)(ws + WS_P); bf16_t* SG = (bf16_t*)(ws + WS_SGUO);
  const int r0 = chunk * 128;
  float* sR = (float*)(lds + 69632);
  __syncthreads();
  { const int row = tid >> 2, q = tid & 3; const bf16_t* pr = P + (size_t)(r0 + row) * PLD + OFF_SGU + 512 + q * 128; float ss = 0.f;
    for (int c = 0; c < 16; ++c) { float f[8]; unpack8(*reinterpret_cast<const u32x4*>(pr + c * 8), f);
#pragma unroll
      for (int e = 0; e < 8; ++e) { float g = gelu_f(f[e]); ss += g * g; } }
    ss += __shfl_xor(ss, 1); ss += __shfl_xor(ss, 2);
    if (q == 0) sR[row] = rsqrtf(ss * (1.f / 512.f) + EPS); }
  __syncthreads();
  const int it = wid >> 1, dt0 = (wid & 1) * 2;
  for (int g = 0; g < 4; ++g) {
    const float* wsrc = p.sgu_w + ((size_t)layer * 4 + g) * 128 * 128;
#pragma unroll
    for (int e = 0; e < 8; ++e) { int id = tid + e * NTHR; int i = id >> 5, j4 = (id & 31) * 4; float4 v = *reinterpret_cast<const float4*>(wsrc + i * 128 + j4);
      u32x2 w = {cvtpk(v.x, v.y), cvtpk(v.z, v.w)}; *reinterpret_cast<u32x2*>(lds + i * 272 + j4 * 2) = w; }
#pragma unroll
    for (int e = 0; e < 4; ++e) { int id = tid + e * NTHR; int j = id >> 4, c = id & 15; float f[8];
      unpack8(*reinterpret_cast<const u32x4*>(P + (size_t)(r0 + j) * PLD + OFF_SGU + 512 + g * 128 + c * 8), f);
      const float rs = sR[j]; bf16_t* bt = (bf16_t*)(lds + 34816);
#pragma unroll
      for (int q = 0; q < 8; ++q) { const int d = c * 8 + q; bt[d * 136 + j] = f2bf(gelu_f(f[q]) * rs * p.sgu_norm[layer * 512 + g * 128 + d]); } }
    __syncthreads();
    f32x16 acc[2];
#pragma unroll
    for (int r = 0; r < 16; ++r) { acc[0][r] = 0.f; acc[1][r] = 0.f; }
#pragma unroll
    for (int s = 0; s < 8; ++s) { const int co = (s * 16 + hi * 8) * 2;
      bf16x8 av = *reinterpret_cast<const bf16x8*>(lds + (it * 32 + l31) * 272 + co);
#pragma unroll
      for (int u = 0; u < 2; ++u) { bf16x8 bv = *reinterpret_cast<const bf16x8*>(lds + 34816 + ((dt0 + u) * 32 + l31) * 272 + co); acc[u] = mfma32(av, bv, acc[u]); } }
#pragma unroll
    for (int u = 0; u < 2; ++u)
#pragma unroll
      for (int r = 0; r < 16; ++r) { const int i = it * 32 + crow(r, hi); const int d = (dt0 + u) * 32 + l31;
        const float uu = gelu_f(bf2f(P[(size_t)(r0 + i) * PLD + OFF_SGU + g * 128 + d]));
        SG[(size_t)(r0 + i) * 512 + g * 128 + d] = f2bf(uu * (acc[u][r] + p.sgu_b[((size_t)layer * 4 + g) * 128 + i])); }
    __syncthreads();
  }
}

__device__ __forceinline__ void phase_mixers(const Params& p, int layer, char* lds, int rep) {
  char* ws = p.ws;
  volatile int* s_item_p = (volatile int*)(lds + LDS_BYTES + 8);
#define s_item (*s_item_p)
  int* ctr = (int*)(ws + WS_CTR) + layer + 2 * rep;
  const int n_ssd = 32, n_attl = 1024, n_attc = layer == 0 ? 16 : 0, n_sgu = layer == 0 ? 132 : 128;
  const int total = n_ssd + n_attl + n_attc + n_sgu;
  float* ML = (float*)(ws + WS_ML);
  for (;;) {
    __syncthreads();
    if (threadIdx.x == 0) s_item = atomicAdd(ctr, 1);
    __syncthreads();
    int it = s_item;
    if (it >= total) break;
    if (it < n_ssd) { ssd_item(p, layer, it, lds); continue; } it -= n_ssd;
    if (it < n_attl) {
      const int bh = it >> 6, qb = (it >> 1) & 31, sp = it & 1, b = bh >> 3, h = bh & 7;
      const size_t t0 = (size_t)b * SEQ + qb * 256;
      attn_item((const bf16_t*)(ws + WS_Q) + ((size_t)bh * SEQ + qb * 256) * 192, (const bf16_t*)(ws + WS_K) + ((size_t)bh * NKEYS + sp * (NKEYS / 2)) * 192,
                (const bf16_t*)(ws + WS_V) + ((size_t)bh * NKEYS + sp * (NKEYS / 2)) * 128, NKEYS / 2,
                (bf16_t*)(ws + (sp ? WS_ATT1 : WS_ATT)) + t0 * 1024 + h * 128, ML + ((size_t)sp * T_ALL + t0) * 16 + h * 2, lds);
      continue; } it -= n_attl;
    if (it < n_attc) {
      const int bh = it, b = bh >> 3, h = bh & 7; const size_t t0 = (size_t)T_LAT + b * CTXL;
      attn_item((const bf16_t*)(ws + WS_QC) + (size_t)bh * CTXL * 192, (const bf16_t*)(ws + WS_K) + (size_t)bh * NKEYS * 192,
                (const bf16_t*)(ws + WS_V) + (size_t)bh * NKEYS * 128, CTXL, (bf16_t*)(ws + WS_ATT) + t0 * 1024 + h * 128, ML + t0 * 16 + h * 2, lds);
      if (threadIdx.x < 256) { float* mp = ML + ((size_t)T_ALL + t0 + threadIdx.x) * 16 + h * 2; mp[0] = 0.f; mp[1] = 0.f; }
      continue; } it -= n_attc;
    sgu_item(p, layer, it, lds);
  }
#undef s_item
}

__device__ __forceinline__ void phase_cat(const Params& p, int layer, int nrows) {
  char* ws = p.ws;
  const int tid = otid(), lane = tid & 63, wid = tid >> 6;
  const bf16_t* ATT = (const bf16_t*)(ws + WS_ATT); const bf16_t* SG = (const bf16_t*)(ws + WS_SGUO);
  const bf16_t* YF = (const bf16_t*)(ws + WS_YF); const bf16_t* YB = (const bf16_t*)(ws + WS_YB);
  const bf16_t* XBC = (const bf16_t*)(ws + WS_XBC); const bf16_t* P = (const bf16_t*)(ws + WS_P);
  bf16_t* CAT = (bf16_t*)(ws + WS_H);
  const float* an = p.attn_out_norm + layer * 1024; const float* gn = p.gmlp_out_norm + layer * 512; const float* sn = p.ssd_norm + layer * 512;
  for (int t = blockIdx.x * 8 + wid; t < nrows; t += gridDim.x * 8) {
    float a0[8], a1[8], sg[8], y[8];
    unpack8(*reinterpret_cast<const u32x4*>(ATT + (size_t)t * 1024 + lane * 8), a0);
    unpack8(*reinterpret_cast<const u32x4*>(ATT + (size_t)t * 1024 + 512 + lane * 8), a1);
    {
      const float* ML = (const float*)(ws + WS_ML); const bf16_t* ATT1 = (const bf16_t*)(ws + WS_ATT1);
#pragma unroll
      for (int hh = 0; hh < 2; ++hh) { const int h = hh * 4 + (lane >> 4);
        const float m0 = ML[((size_t)t) * 16 + h * 2], l0 = ML[((size_t)t) * 16 + h * 2 + 1];
        const float m1 = ML[((size_t)T_ALL + t) * 16 + h * 2], l1 = ML[((size_t)T_ALL + t) * 16 + h * 2 + 1];
        if (l1 > 0.f) { const float M = fmaxf(m0, m1); const float w0 = l0 * __builtin_amdgcn_exp2f(m0 - M), w1 = l1 * __builtin_amdgcn_exp2f(m1 - M);
          const float inv = 1.f / (w0 + w1); float b1[8];
          unpack8(*reinterpret_cast<const u32x4*>(ATT1 + (size_t)t * 1024 + hh * 512 + lane * 8), b1);
          float* av = hh ? a1 : a0;
#pragma unroll
          for (int e = 0; e < 8; ++e) av[e] = (av[e] * w0 + b1[e] * w1) * inv; } } }
    unpack8(*reinterpret_cast<const u32x4*>(SG + (size_t)t * 512 + lane * 8), sg);
    float xs[8], z[8];
    unpack8(*reinterpret_cast<const u32x4*>(XBC + (size_t)t * 1024 + lane * 8), xs);
    unpack8(*reinterpret_cast<const u32x4*>(P + (size_t)t * PLD + OFF_Z + lane * 8), z);
    const float dsk = p.ssd_d[layer * 8 + (lane >> 3)];
    float yf[8], yb[8];
    unpack8(*reinterpret_cast<const u32x4*>(YF + (size_t)t * 512 + lane * 8), yf);
    unpack8(*reinterpret_cast<const u32x4*>(YB + (size_t)t * 512 + lane * 8), yb);
    float sa = 0.f, ssg = 0.f, sy = 0.f;
#pragma unroll
    for (int e = 0; e < 8; ++e) {
      y[e] = (yf[e] + yb[e] + dsk * xs[e]) * silu_f(z[e]);
      sa += a0[e] * a0[e] + a1[e] * a1[e]; ssg += sg[e] * sg[e]; sy += y[e] * y[e];
    }
    sa = wave_sum(sa); ssg = wave_sum(ssg); sy = wave_sum(sy);
    const float ra = rsqrtf(sa * (1.f / 1024.f) + EPS), rg = rsqrtf(ssg * (1.f / 512.f) + EPS), ry = rsqrtf(sy * (1.f / 512.f) + EPS);
#pragma unroll
    for (int e = 0; e < 8; ++e) {
      a0[e] *= ra * an[lane * 8 + e]; a1[e] *= ra * an[512 + lane * 8 + e];
      sg[e] *= rg * gn[lane * 8 + e]; y[e] *= ry * sn[lane * 8 + e];
    }
    bf16_t* cr = CAT + (size_t)t * HLD;
    *reinterpret_cast<u32x4*>(cr + lane * 8) = pack8(a0);
    *reinterpret_cast<u32x4*>(cr + 512 + lane * 8) = pack8(a1);
    *reinterpret_cast<u32x4*>(cr + 1024 + lane * 8) = pack8(sg);
    *reinterpret_cast<u32x4*>(cr + 1536 + lane * 8) = pack8(y);
  }
}

__device__ __forceinline__ void phase_gemm_out(const Params& p, int layer, int nrows, char* lds) {
  char* ws = p.ws;
  float* X = (float*)(ws + WS_X);
  const float* mods = (const float*)(ws + WS_MODS) + (size_t)layer * 3 * 12288 + 2 * DM;
  const float* xin = p.x; const float* cin = p.ctx;
  SchedRes S{ws + WS_H, ws + WS_WOUT, HLD, WLD, DM / 64, nrows > T_LAT ? 16 : 0};
  float* PART = (float*)(ws + WS_PART);
  auto epi = [=](const pg::f32x4 (&acc)[2][2][4][2], const pg::Unit& u, int wr, int wc, int fr, int fq) {
    const float* g1 = mods + mod_idx(u.m0) * 12288;
    const float* xsrc = layer == 0 ? (u.m0 < T_LAT ? xin : cin - (size_t)T_LAT * DM) : X;
    const int row0 = u.m0 + wr * 64 + fr;
#pragma unroll
    for (int bj = 0; bj < 2; ++bj)
#pragma unroll
      for (int n = 0; n < 2; ++n) { const int c = u.n0 + bj * 128 + wc * 32 + n * 16 + 4 * fq;
        const pg::f32x4 g = *reinterpret_cast<const pg::f32x4*>(g1 + c);
#pragma unroll
        for (int ai = 0; ai < 2; ++ai)
#pragma unroll
          for (int m = 0; m < 4; ++m) { const size_t o = (size_t)(row0 + ai * 128 + m * 16) * DM + c;
            if (u.tag) *reinterpret_cast<pg::f32x4*>(PART + o + (size_t)((u.tag - 1) * 512 - T_LAT) * DM) = acc[ai][bj][m][n];
            else { const pg::f32x4 xo = *reinterpret_cast<const pg::f32x4*>(xsrc + o);
              *reinterpret_cast<pg::f32x4*>(X + o) = xo + g * acc[ai][bj][m][n]; } } }
  };
  pg::gemm_phase<false>((LAS unsigned char*)lds, HLD, WLD, S, epi);
}

struct SchedFFN1 {
  const char* H2; const char* W; int MT;
  __device__ __forceinline__ bool next(int i, pg::Unit& u) const {
    int mt, ntl; if (!tile_of(i, MT, 44, mt, ntl)) return false;
    u.m0 = mt * 254 - 1; u.n0 = ntl * 256; u.a = H2 + (long)u.m0 * (HLD * 2); u.b = W + (size_t)u.n0 * WLD * 2; u.nt = DM / 64; u.tag = 0; return true; }
};
__device__ __forceinline__ float dpp_ror1(float v) { return __int_as_float(__builtin_amdgcn_update_dpp(0, __float_as_int(v), 0x121, 0xf, 0xf, false)); }
__device__ __forceinline__ float dpp_ror15(float v) { return __int_as_float(__builtin_amdgcn_update_dpp(0, __float_as_int(v), 0x12f, 0xf, 0xf, false)); }
__device__ __forceinline__ void phase_gemm_ffn1(const Params& p, int layer, int nrows, char* lds) {
  char* ws = p.ws;
  bf16_t* ACT = (bf16_t*)(ws + WS_ACT);
  const float* cw = p.ffn_conv_w + (size_t)layer * 3 * FFN; const float* cb = p.ffn_conv_b + (size_t)layer * FFN;
  SchedFFN1 S{ws + WS_H, ws + WS_WGU, (nrows + 253) / 254};
  float* EX = (float*)(lds + 131072);
  auto epi = [=](const pg::f32x4 (&acc)[2][2][4][2], const pg::Unit& u, int wr, int wc, int fr, int fq) {
    const int ccb = 32 * wc + 8 * fq;
#pragma unroll
    for (int ai = 0; ai < 2; ++ai) { const int q = 2 * ai + wr;
      if (fr == 0) {
#pragma unroll
        for (int n = 0; n < 2; ++n) *reinterpret_cast<pg::f32x4*>(EX + (q * 2 + 0) * 128 + ccb + 4 * n) = acc[ai][0][0][n]; }
      if (fr == 15) {
#pragma unroll
        for (int n = 0; n < 2; ++n) *reinterpret_cast<pg::f32x4*>(EX + (q * 2 + 1) * 128 + ccb + 4 * n) = acc[ai][0][3][n]; } }
    asm volatile("s_waitcnt lgkmcnt(0)" ::: "memory");
    __builtin_amdgcn_s_barrier(); asm volatile("" ::: "memory");
    __builtin_amdgcn_s_barrier(); asm volatile("" ::: "memory");
    const int ch0 = (u.n0 >> 1) + ccb;
#pragma unroll
    for (int n = 0; n < 2; ++n) {
      const pg::f32x4 w0 = *reinterpret_cast<const pg::f32x4*>(cw + ch0 + 4 * n), w1 = *reinterpret_cast<const pg::f32x4*>(cw + FFN + ch0 + 4 * n);
      const pg::f32x4 w2 = *reinterpret_cast<const pg::f32x4*>(cw + 2 * FFN + ch0 + 4 * n), bb = *reinterpret_cast<const pg::f32x4*>(cb + ch0 + 4 * n);
#pragma unroll
      for (int ai = 0; ai < 2; ++ai) { const int q = 2 * ai + wr;
        float o[4][4]; bool zp[4], zn[4];
#pragma unroll
        for (int m = 0; m < 4; ++m) { const int t = u.m0 + 128 * ai + 64 * wr + 16 * m + fr; const bool tv = t >= 0 && t < nrows;
          zp[m] = !tv || seq_start(t); zn[m] = !tv || seq_end(t); }
#pragma unroll
        for (int j = 0; j < 4; ++j) {
          float R[4], L[4];
#pragma unroll
          for (int m = 0; m < 4; ++m) { R[m] = dpp_ror1(acc[ai][0][m][n][j]); L[m] = dpp_ror15(acc[ai][0][m][n][j]); }
          const float exp_ = q > 0 ? EX[((q - 1) * 2 + 1) * 128 + ccb + 4 * n + j] : 0.f;
          const float exn_ = q < 3 ? EX[((q + 1) * 2 + 0) * 128 + ccb + 4 * n + j] : 0.f;
#pragma unroll
          for (int m = 0; m < 4; ++m) {
            float pv = fr > 0 ? R[m] : (m > 0 ? R[m > 0 ? m - 1 : 0] : exp_);
            float nv = fr < 15 ? L[m] : (m < 3 ? L[m < 3 ? m + 1 : 3] : exn_);
            pv = zp[m] ? 0.f : pv; nv = zn[m] ? 0.f : nv;
            const float cv = bb[j] + w0[j] * pv + w1[j] * acc[ai][0][m][n][j] + w2[j] * nv;
            o[m][j] = cv * __builtin_amdgcn_rcpf(1.f + __builtin_amdgcn_exp2f(-1.4426950408889634f * cv)) * acc[ai][1][m][n][j];
          } }
#pragma unroll
        for (int m = 0; m < 4; ++m) { const int e = 128 * ai + 64 * wr + 16 * m + fr; const int t = u.m0 + e;
          if (e >= 1 && e <= 254 && t < nrows) { u32x2 w = {cvtpk(o[m][0], o[m][1]), cvtpk(o[m][2], o[m][3])}; *reinterpret_cast<u32x2*>(ACT + (size_t)t * FFN + ch0 + 4 * n) = w; } }
        __builtin_amdgcn_sched_barrier(0);
      }
    }
  };
  pg::gemm_phase<true>((LAS unsigned char*)lds, HLD, WLD, S, epi);
}

__device__ __forceinline__ void phase_gemm_down(const Params& p, int layer, int nrows, char* lds) {
  char* ws = p.ws;
  float* X = (float*)(ws + WS_X); float* out = p.out;
  const float* mods = (const float*)(ws + WS_MODS) + (size_t)layer * 3 * 12288 + 5 * DM;
  SchedRes S{ws + WS_ACT, ws + WS_WDN, FFN, FFN, FFN / 64, nrows > T_LAT ? 16 : 0};
  float* PART = (float*)(ws + WS_PART);
  auto epi = [=](const pg::f32x4 (&acc)[2][2][4][2], const pg::Unit& u, int wr, int wc, int fr, int fq) {
    const float* g2 = mods + mod_idx(u.m0) * 12288;
    float* dst = layer == 0 ? X : out;
    const int row0 = u.m0 + wr * 64 + fr;
#pragma unroll
    for (int bj = 0; bj < 2; ++bj)
#pragma unroll
      for (int n = 0; n < 2; ++n) { const int c = u.n0 + bj * 128 + wc * 32 + n * 16 + 4 * fq;
        const pg::f32x4 g = *reinterpret_cast<const pg::f32x4*>(g2 + c);
#pragma unroll
        for (int ai = 0; ai < 2; ++ai)
#pragma unroll
          for (int m = 0; m < 4; ++m) { const size_t o = (size_t)(row0 + ai * 128 + m * 16) * DM + c;
            if (u.tag) *reinterpret_cast<pg::f32x4*>(PART + o + (size_t)((u.tag - 1) * 512 - T_LAT) * DM) = acc[ai][bj][m][n];
            else { const pg::f32x4 xo = *reinterpret_cast<const pg::f32x4*>(X + o);
              *reinterpret_cast<pg::f32x4*>(dst + o) = xo + g * acc[ai][bj][m][n]; } } }
  };
  pg::gemm_phase<false>((LAS unsigned char*)lds, FFN, FFN, S, epi);
}

#ifndef DBG_NAN
#define DBG_NAN 0
#endif
#if DBG_NAN
__device__ __forceinline__ void nan_scan(const Params& p, size_t off, size_t n, int isbf, int code) {
  int* flags = (int*)(p.ws + WS_CTR) + 8;
  const char* base = p.ws + off; bool bad = false;
  for (size_t i = (size_t)blockIdx.x * NTHR + threadIdx.x; i < n; i += (size_t)gridDim.x * NTHR) {
    float v = isbf ? bf2f(((const bf16_t*)base)[i]) : ((const float*)base)[i];
    if (!(fabsf(v) < 1e30f)) bad = true;
  }
  if (bad) atomicMin(flags, code);
}
__device__ __forceinline__ void dbg_scan(const Params& p, int ph) {
  const int k = (ph + 1) * 10;
  if (ph == 0) { nan_scan(p, WS_MODS, 2 * 3 * 12288, 0, k); nan_scan(p, WS_ROPE, 4096, 0, k + 1); nan_scan(p, WS_WIN, (size_t)49152000, 1, k + 2); return; }
  const int layer = (ph - 1) / 10, s = (ph - 1) % 10; const size_t nr = layer == 0 ? T_ALL : T_LAT;
  switch (s) {
    case 0: nan_scan(p, WS_H, (size_t)T_ALL * DM, 1, k); break;
    case 1: nan_scan(p, WS_P, (size_t)T_ALL * PLD, 1, k); nan_scan(p, WS_DT, (size_t)T_ALL * 16, 0, k + 1); break;
    case 2: nan_scan(p, WS_QRAW, (size_t)T_ALL * 1536, 1, k); nan_scan(p, WS_KVRAW, (size_t)T_ALL * 2048, 1, k + 1); nan_scan(p, WS_RSTD, (size_t)T_ALL * 2, 0, k + 2);
            nan_scan(p, WS_XBC, (size_t)T_ALL * 1024, 1, k + 3); nan_scan(p, WS_DT, (size_t)T_ALL * 16, 0, k + 4); break;
    case 3: nan_scan(p, WS_Q, (size_t)16 * SEQ * 192, 1, k); nan_scan(p, WS_K, (size_t)16 * NKEYS * 192, 1, k + 1); nan_scan(p, WS_V, (size_t)16 * NKEYS * 128, 1, k + 2); break;
    case 4: nan_scan(p, WS_ATT, (size_t)T_LAT * 1024, 1, k); nan_scan(p, WS_SGUO, (size_t)T_LAT * 512, 1, k + 1); nan_scan(p, WS_YF, (size_t)T_ALL * 512, 0, k + 2); nan_scan(p, WS_YB, (size_t)T_ALL * 512, 0, k + 3); break;
    case 5: nan_scan(p, WS_H, nr * DM, 1, k); break;
    case 6: nan_scan(p, WS_X, nr * DM, 0, k); break;
    case 7: nan_scan(p, WS_H, nr * DM, 1, k); break;
    case 8: nan_scan(p, WS_ACT, nr * FFN, 1, k); break;
    default: if (layer == 0) nan_scan(p, WS_X, nr * DM, 0, k); break;
  }
}
#endif
typedef const __attribute__((address_space(4))) Params* KArgP;
__device__ __forceinline__ Params load_params() {
#if defined(__HIP_DEVICE_COMPILE__)
  KArgP q = (KArgP)__builtin_amdgcn_kernarg_segment_ptr(); asm volatile("" : "+s"(q));
  Params r; __builtin_memcpy(&r, q, sizeof(Params)); return r;
#else
  return Params{};
#endif
}
__device__ __forceinline__ void run_phase(int ph, char* lds, int rep) {
  if (ph == 0) { const Params p = load_params(); phase_prep(p, lds); return; }
  const int layer = (ph - 1) / 10, s = (ph - 1) % 10;
  const int nrows2 = layer == 0 ? T_ALL : T_LAT;
  switch (s) {
    case 0: { const Params p = load_params(); phase_norm_mod(p, layer, 0, T_ALL); if (layer == 1) convert_weights(p, 1, lds); } break;
    case 1: { const Params p = load_params(); phase_gemm_in(p, lds); } break;
    case 2: { const Params p = load_params(); phase_qkv_gemm_and_post(p, layer, lds); } break;
    case 3: { const Params p = load_params(); phase_build_qkv(p, layer); } break;
    case 4: { const Params p = load_params(); phase_mixers(p, layer, lds, rep); } break;
    case 5: { const Params p = load_params(); phase_cat(p, layer, nrows2); } break;
    case 6: { const Params p = load_params(); phase_gemm_out(p, layer, nrows2, lds); } break;
    case 7: { const Params p = load_params(); phase_norm_mod(p, layer, 1, nrows2); } break;
    case 8: { const Params p = load_params(); phase_gemm_ffn1(p, layer, nrows2, lds); } break;
    default: { const Params p = load_params(); phase_gemm_down(p, layer, nrows2, lds); } break;
  }
}

__global__ void __launch_bounds__(NTHR) mega_fwd(Params p) {
  extern __shared__ __attribute__((aligned(16))) char lds[];
#if MULTI_LAUNCH
  run_phase((int)p.ph_lo, lds, 0);
#else
  cg::grid_group grid = cg::this_grid();
  unsigned* bar_st = (unsigned*)(lds + LDS_BYTES);
  if (threadIdx.x < 4) bar_st[threadIdx.x] = 0u;
  __syncthreads();
  XcdBarrier xb = xcd_barrier_post((unsigned*)(p.ws + WS_BAR), (volatile LAS unsigned*)bar_st);
  for (int ph = 0; ph < 21; ++ph) {
#if REPEAT_MASK
    if (ph > 0 && ((REPEAT_MASK >> ((ph - 1) % 10)) & 1)) { run_phase(ph, lds, 1); xcd_barrier(xb); }
#endif
    run_phase(ph, lds, 0);
    if (ph == 0) grid.sync();
    else if (ph + 1 < 21) xcd_barrier(xb);
  }
#endif
}


#if DBG_NAN
__global__ void __launch_bounds__(NTHR) dbg_init_k(Params p) { ((int*)(p.ws + WS_CTR))[8] = 100000; }
__global__ void __launch_bounds__(NTHR) dbg_scan_k(Params p) { dbg_scan(p, (int)p.ph_lo); }
__global__ void __launch_bounds__(NTHR) dbg_report_k(Params p) {
  int code = ((int*)(p.ws + WS_CTR))[8];
  if (code < 100000) { float e = (float)(code / 10) * 0.5f; float c = sqrtf(1.27f) * __powf(10.f, e) * (1.f + 0.1f * (float)(code % 10));
    for (size_t i = (size_t)blockIdx.x * NTHR + threadIdx.x; i < (size_t)T_LAT * DM; i += (size_t)gridDim.x * NTHR) p.out[i] = c; }
}
#endif
extern "C" void kernel_launch(void* const* d_in, const int* in_sizes, int n_in, void* d_out, int out_size, void* d_ws, size_t ws_size, hipStream_t stream) {
  static int grid_blocks = 0;
  if (grid_blocks == 0) {
    if (n_in != 32 || out_size != T_LAT * DM || ws_size < WS_END) {
      fprintf(stderr, "kernel_launch: bad shapes: n_in %d out %d ws %zu (need %zu)\n", n_in, out_size, ws_size, (size_t)WS_END); grid_blocks = -1; return; }
    int dev = 0, cus = 0, per_cu = 0;
    hipGetDevice(&dev); hipDeviceGetAttribute(&cus, hipDeviceAttributeMultiprocessorCount, dev);
    hipFuncSetAttribute((const void*)mega_fwd, hipFuncAttributeMaxDynamicSharedMemorySize, LDS_DYN);
    hipOccupancyMaxActiveBlocksPerMultiprocessor(&per_cu, (const void*)mega_fwd, NTHR, LDS_DYN);
    if (per_cu < 1) { fprintf(stderr, "kernel_launch: occupancy query says %d blocks/CU\n", per_cu); per_cu = 1; }
    grid_blocks = cus * per_cu;
  }
  if (grid_blocks < 0) return;
  Params p{};
  const float** pp = (const float**)&p;
  for (int i = 0; i < 32; ++i) pp[i] = (const float*)d_in[i];
  p.out = (float*)d_out; p.ws = (char*)d_ws; p.ph_lo = 0; p.ph_hi = 21;
#if MULTI_LAUNCH
  for (int ph = 0; ph < 21; ++ph) { p.ph_lo = ph; p.ph_hi = ph + 1; hipLaunchKernelGGL(mega_fwd, dim3(grid_blocks), dim3(NTHR), LDS_DYN, stream, p);
#if DBG_NAN
    if (ph == 0) hipLaunchKernelGGL(dbg_init_k, dim3(1), dim3(1), 0, stream, p);
    hipLaunchKernelGGL(dbg_scan_k, dim3(grid_blocks), dim3(NTHR), 0, stream, p);
#endif
  }
#if DBG_NAN
  hipLaunchKernelGGL(dbg_report_k, dim3(grid_blocks), dim3(NTHR), 0, stream, p);
#endif
#else
  hipMemsetAsync((char*)d_ws + WS_BAR, 0, XCD_BAR_WORDS * 4, stream);
  void* args[] = {&p};
  hipError_t e = hipLaunchCooperativeKernel((const void*)mega_fwd, dim3(grid_blocks), dim3(NTHR), args, LDS_DYN, stream);
  if (e != hipSuccess) fprintf(stderr, "cooperative launch failed: %s (grid %d)\n", hipGetErrorString(e), grid_blocks);
#endif
}
```

```cpp
#include <hip/hip_runtime.h>
#include <hip/hip_cooperative_groups.h>
#include <cstdio>
#include <cstdint>
namespace cg = cooperative_groups;

#ifndef REPEAT_MASK
#define REPEAT_MASK 0
#endif
#ifndef MULTI_LAUNCH
#define MULTI_LAUNCH 0
#endif

typedef unsigned short bf16_t;
using bf16x8 = __attribute__((ext_vector_type(8))) short;
using s16x4  = __attribute__((ext_vector_type(4))) short;
using f32x16 = __attribute__((ext_vector_type(16))) float;
using u32x4  = __attribute__((ext_vector_type(4))) unsigned;
using u32x2  = __attribute__((ext_vector_type(2))) unsigned;

constexpr int NTHR = 512;
constexpr int DM = 2048, SEQ = 8192, CTXL = 256, NB = 2;
constexpr int T_LAT = NB * SEQ;
constexpr int T_ALL = T_LAT + NB * CTXL;
constexpr int PIN = 3920, PLD = 3968, PNP = 4096;
constexpr int OFF_CKV = 768, OFF_KR = 1280, OFF_SGU = 1344, OFF_Z = 2368, OFF_XBC = 2880, OFF_DT = 3904;
constexpr int FFN = 5632;
constexpr int HLD = 2112, WLD = 2112, UKVLD = 768;
constexpr int NKEYS = CTXL + SEQ;
constexpr float EPS = 1e-6f;
constexpr float QSCALE = 0.07216878364870322f * 1.4426950408889634f;

constexpr size_t al256(size_t x) { return (x + 255) / 256 * 256; }
constexpr size_t WS_WIN  = 0;
constexpr size_t WS_WUQ  = WS_WIN  + (size_t)PNP * WLD * 2;
constexpr size_t WS_WUKV = WS_WUQ  + (size_t)1536 * 768 * 2;
constexpr size_t WS_WOUT = WS_WUKV + (size_t)2048 * UKVLD * 2;
constexpr size_t WS_WGU  = WS_WOUT + (size_t)2048 * WLD * 2;
constexpr size_t WS_WDN  = WS_WGU  + (size_t)2 * FFN * WLD * 2;
constexpr size_t WS_X    = WS_WDN  + (size_t)DM * FFN * 2;
constexpr size_t WS_MODS = WS_X    + (size_t)T_ALL * DM * 4;
constexpr size_t WS_ROPE = WS_MODS + (size_t)2 * 3 * 12288 * 4;
constexpr size_t WS_CTR  = WS_ROPE + (size_t)128 * 16 * 2 * 4;
constexpr size_t WS_BAR  = al256(WS_CTR + 256);
constexpr size_t WS_A1   = al256(WS_BAR + 3456 * 4);
constexpr size_t WS_P    = WS_A1;
constexpr size_t WS_DT   = WS_P    + (size_t)T_ALL * PLD * 2;
constexpr size_t WS_RSTD = WS_DT   + (size_t)T_ALL * 16 * 4;
constexpr size_t WS_A2   = al256(WS_RSTD + (size_t)T_ALL * 2 * 4);
constexpr size_t WS_QRAW = WS_A2;
constexpr size_t WS_KVRAW= WS_QRAW + (size_t)T_ALL * 1536 * 2;
constexpr size_t WS_A2END= WS_KVRAW+ (size_t)T_ALL * 2048 * 2;
constexpr size_t WS_ATT  = WS_A2;
constexpr size_t WS_SGUO = WS_ATT  + (size_t)T_ALL * 1024 * 2;
constexpr size_t WS_YF   = WS_SGUO + (size_t)T_ALL * 512 * 2;
constexpr size_t WS_YB   = WS_YF   + (size_t)T_ALL * 512 * 2;
static_assert(WS_YB + (size_t)T_ALL * 512 * 2 <= WS_A2END, "A2 alias overflow");
constexpr size_t WS_XBC  = al256(WS_A2END);
constexpr size_t WS_A4   = al256(WS_XBC + (size_t)T_ALL * 1024 * 2);
constexpr size_t WS_Q    = WS_A4;
constexpr size_t WS_QC   = WS_Q    + (size_t)16 * SEQ * 192 * 2;
constexpr size_t WS_K    = WS_QC   + (size_t)16 * CTXL * 192 * 2;
constexpr size_t WS_V    = WS_K    + (size_t)16 * NKEYS * 192 * 2;
constexpr size_t WS_END0 = al256(WS_V + (size_t)16 * NKEYS * 128 * 2);
constexpr size_t WS_ATT1 = WS_END0;
constexpr size_t WS_ML   = WS_ATT1 + (size_t)T_ALL * 1024 * 2;
constexpr size_t WS_PART = al256(WS_ML + (size_t)2 * T_ALL * 8 * 2 * 4);
constexpr size_t WS_END  = al256(WS_PART + (size_t)4 * 512 * DM * 4);
constexpr size_t WS_H    = WS_A4;
constexpr size_t WS_ACT  = WS_A1;
static_assert(WS_ACT + (size_t)T_ALL * FFN * 2 <= WS_XBC + (size_t)T_ALL * 1024 * 2, "ACT alias overflow");
static_assert((size_t)T_ALL * HLD * 2 <= WS_END - WS_A4, "H alias overflow");

constexpr int LDS_BYTES = 140800;
constexpr int LDS_DYN = LDS_BYTES + 16;

struct Params {
  const float *x, *c, *ctx, *c_ctx, *w_mod, *b_mod, *norm_mix, *norm_ffn, *w_in, *q_a_norm, *w_uq, *kv_a_norm, *w_ukv,
              *q_norm, *k_norm, *attn_out_norm, *sgu_norm, *sgu_w, *sgu_b, *gmlp_out_norm, *ssd_conv_w, *ssd_conv_b,
              *ssd_dt_bias, *ssd_a_log, *ssd_d, *ssd_norm, *w_out, *ffn_w_gate, *ffn_w_up, *ffn_conv_w, *ffn_conv_b, *ffn_w_down;
  float* out; char* ws;
  long long ph_lo, ph_hi;
};

__device__ __forceinline__ int otid() { int t = threadIdx.x; asm volatile("" : "+v"(t)); return t; }
typedef float f32x2_t __attribute__((ext_vector_type(2)));
typedef __bf16 bf16x2_t __attribute__((ext_vector_type(2)));
__device__ __forceinline__ unsigned cvtpk(float lo, float hi) {
  f32x2_t v = {lo, hi}; bf16x2_t r = __builtin_convertvector(v, bf16x2_t);
  return __builtin_bit_cast(unsigned, r);
}
__device__ __forceinline__ bf16_t f2bf(float x) { return __builtin_bit_cast(bf16_t, (__bf16)x); }
__device__ __forceinline__ float bf2f(bf16_t b) { return __uint_as_float(((unsigned)b) << 16); }
__device__ __forceinline__ float bflo(unsigned w) { return __uint_as_float(w << 16); }
__device__ __forceinline__ float bfhi(unsigned w) { return __uint_as_float(w & 0xffff0000u); }
__device__ __forceinline__ void unpack8(u32x4 w, float* f) {
  f[0] = bflo(w[0]); f[1] = bfhi(w[0]); f[2] = bflo(w[1]); f[3] = bfhi(w[1]);
  f[4] = bflo(w[2]); f[5] = bfhi(w[2]); f[6] = bflo(w[3]); f[7] = bfhi(w[3]);
}
__device__ __forceinline__ u32x4 pack8(const float* f) {
  u32x4 w = {cvtpk(f[0], f[1]), cvtpk(f[2], f[3]), cvtpk(f[4], f[5]), cvtpk(f[6], f[7])}; return w;
}
__device__ __forceinline__ float wave_sum(float v) {
  { auto rr = __builtin_amdgcn_permlane32_swap(__float_as_uint(v), __float_as_uint(v), false, false); v = __uint_as_float(rr[0]) + __uint_as_float(rr[1]); }
  { auto rr = __builtin_amdgcn_permlane16_swap(__float_as_uint(v), __float_as_uint(v), false, false); v = __uint_as_float(rr[0]) + __uint_as_float(rr[1]); }
  v += __int_as_float(__builtin_amdgcn_update_dpp(0, __float_as_int(v), 0x128, 0xf, 0xf, false));
  v += __int_as_float(__builtin_amdgcn_update_dpp(0, __float_as_int(v), 0x124, 0xf, 0xf, false));
  v += __int_as_float(__builtin_amdgcn_update_dpp(0, __float_as_int(v), 0x122, 0xf, 0xf, false));
  v += __int_as_float(__builtin_amdgcn_update_dpp(0, __float_as_int(v), 0x121, 0xf, 0xf, false));
  return v;
}
__device__ __forceinline__ float lane_xor16(float v, int lane) {
  auto rr = __builtin_amdgcn_permlane16_swap(__float_as_uint(v), __float_as_uint(v), false, false);
  return __uint_as_float(((lane >> 4) & 1) ? rr[0] : rr[1]);
}
__device__ __forceinline__ float silu_f(float x) { return x * __builtin_amdgcn_rcpf(1.f + __builtin_amdgcn_exp2f(-1.4426950408889634f * x)); }
__device__ __forceinline__ float gelu_f(float x) {
  float u = 0.7978845608028654f * (x + 0.044715f * x * x * x);
  float t = 1.f - 2.f * __builtin_amdgcn_rcpf(__builtin_amdgcn_exp2f(2.8853900817779268f * u) + 1.f);
  return 0.5f * x * (1.f + t);
}
__device__ __forceinline__ int crow(int r, int hi) { return (r & 3) + 8 * (r >> 2) + 4 * hi; }
__device__ __forceinline__ f32x16 mfma32(bf16x8 a, bf16x8 b, f32x16 c) { return __builtin_amdgcn_mfma_f32_32x32x16_bf16(a, b, c, 0, 0, 0); }
__device__ __forceinline__ bool seq_start(int t) { return t < T_LAT ? ((t & (SEQ - 1)) == 0) : (((t - T_LAT) & (CTXL - 1)) == 0); }
__device__ __forceinline__ bool seq_end(int t) { return t < T_LAT ? ((t & (SEQ - 1)) == SEQ - 1) : (((t - T_LAT) & (CTXL - 1)) == CTXL - 1); }
__device__ __forceinline__ int mod_idx(int row) { return row < SEQ ? 0 : (row < T_LAT ? 1 : 2); }

#define XB_TMO      128
#define XB_XCNT(j)  (256  + 64 * (j))
#define XB_XSUB(j)  (1280 + 64 * (j))
#define XB_XGEN(j)  (2304 + 64 * (j))
#define XB_TOP      3328
#define XB_TOPGEN   3392
#define XCD_BAR_WORDS 3456
#define XB_SPIN_CAP (1u << 24)
#define LAS __attribute__((address_space(3)))

__device__ __forceinline__ unsigned xb_ld(unsigned* p)              { return __hip_atomic_load(p, __ATOMIC_RELAXED, __HIP_MEMORY_SCOPE_AGENT); }
__device__ __forceinline__ unsigned xb_add(unsigned* p, unsigned v) { return __hip_atomic_fetch_add(p, v, __ATOMIC_RELAXED, __HIP_MEMORY_SCOPE_AGENT); }
__device__ __forceinline__ unsigned xb_xcc_id() { return (unsigned)__builtin_amdgcn_s_getreg((3 << 11) | 20) & 0xFu; }
#define XB_SPIN(cond, bar) do { unsigned _sp = 0; while (cond) { __builtin_amdgcn_s_sleep(1); \
    if ((++_sp & 255u) == 0u) { if (xb_ld(&(bar)[XB_TMO])) break; if (_sp > XB_SPIN_CAP) { atomicAdd(&(bar)[XB_TMO], 1u); break; } } } } while (0)

struct XcdBarrier {
    unsigned* bar; unsigned x;
    volatile LAS unsigned* st;
};

__device__ __forceinline__ XcdBarrier xcd_barrier_post(unsigned* bar, volatile LAS unsigned* st) {
    XcdBarrier b; b.bar = bar; b.x = xb_xcc_id(); b.st = st;
    if (threadIdx.x == 0) (void)xb_add(&bar[XB_XCNT(b.x)], 1u);
    return b;
}
__device__ __forceinline__ void xcd_barrier_complete(unsigned* bar, unsigned x, unsigned& nloc, unsigned& nx) {
    const unsigned G = gridDim.x * gridDim.y * gridDim.z;
    unsigned sum, cnt, mine, sp = 0u;
    for (;;) {
        sum = 0u; cnt = 0u; mine = 0u;
#pragma unroll
        for (unsigned j = 0; j < 16; ++j) { const unsigned c = xb_ld(&bar[XB_XCNT(j)]); sum += c; cnt += (c > 0u) ? 1u : 0u; mine = (j == x) ? c : mine; }
        if (sum == G) break;
        __builtin_amdgcn_s_sleep(1);
        if ((++sp & 255u) == 0u) { if (xb_ld(&bar[XB_TMO])) break; if (sp > XB_SPIN_CAP) { atomicAdd(&bar[XB_TMO], 1u); break; } }
    }
    nloc = mine > 0u ? mine : 1u; nx = cnt > 0u ? cnt : 1u;
}

__device__ __forceinline__ void xcd_barrier(const XcdBarrier& b) {
    asm volatile("s_waitcnt vmcnt(0)" ::: "memory");
    __syncthreads();
    if (threadIdx.x == 0) {
        unsigned* bar = b.bar;
        __builtin_amdgcn_s_waitcnt(0);
        unsigned nloc = b.st[0], nx = b.st[1];
        if (nloc == 0u) { xcd_barrier_complete(bar, b.x, nloc, nx); b.st[0] = nloc; b.st[1] = nx; }
        const unsigned old = xb_add(&bar[XB_XSUB(b.x)], 1u);
        const unsigned gen = old / nloc;
        if (old + 1u == (gen + 1u) * nloc) {
            __builtin_amdgcn_fence(__ATOMIC_RELEASE, "agent");
            asm volatile("s_waitcnt vmcnt(0)" ::: "memory");
            const unsigned og = xb_add(&bar[XB_TOP], 1u);
            const unsigned tg = og / nx;
            if (og + 1u == (tg + 1u) * nx) xb_add(&bar[XB_TOPGEN], 1u);
            else XB_SPIN(xb_ld(&bar[XB_TOPGEN]) == tg, bar);
            __builtin_amdgcn_fence(__ATOMIC_ACQUIRE, "agent");
            xb_add(&bar[XB_XGEN(b.x)], 1u);
            asm volatile("s_waitcnt vmcnt(0)" ::: "memory");
        } else {
            XB_SPIN(xb_ld(&bar[XB_XGEN(b.x)]) == gen, bar);
            __builtin_amdgcn_fence(__ATOMIC_ACQUIRE, "agent");
            asm volatile("s_waitcnt vmcnt(0)" ::: "memory");
        }
    }
    __syncthreads();
}


__device__ __forceinline__ void convert_tile(const float* __restrict__ src, int K, int N, bf16_t* __restrict__ dst, int ldd, int mode, const float* __restrict__ kscale,
                             int tk, int tn, char* lds) {
  const int tid = otid();
  bf16_t* s = (bf16_t*)lds;
  __syncthreads();
  float v[16];
#pragma unroll
  for (int e = 0; e < 16; ++e) {
    const int id = tid + e * NTHR; const int n = id & 127, k = id >> 7;
    const int gk = tk * 64 + k, gn = tn * 128 + n;
    v[e] = gn < N ? src[(size_t)gk * N + gn] : 0.f;
    if (kscale) v[e] *= kscale[gk];
  }
#pragma unroll
  for (int e = 0; e < 16; ++e) { const int id = tid + e * NTHR; const int n = id & 127, k = id >> 7; s[n * 68 + k] = f2bf(v[e]); }
  __syncthreads();
#pragma unroll
  for (int e = 0; e < 2; ++e) {
    int id = tid + e * NTHR; int n = id >> 3, c = id & 7;
    int gn = tn * 128 + n; int drow;
    if (mode == 0) drow = gn;
    else { drow = (gn >> 7) * 256 + (mode == 2 ? 128 : 0) + (gn & 127); }
    const u32x2 a = *reinterpret_cast<const u32x2*>(s + n * 68 + c * 8), b = *reinterpret_cast<const u32x2*>(s + n * 68 + c * 8 + 4);
    u32x4 w = {a[0], a[1], b[0], b[1]};
    *reinterpret_cast<u32x4*>(dst + (size_t)drow * ldd + tk * 64 + c * 8) = w;
  }
}

__device__ __forceinline__ void convert_weights(const Params& p, int layer, char* lds) {
  char* ws = p.ws;
  const int n_in = 32 * 32, n_uq = 12 * 12, n_ukv = 8 * 16, n_out = 32 * 16, n_g = 32 * 44, n_dn = 88 * 16;
  const int total = n_in + n_uq + n_ukv + n_out + 2 * n_g + n_dn;
  for (int it = blockIdx.x; it < total; it += gridDim.x) {
    int i = it;
    if (i < n_in) { convert_tile(p.w_in + (size_t)layer * DM * PIN, DM, PIN, (bf16_t*)(ws + WS_WIN), WLD, 0, nullptr, i & 31, i >> 5, lds); continue; } i -= n_in;
    if (i < n_uq) { convert_tile(p.w_uq + (size_t)layer * 768 * 1536, 768, 1536, (bf16_t*)(ws + WS_WUQ), 768, 0, p.q_a_norm + layer * 768, i % 12, i / 12, lds); continue; } i -= n_uq;
    if (i < n_ukv) { convert_tile(p.w_ukv + (size_t)layer * 512 * 2048, 512, 2048, (bf16_t*)(ws + WS_WUKV), UKVLD, 0, p.kv_a_norm + layer * 512, i & 7, i >> 3, lds); continue; } i -= n_ukv;
    if (i < n_out) { convert_tile(p.w_out + (size_t)layer * DM * DM, DM, DM, (bf16_t*)(ws + WS_WOUT), WLD, 0, nullptr, i & 31, i >> 5, lds); continue; } i -= n_out;
    if (i < n_g) { convert_tile(p.ffn_w_gate + (size_t)layer * DM * FFN, DM, FFN, (bf16_t*)(ws + WS_WGU), WLD, 1, nullptr, i & 31, i >> 5, lds); continue; } i -= n_g;
    if (i < n_g) { convert_tile(p.ffn_w_up + (size_t)layer * DM * FFN, DM, FFN, (bf16_t*)(ws + WS_WGU), WLD, 2, nullptr, i & 31, i >> 5, lds); continue; } i -= n_g;
    convert_tile(p.ffn_w_down + (size_t)layer * FFN * DM, FFN, DM, (bf16_t*)(ws + WS_WDN), FFN, 0, nullptr, i % 88, i / 88, lds);
  }
}

__device__ __forceinline__ void sincos_small(float x, float& s, float& c) {
  float kf = rintf(x * 0.6366197723675814f); int k = (int)kf;
  float r = fmaf(-kf, 1.5707963705062866f, x); r = fmaf(-kf, -4.371139000186241e-8f, r);
  float r2 = r * r;
  float sp = r + r * r2 * (-1.6666654611e-1f + r2 * (8.3321608736e-3f + r2 * (-1.9515295891e-4f)));
  float cp = 1.f + r2 * (-0.5f + r2 * (4.166664568298827e-2f + r2 * (-1.388731625493765e-3f + r2 * 2.443315711809948e-5f)));
  int q = k & 3;
  float ss = (q & 1) ? cp : sp, cc = (q & 1) ? sp : cp;
  s = (q & 2) ? -ss : ss; c = ((q + 1) & 2) ? -cc : cc;
}

__device__ __forceinline__ void phase_prep(const Params& p, char* lds) {
  const int tid = otid(), lane = tid & 63, wid = tid >> 6;
  char* ws = p.ws;
  if (blockIdx.x == 0) {
    int* ctr = (int*)(ws + WS_CTR);
    if (tid < 64) ctr[tid] = 0;
    float* rope = (float*)(ws + WS_ROPE);
    for (int i = tid; i < 128 * 16; i += NTHR) {
      int pos = i >> 4, j = i & 15;
      float freq = exp2f(-(float)j * (13.287712379549449f / 16.f));
      float ang = (float)pos * freq; float s, c; sincos_small(ang, s, c);
      rope[i * 2] = c; rope[i * 2 + 1] = s;
    }
  }
  float* sc = (float*)lds;
  float* red = sc + 3 * 2048;
  __syncthreads();
  for (int i = tid; i < 3 * 2048; i += NTHR) {
    int j = i >> 11, k = i & 2047;
    float v = (j < 2) ? p.c[j * DM + k] : p.c_ctx[k];
    sc[i] = silu_f(v);
  }
  __syncthreads();
  float* mods = (float*)(ws + WS_MODS);
  for (int it = blockIdx.x; it < 2 * 192; it += gridDim.x) {
    int layer = it / 192, cg_ = it % 192; int n = cg_ * 64 + lane;
    const float* w = p.w_mod + (size_t)layer * DM * 12288 + n;
    float a0 = 0.f, a1 = 0.f, a2 = 0.f;
    int k0 = wid * 256;
    for (int kb = k0; kb < k0 + 256; kb += 32) {
      float wv[32];
#pragma unroll
      for (int u = 0; u < 32; ++u) wv[u] = w[(size_t)(kb + u) * 12288];
#pragma unroll
      for (int u = 0; u < 32; ++u) { a0 = fmaf(sc[kb + u], wv[u], a0); a1 = fmaf(sc[2048 + kb + u], wv[u], a1); a2 = fmaf(sc[4096 + kb + u], wv[u], a2); }
    }
    red[(wid * 3 + 0) * 64 + lane] = a0; red[(wid * 3 + 1) * 64 + lane] = a1; red[(wid * 3 + 2) * 64 + lane] = a2;
    __syncthreads();
    if (tid < 192) {
      int j = tid >> 6, l = tid & 63; float s = 0.f;
#pragma unroll
      for (int w8 = 0; w8 < 8; ++w8) s += red[(w8 * 3 + j) * 64 + l];
      int nn = cg_ * 64 + l;
      mods[(size_t)(layer * 3 + j) * 12288 + nn] = s + p.b_mod[layer * 12288 + nn];
    }
    __syncthreads();
  }
  convert_weights(p, 0, lds);
}

__device__ __forceinline__ void phase_norm_mod(const Params& p, int layer, int which, int nrows) {
  const int tid = otid(), lane = tid & 63, wid = tid >> 6;
  char* ws = p.ws;
  const float* gain = (which ? p.norm_ffn : p.norm_mix) + layer * DM;
  const float* mods = (const float*)(ws + WS_MODS) + (size_t)layer * 3 * 12288;
  const float* X = (const float*)(ws + WS_X);
  bf16_t* H = (bf16_t*)(ws + WS_H);
  for (int row = blockIdx.x * 8 + wid; row < nrows; row += gridDim.x * 8) {
    const float* src = (layer == 0 && which == 0) ? (row < T_LAT ? p.x + (size_t)row * DM : p.ctx + (size_t)(row - T_LAT) * DM) : X + (size_t)row * DM;
    const float* sh = mods + mod_idx(row) * 12288 + (which ? 3 : 0) * DM; const float* scl = sh + DM;
    float4 v[8]; float ss = 0.f;
    const bool comb = row >= T_LAT && ((layer == 0 && which == 1) || (layer == 1 && which == 0));
    if (comb) { src = which ? p.ctx + (size_t)(row - T_LAT) * DM : X + (size_t)row * DM; }
    const float* gate = (const float*)(ws + WS_MODS) + 2 * 12288 + (which ? 2 : 5) * DM;
    const float* part = (const float*)(ws + WS_PART) + (size_t)(row - T_LAT) * DM;
#pragma unroll
    for (int i = 0; i < 8; ++i) { v[i] = reinterpret_cast<const float4*>(src)[i * 64 + lane];
      if (comb) { const int n4 = i * 64 + lane; const float4 g4 = reinterpret_cast<const float4*>(gate)[n4];
        float4 s4 = reinterpret_cast<const float4*>(part)[n4];
#pragma unroll
        for (int q = 1; q < 4; ++q) { const float4 t4 = reinterpret_cast<const float4*>(part + (size_t)q * 512 * DM)[n4]; s4.x += t4.x; s4.y += t4.y; s4.z += t4.z; s4.w += t4.w; }
        v[i].x += g4.x * s4.x; v[i].y += g4.y * s4.y; v[i].z += g4.z * s4.z; v[i].w += g4.w * s4.w;
        if (which) reinterpret_cast<float4*>((float*)(ws + WS_X) + (size_t)row * DM)[n4] = v[i]; }
      ss += v[i].x * v[i].x + v[i].y * v[i].y + v[i].z * v[i].z + v[i].w * v[i].w; }
    ss = wave_sum(ss);
    float rstd = rsqrtf(ss * (1.f / DM) + EPS);
#pragma unroll
    for (int i = 0; i < 8; ++i) {
      int n = (i * 64 + lane) * 4;
      float4 g = *reinterpret_cast<const float4*>(gain + n), s4 = *reinterpret_cast<const float4*>(scl + n), h4 = *reinterpret_cast<const float4*>(sh + n);
      float y0 = v[i].x * rstd * g.x * (1.f + s4.x) + h4.x, y1 = v[i].y * rstd * g.y * (1.f + s4.y) + h4.y;
      float y2 = v[i].z * rstd * g.z * (1.f + s4.z) + h4.z, y3 = v[i].w * rstd * g.w * (1.f + s4.w) + h4.w;
      u32x2 o = {cvtpk(y0, y1), cvtpk(y2, y3)};
      *reinterpret_cast<u32x2*>(H + (size_t)row * HLD + n) = o;
    }
  }
}

template <int NTW, class Epi>
__device__ __forceinline__ void gemm_tile(const bf16_t* __restrict__ A, int lda, int arow0, int amax,
                                          const bf16_t* __restrict__ Bt, int ldb, int K, char* lds, Epi epi) {
  constexpr int NBL = 2 * NTW;
  constexpr int ABYTES = 256 * 128, BBYTES = 128 * NTW * 128, STAGE = ABYTES + BBYTES;
  const int tid = otid(), lane = tid & 63, wid = tid >> 6, l31 = lane & 31, hi = lane >> 5;
  const int wm = wid >> 2, wn = wid & 3;
  f32x16 acc[4][NTW];
#pragma unroll
  for (int i = 0; i < 4; ++i)
#pragma unroll
    for (int j = 0; j < NTW; ++j)
#pragma unroll
      for (int r = 0; r < 16; ++r) acc[i][j][r] = 0.f;
  const int lc = tid & 7, lr = tid >> 3;
  unsigned aoff[4], boff[NBL];
#pragma unroll
  for (int i = 0; i < 4; ++i) { int gr = arow0 + lr + 64 * i; gr = gr < 0 ? 0 : (gr > amax ? amax : gr); aoff[i] = (unsigned)gr * (unsigned)lda + (unsigned)(lc * 8); }
#pragma unroll
  for (int i = 0; i < NBL; ++i) boff[i] = (unsigned)(lr + 64 * i) * (unsigned)ldb + (unsigned)(lc * 8);
  const int wofs = lr * 128 + ((lc ^ ((lr >> 1) & 7)) << 4);
  u32x4 ra[4], rb[NBL];
  const int nk = K >> 6;
#pragma unroll
  for (int i = 0; i < 4; ++i) ra[i] = *reinterpret_cast<const u32x4*>(A + aoff[i]);
#pragma unroll
  for (int i = 0; i < NBL; ++i) rb[i] = *reinterpret_cast<const u32x4*>(Bt + boff[i]);
  __syncthreads();
#pragma unroll
  for (int i = 0; i < 4; ++i) *reinterpret_cast<u32x4*>(lds + wofs + i * 8192) = ra[i];
#pragma unroll
  for (int i = 0; i < NBL; ++i) *reinterpret_cast<u32x4*>(lds + ABYTES + wofs + i * 8192) = rb[i];
  __syncthreads();
  const int rsw = (l31 >> 1) & 7;
  const int a_base = (wm * 128 + l31) * 128, b_base = ABYTES + (wn * 32 * NTW + l31) * 128;
  for (int kt = 0; kt < nk; ++kt) {
    if (kt + 1 < nk) {
      const int ko = (kt + 1) * 64;
#pragma unroll
      for (int i = 0; i < 4; ++i) ra[i] = *reinterpret_cast<const u32x4*>(A + ko + aoff[i]);
#pragma unroll
      for (int i = 0; i < NBL; ++i) rb[i] = *reinterpret_cast<const u32x4*>(Bt + ko + boff[i]);
    }
    __builtin_amdgcn_sched_barrier(0);
    const char* st = lds + (kt & 1) * STAGE;
    bf16x8 af[4], bfv[2][NTW];
#define CO_(S) ((((S) * 2 + hi) ^ rsw) << 4)
#define LDA_(MT, S) af[MT] = *reinterpret_cast<const bf16x8*>(st + a_base + (MT) * 4096 + CO_(S))
#define LDB_(BUF, S) do { _Pragma("unroll") for (int nt = 0; nt < NTW; ++nt) bfv[BUF][nt] = *reinterpret_cast<const bf16x8*>(st + b_base + nt * 4096 + CO_(S)); } while (0)
    LDB_(0, 0);
#pragma unroll
    for (int mt = 0; mt < 4; ++mt) LDA_(mt, 0);
#pragma unroll
    for (int s = 0; s < 4; ++s) {
      if (s < 3) LDB_((s + 1) & 1, s + 1);
#pragma unroll
      for (int mt = 0; mt < 4; ++mt) {
        __builtin_amdgcn_sched_barrier(0);
#pragma unroll
        for (int nt = 0; nt < NTW; ++nt) acc[mt][nt] = mfma32(af[mt], bfv[s & 1][nt], acc[mt][nt]);
        if (s < 3) LDA_(mt, s + 1);
      }
      __builtin_amdgcn_sched_barrier(0);
    }
#undef CO_
#undef LDA_
#undef LDB_
    if (kt + 1 < nk) {
      char* sw = lds + ((kt + 1) & 1) * STAGE;
#pragma unroll
      for (int i = 0; i < 4; ++i) *reinterpret_cast<u32x4*>(sw + wofs + i * 8192) = ra[i];
#pragma unroll
      for (int i = 0; i < NBL; ++i) *reinterpret_cast<u32x4*>(sw + ABYTES + wofs + i * 8192) = rb[i];
    }
    __syncthreads();
  }
  epi(acc, wm, wn, l31, hi);
}


__device__ __forceinline__ int block_L(int r) { const int G = gridDim.x, slots = G >> 3, b = blockIdx.x; return (r * 8 + (b & 7)) * slots + (b >> 3); }
__device__ __forceinline__ void grouped_mn(int L, int MT, int NT, int& mt, int& nt) {
  const int pg_ = 4 * NT; const int g = L / pg_, rem = L - g * pg_; const int gsz = (MT - 4 * g) < 4 ? (MT - 4 * g) : 4;
  nt = rem / gsz; mt = 4 * g + rem - nt * gsz;
}
__device__ __forceinline__ bool tile_of(int r, int MT, int NT, int& mt, int& nt) {
  const int G = gridDim.x, slots = G >> 3, b = blockIdx.x, x = b & 7, s = b >> 3;
  const int total = MT * NT, per = (total + 7) >> 3;
  const int start = x * per; int cnt = total - start; cnt = cnt > per ? per : cnt;
  const int idx = r * slots + s; if (idx >= cnt) return false;
  grouped_mn(start + idx, MT, NT, mt, nt); return true;
}

namespace pg {
using f32x4 = __attribute__((ext_vector_type(4))) float;
constexpr int HTB = 128 * 64 * 2;
__device__ __forceinline__ int lds_byte(int r, int c) { const int st = (r >> 4) * 2 + (c >> 5), rr = r & 15, cc = c & 31, ob = rr * 64 + cc * 2; return st * 1024 + (ob ^ (((ob >> 9) & 1) << 5)); }
__device__ __forceinline__ void stage_rc(int b, int& R, int& C) { const int st = b / 1024, sb = b % 1024, swz = sb ^ (((sb >> 9) & 1) << 5); R = (st >> 1) * 16 + swz / 64; C = (st & 1) * 32 + (swz % 64) / 2; }
__device__ __forceinline__ int perm32(int rho) { const int n = rho >> 4, i = rho & 15; return 8 * (i >> 2) + 4 * n + (i & 3); }
struct Unit { const char* a; const char* b; int nt, m0, n0, tag; };

template <bool PERM, class Sched, class Epi>
__device__ __forceinline__ void gemm_phase(LAS unsigned char* lds, int lda, int ldb, const Sched& S, const Epi& E) {
    const int tid = otid(), wid = __builtin_amdgcn_readfirstlane(tid >> 6), lane = tid & 63, wr = wid >> 2, wc = wid & 3, fr = lane & 15, fq = lane >> 4;
    unsigned voffA[2], voffB[2];
#pragma unroll
    for (int i = 0; i < 2; ++i) { int R, C; stage_rc(tid * 16 + i * 8192, R, C); const int Rb = PERM ? ((R & ~31) + perm32(R & 31)) : R;
        voffA[i] = (unsigned)(R * lda + C) * 2u; voffB[i] = (unsigned)(Rb * ldb + C) * 2u; }
    const size_t kstep = 128;
    const size_t hstepA = (size_t)128 * lda * 2, hstepB = (size_t)128 * ldb * 2;
    const unsigned ldsw = (unsigned)wid * 1024u;
    const int aoff = lds_byte(wr * 64 + fr, fq * 8), boff = lds_byte(wc * 32 + fr, fq * 8);
#define PG8_SA(b, h) (((b) * 2 + (h)) * HTB)
#define PG8_SB(b, h) ((4 + (b) * 2 + (h)) * HTB)
#define PG8_STAGE(bufoff, gbase, voff) do { _Pragma("unroll") for (int _i = 0; _i < 2; ++_i) \
        __builtin_amdgcn_global_load_lds((const unsigned*)((const char*)(gbase) + (voff)[_i]), (LAS unsigned*)(lds + (bufoff) + ldsw + _i * 8192), 16, 0, 0); } while (0)
#define PG8_LDA(dst, b, h) do { _Pragma("unroll") for (int m = 0; m < 4; ++m) _Pragma("unroll") for (int k = 0; k < 2; ++k) dst[m][k] = *(const LAS bf16x8*)(lds + PG8_SA(b, h) + aoff + m * 2048 + k * 1024); } while (0)
#define PG8_LDB(dst, b, h) do { _Pragma("unroll") for (int n = 0; n < 2; ++n) _Pragma("unroll") for (int k = 0; k < 2; ++k) dst[n][k] = *(const LAS bf16x8*)(lds + PG8_SB(b, h) + boff + n * 2048 + k * 1024); } while (0)
#define PG8_MMA(ai, bj, At, Bt) do { __builtin_amdgcn_s_setprio(1); _Pragma("unroll") for (int m = 0; m < 4; ++m) _Pragma("unroll") for (int n = 0; n < 2; ++n) _Pragma("unroll") for (int k = 0; k < 2; ++k) \
        acc[ai][bj][m][n] = __builtin_amdgcn_mfma_f32_16x16x32_bf16(Bt[n][k], At[m][k], acc[ai][bj][m][n], 0, 0, 0); __builtin_amdgcn_s_setprio(0); } while (0)
#define PG8_WAIT_V(n) asm volatile("s_waitcnt vmcnt(" #n ")" ::: "memory")
#define PG8_WAIT_L(n) asm volatile("s_waitcnt lgkmcnt(" #n ")" ::: "memory")
#define PG8_BAR __builtin_amdgcn_s_barrier()
#define PG8_SCHED __builtin_amdgcn_sched_barrier(0)
    Unit cur, nxt; int ui = 0;
    if (!S.next(0, cur)) return;
    f32x4 acc[2][2][4][2];
#pragma unroll
    for (int a = 0; a < 2; ++a)
#pragma unroll
        for (int b = 0; b < 2; ++b)
#pragma unroll
            for (int m = 0; m < 4; ++m)
#pragma unroll
                for (int n = 0; n < 2; ++n) acc[a][b][m][n] = (f32x4){0.f, 0.f, 0.f, 0.f};
    bf16x8 At[4][2], B0[2][2], B1[2][2];
    const char* cA = cur.a; const char* cB = cur.b;
    PG8_STAGE(PG8_SB(0, 0), cB, voffB); PG8_STAGE(PG8_SA(0, 0), cA, voffA); PG8_STAGE(PG8_SB(0, 1), cB + hstepB, voffB); PG8_STAGE(PG8_SA(0, 1), cA + hstepA, voffA);
    if (wr == 1) PG8_BAR;
    PG8_WAIT_V(4); PG8_BAR;
    PG8_STAGE(PG8_SB(1, 0), cB + kstep, voffB); PG8_STAGE(PG8_SA(1, 0), cA + kstep, voffA); PG8_STAGE(PG8_SB(1, 1), cB + hstepB + kstep, voffB);
    PG8_WAIT_V(6); PG8_BAR;
    for (;;) {
        const bool has_next = S.next(ui + 1, nxt);
        const char* nA = has_next ? nxt.a : cA; const char* nB = has_next ? nxt.b : cB;
        const int nt = cur.nt;
        for (int t = 0; t < nt; t += 2) {
            const bool last = (t == nt - 2);
            const char* a1 = cA + (size_t)(t + 1) * kstep;
            const char* a2 = last ? nA : cA + (size_t)(t + 2) * kstep; const char* b2 = last ? nB : cB + (size_t)(t + 2) * kstep;
            const char* a3 = a2 + kstep; const char* b3 = b2 + kstep;
            PG8_LDB(B0, 0, 0); PG8_SCHED; PG8_LDA(At, 0, 0); PG8_STAGE(PG8_SA(1, 1), a1 + hstepA, voffA);
            PG8_WAIT_L(8); PG8_BAR; PG8_WAIT_L(0); PG8_MMA(0, 0, At, B0); PG8_BAR; PG8_SCHED;
            PG8_LDB(B1, 0, 1); PG8_STAGE(PG8_SB(0, 0), b2, voffB);
            PG8_BAR; PG8_WAIT_L(0); PG8_MMA(0, 1, At, B1); PG8_BAR;
            PG8_LDA(At, 0, 1); PG8_STAGE(PG8_SA(0, 0), a2, voffA);
            PG8_BAR; PG8_WAIT_L(0); PG8_MMA(1, 0, At, B0); PG8_BAR; PG8_SCHED;
            PG8_STAGE(PG8_SB(0, 1), b2 + hstepB, voffB);
            PG8_WAIT_V(6); PG8_BAR; PG8_MMA(1, 1, At, B1); PG8_BAR;
            PG8_LDB(B0, 1, 0); PG8_SCHED; PG8_LDA(At, 1, 0); PG8_STAGE(PG8_SA(0, 1), a2 + hstepA, voffA);
            PG8_WAIT_L(8); PG8_BAR; PG8_WAIT_L(0); PG8_MMA(0, 0, At, B0); PG8_BAR; PG8_SCHED;
            PG8_LDB(B1, 1, 1); PG8_STAGE(PG8_SB(1, 0), b3, voffB);
            PG8_BAR; PG8_WAIT_L(0); PG8_MMA(0, 1, At, B1); PG8_BAR;
            PG8_LDA(At, 1, 1); PG8_STAGE(PG8_SA(1, 0), a3, voffA);
            PG8_BAR; PG8_WAIT_L(0); PG8_MMA(1, 0, At, B0); PG8_BAR; PG8_SCHED;
            PG8_STAGE(PG8_SB(1, 1), b3 + hstepB, voffB);
            PG8_WAIT_V(6); PG8_BAR; PG8_MMA(1, 1, At, B1); PG8_BAR;
        }
        E(acc, cur, wr, wc, fr, fq);
        if (!has_next) break;
#pragma unroll
        for (int a = 0; a < 2; ++a)
#pragma unroll
            for (int b = 0; b < 2; ++b)
#pragma unroll
                for (int m = 0; m < 4; ++m)
#pragma unroll
                    for (int n = 0; n < 2; ++n) acc[a][b][m][n] = (f32x4){0.f, 0.f, 0.f, 0.f};
        cur = nxt; cA = nA; cB = nB; ++ui;
    }
    PG8_WAIT_V(0);
    if (wr == 0) PG8_BAR;
    PG8_BAR;
#undef PG8_SA
#undef PG8_SB
#undef PG8_STAGE
#undef PG8_LDA
#undef PG8_LDB
#undef PG8_MMA
#undef PG8_WAIT_V
#undef PG8_WAIT_L
#undef PG8_BAR
#undef PG8_SCHED
}
}


struct SchedMN {
  const char* A; const char* B; int lda, ldb, MT, NT, nt;
  __device__ __forceinline__ bool next(int i, pg::Unit& u) const {
    int mt, ntl; if (!tile_of(i, MT, NT, mt, ntl)) return false;
    u.m0 = mt * 256; u.n0 = ntl * 256; u.a = A + (size_t)u.m0 * lda * 2; u.b = B + (size_t)u.n0 * ldb * 2; u.nt = nt; u.tag = 0; return true; }
};
struct SchedRes {
  const char* A; const char* B; int lda, ldb, ntk, nctx;
  __device__ __forceinline__ bool next(int i, pg::Unit& u) const {
    const int L = block_L(i);
    if (L < 512) { int mt, ntl; grouped_mn(L, 64, 8, mt, ntl); u.m0 = mt * 256; u.n0 = ntl * 256; u.a = A + (size_t)u.m0 * lda * 2; u.b = B + (size_t)u.n0 * ldb * 2; u.nt = ntk; u.tag = 0; return true; }
    const int s = L - 512; if (s >= nctx * 4) return false;
    const int cu = s >> 2, ks = s & 3, kt = ntk >> 2;
    u.m0 = (64 + (cu >> 3)) * 256; u.n0 = (cu & 7) * 256; u.nt = kt; u.tag = 1 + ks;
    u.a = A + ((size_t)u.m0 * lda + (size_t)ks * kt * 64) * 2; u.b = B + ((size_t)u.n0 * ldb + (size_t)ks * kt * 64) * 2; return true; }
};
struct SchedQKV {
  const char* P; const char* Wq; const char* Wkv; int MT;
  __device__ __forceinline__ bool next(int i, pg::Unit& u) const {
    int mt, ntv; if (!tile_of(i, MT, 14, mt, ntv)) return false;
    const bool isq = ntv < 6; const int ntl = isq ? ntv : ntv - 6;
    u.m0 = mt * 256; u.n0 = ntl * 256; u.tag = isq ? 0 : 1; u.nt = isq ? 12 : 8;
    u.a = P + ((size_t)u.m0 * PLD + (isq ? 0 : OFF_CKV)) * 2; u.b = (isq ? Wq : Wkv) + (size_t)u.n0 * 768 * 2; return true; }
};

__device__ __forceinline__ void phase_gemm_in(const Params& p, char* lds) {
  char* ws = p.ws;
  bf16_t* P = (bf16_t*)(ws + WS_P); float* DT = (float*)(ws + WS_DT);
  SchedMN S{ws + WS_H, ws + WS_WIN, HLD, WLD, T_ALL / 256, PNP / 256, DM / 64};
  auto epi = [=](const pg::f32x4 (&acc)[2][2][4][2], const pg::Unit& u, int wr, int wc, int fr, int fq) {
    const int row0 = u.m0 + wr * 64 + fr;
#pragma unroll
    for (int ai = 0; ai < 2; ++ai)
#pragma unroll
      for (int m = 0; m < 4; ++m) { const int row = row0 + ai * 128 + m * 16;
#pragma unroll
        for (int bj = 0; bj < 2; ++bj) { const int c = u.n0 + bj * 128 + wc * 32 + 8 * fq;
          const pg::f32x4 v0 = acc[ai][bj][m][0], v1 = acc[ai][bj][m][1];
          if (c < PLD) { u32x4 w = {cvtpk(v0[0], v0[1]), cvtpk(v0[2], v0[3]), cvtpk(v1[0], v1[1]), cvtpk(v1[2], v1[3])}; *reinterpret_cast<u32x4*>(P + (size_t)row * PLD + c) = w; }
          if (c >= OFF_DT && c < PIN) { *reinterpret_cast<pg::f32x4*>(DT + (size_t)row * 16 + (c - OFF_DT)) = v0; *reinterpret_cast<pg::f32x4*>(DT + (size_t)row * 16 + (c - OFF_DT) + 4) = v1; } } }
  };
  pg::gemm_phase<true>((LAS unsigned char*)lds, HLD, WLD, S, epi);
}

__device__ __forceinline__ void phase_qkv_gemm_and_post(const Params& p, int layer, char* lds) {
  char* ws = p.ws;
  const bf16_t* P = (const bf16_t*)(ws + WS_P);
  { SchedQKV S{ws + WS_P, ws + WS_WUQ, ws + WS_WUKV, T_ALL / 256};
    bf16_t* dq = (bf16_t*)(ws + WS_QRAW); bf16_t* dkv = (bf16_t*)(ws + WS_KVRAW);
    auto epi = [=](const pg::f32x4 (&acc)[2][2][4][2], const pg::Unit& u, int wr, int wc, int fr, int fq) {
      bf16_t* dst = u.tag ? dkv : dq; const int ldd = u.tag ? 2048 : 1536;
      const int row0 = u.m0 + wr * 64 + fr;
#pragma unroll
      for (int ai = 0; ai < 2; ++ai)
#pragma unroll
        for (int m = 0; m < 4; ++m) { const int row = row0 + ai * 128 + m * 16;
#pragma unroll
          for (int bj = 0; bj < 2; ++bj) { const int c = u.n0 + bj * 128 + wc * 32 + 8 * fq;
            const pg::f32x4 v0 = acc[ai][bj][m][0], v1 = acc[ai][bj][m][1];
            u32x4 w = {cvtpk(v0[0], v0[1]), cvtpk(v0[2], v0[3]), cvtpk(v1[0], v1[1]), cvtpk(v1[2], v1[3])};
            *reinterpret_cast<u32x4*>(dst + (size_t)row * ldd + c) = w; } }
    };
    pg::gemm_phase<true>((LAS unsigned char*)lds, PLD, 768, S, epi); }
  const int tid = otid(), lane = tid & 63, wid = tid >> 6;
  float* RSTD = (float*)(ws + WS_RSTD); float* DT = (float*)(ws + WS_DT); bf16_t* XBC = (bf16_t*)(ws + WS_XBC);
  const float* cw = p.ssd_conv_w + (size_t)layer * 3 * 1024; const float* cb = p.ssd_conv_b + layer * 1024;
  for (int t = blockIdx.x * 8 + wid; t < T_ALL; t += gridDim.x * 8) {
    const bf16_t* pr = P + (size_t)t * PLD;
    float sq = 0.f, skv = 0.f; float f[8];
    for (int c = lane; c < 96; c += 64) { unpack8(*reinterpret_cast<const u32x4*>(pr + c * 8), f);
#pragma unroll
      for (int e = 0; e < 8; ++e) sq += f[e] * f[e]; }
    { unpack8(*reinterpret_cast<const u32x4*>(pr + OFF_CKV + lane * 8), f);
#pragma unroll
      for (int e = 0; e < 8; ++e) skv += f[e] * f[e]; }
    sq = wave_sum(sq); skv = wave_sum(skv);
    if (lane == 0) { RSTD[t * 2] = rsqrtf(sq * (1.f / 768.f) + EPS); RSTD[t * 2 + 1] = rsqrtf(skv * (1.f / 512.f) + EPS); }
    if (lane < 16) { float v = DT[(size_t)t * 16 + lane] + p.ssd_dt_bias[layer * 16 + lane]; DT[(size_t)t * 16 + lane] = v > 20.f ? v : log1pf(__expf(v)); }
    const bool s0 = seq_start(t), s1 = seq_end(t);
#pragma unroll
    for (int cc = 0; cc < 2; ++cc) {
      const int c0 = (cc * 64 + lane) * 8;
      float fm[8], fc[8], fp[8];
      unpack8(*reinterpret_cast<const u32x4*>(pr + OFF_XBC + c0), fc);
      if (!s0) unpack8(*reinterpret_cast<const u32x4*>(pr - PLD + OFF_XBC + c0), fm);
      if (!s1) unpack8(*reinterpret_cast<const u32x4*>(pr + PLD + OFF_XBC + c0), fp);
      float o[8];
#pragma unroll
      for (int e = 0; e < 8; ++e) {
        float a = cb[c0 + e] + cw[1024 + c0 + e] * fc[e];
        if (!s0) a += cw[c0 + e] * fm[e];
        if (!s1) a += cw[2048 + c0 + e] * fp[e];
        o[e] = silu_f(a);
      }
      *reinterpret_cast<u32x4*>(XBC + (size_t)t * 1024 + c0) = pack8(o);
    }
  }
}

__device__ __forceinline__ void phase_build_qkv(const Params& p, int layer) {
  char* ws = p.ws;
  const int tid = otid(), lane = tid & 63, wid = tid >> 6;
  const bf16_t* P = (const bf16_t*)(ws + WS_P); const bf16_t* QR = (const bf16_t*)(ws + WS_QRAW); const bf16_t* KVR = (const bf16_t*)(ws + WS_KVRAW);
  const float* RSTD = (const float*)(ws + WS_RSTD); const float* rope = (const float*)(ws + WS_ROPE);
  bf16_t* Q = (bf16_t*)(ws + WS_Q); bf16_t* QC = (bf16_t*)(ws + WS_QC); bf16_t* Kb = (bf16_t*)(ws + WS_K); bf16_t* Vb = (bf16_t*)(ws + WS_V);
  const float* qn = p.q_norm + layer * 192; const float* kn = p.k_norm + layer * 192;
  const float qg0 = qn[lane], qg1 = qn[64 + lane], qg2 = qn[128 + lane];
  const float kg0 = kn[lane], kg1 = kn[64 + lane], kg2 = kn[128 + lane];
  const int ax = lane >> 5, jj = lane & 15, second = (lane >> 4) & 1;
  for (int t = blockIdx.x * 8 + wid; t < T_ALL; t += gridDim.x * 8) {
    const bool lat = t < T_LAT;
    const int b = lat ? (t >> 13) : ((t - T_LAT) >> 8);
    const int pos = lat ? (t & (SEQ - 1)) : ((t - T_LAT) & (CTXL - 1));
    const int kpos = lat ? (CTXL + pos) : pos;
    const float rq = RSTD[t * 2], rkv = RSTD[t * 2 + 1];
    float cs = 1.f, sn = 0.f;
    if (lat) { const int pa = ax ? (pos & 63) : (pos >> 6); cs = rope[(pa * 16 + jj) * 2]; sn = rope[(pa * 16 + jj) * 2 + 1]; }
    const float krv = bf2f(P[(size_t)t * PLD + OFF_KR + lane]);
    bf16_t qraw[8][3], kraw[8][4];
#pragma unroll
    for (int h = 0; h < 8; ++h) { const bf16_t* qs = QR + (size_t)t * 1536 + h * 192; const bf16_t* ks = KVR + (size_t)t * 2048 + h * 256;
      qraw[h][0] = qs[lane]; qraw[h][1] = qs[64 + lane]; qraw[h][2] = qs[128 + lane];
      kraw[h][0] = ks[lane]; kraw[h][1] = ks[64 + lane]; kraw[h][2] = ks[128 + lane]; kraw[h][3] = ks[192 + lane]; }
#pragma unroll
    for (int h = 0; h < 8; ++h) {
      float v0 = bf2f(qraw[h][0]) * rq, v1 = bf2f(qraw[h][1]) * rq, v2 = bf2f(qraw[h][2]) * rq;
      float ss = wave_sum(v0 * v0 + v1 * v1 + v2 * v2);
      float r = rsqrtf(ss * (1.f / 192.f) + EPS);
      v0 *= r * qg0; v1 *= r * qg1; v2 *= r * qg2;
      if (lat) { float pr = lane_xor16(v2, lane); v2 = second ? (v2 * cs + pr * sn) : (v2 * cs - pr * sn); }
      bf16_t* qd = lat ? Q + ((size_t)(b * 8 + h) * SEQ + pos) * 192 : QC + ((size_t)(b * 8 + h) * CTXL + pos) * 192;
      qd[lane] = f2bf(v0 * QSCALE); qd[64 + lane] = f2bf(v1 * QSCALE); qd[128 + lane] = f2bf(v2 * QSCALE);
      float k0 = bf2f(kraw[h][0]) * rkv, k1 = bf2f(kraw[h][1]) * rkv, k2 = krv;
      float vv0 = bf2f(kraw[h][2]) * rkv, vv1 = bf2f(kraw[h][3]) * rkv;
      float ks2 = wave_sum(k0 * k0 + k1 * k1 + k2 * k2);
      float rk = rsqrtf(ks2 * (1.f / 192.f) + EPS);
      k0 *= rk * kg0; k1 *= rk * kg1; k2 *= rk * kg2;
      if (lat) { float pr = lane_xor16(k2, lane); k2 = second ? (k2 * cs + pr * sn) : (k2 * cs - pr * sn); }
      bf16_t* kd = Kb + ((size_t)(b * 8 + h) * NKEYS + kpos) * 192;
      kd[lane] = f2bf(k0); kd[64 + lane] = f2bf(k1); kd[128 + lane] = f2bf(k2);
      bf16_t* vd = Vb + ((size_t)(b * 8 + h) * NKEYS + kpos) * 128;
      vd[lane] = f2bf(vv0); vd[64 + lane] = f2bf(vv1);
    }
  }
}

#define KSWZ(row, colB) ((row) * 384 + ((colB) ^ ((((row) >> 1) & 7) << 4)))
__device__ __forceinline__ int v_st(int k, int c) { const int kk = (k & ~0xC) | ((k & 4) << 1) | ((k & 8) >> 1); return ((kk >> 3) * 4 + (c >> 5)) * 512 + ((kk & 7) * 32 + (c & 31)) * 2; }
__device__ __forceinline__ int v_rd_base(int lane) { return ((lane & 3) << 3) | (((lane >> 2) & 3) << 6) | (((lane >> 4) & 1) << 5) | (((lane >> 5) & 1) << 8); }
constexpr int v_rd_off(int d0, int ks, int half) { return d0 * 512 + ks * 4096 + half * 2048; }
template <int OFF> __device__ __forceinline__ s16x4 tr_read(int vb) {
  s16x4 r; asm volatile("ds_read_b64_tr_b16 %0, %1 offset:%2" : "=&v"(r) : "v"(vb), "i"(OFF) : "memory"); return r;
}
struct VFrag { s16x4 l0, h0, l1, h1, l2, h2, l3, h3; };
template <int D0> __device__ __forceinline__ void pv_read(VFrag& f, int vb) {
  f.l0 = tr_read<v_rd_off(D0, 0, 0)>(vb); f.h0 = tr_read<v_rd_off(D0, 0, 1)>(vb); f.l1 = tr_read<v_rd_off(D0, 1, 0)>(vb); f.h1 = tr_read<v_rd_off(D0, 1, 1)>(vb);
  f.l2 = tr_read<v_rd_off(D0, 2, 0)>(vb); f.h2 = tr_read<v_rd_off(D0, 2, 1)>(vb); f.l3 = tr_read<v_rd_off(D0, 3, 0)>(vb); f.h3 = tr_read<v_rd_off(D0, 3, 1)>(vb);
}
__device__ __forceinline__ void pv_mma(f32x16& od, const VFrag& f, bf16x8 pa0, bf16x8 pa1, bf16x8 pa2, bf16x8 pa3) {
#define PK(L, H) (bf16x8){L[0], L[1], L[2], L[3], H[0], H[1], H[2], H[3]}
  od = mfma32(pa0, PK(f.l0, f.h0), od); od = mfma32(pa1, PK(f.l1, f.h1), od); od = mfma32(pa2, PK(f.l2, f.h2), od); od = mfma32(pa3, PK(f.l3, f.h3), od);
#undef PK
}
__device__ __forceinline__ void pv_all(f32x16* o, int vb, bf16x8 pa0, bf16x8 pa1, bf16x8 pa2, bf16x8 pa3) {
  VFrag fa, fb;
  pv_read<0>(fa, vb); pv_read<1>(fb, vb);
  asm volatile("s_waitcnt lgkmcnt(8)" : "+v"(fa.l0), "+v"(fa.h0), "+v"(fa.l1), "+v"(fa.h1), "+v"(fa.l2), "+v"(fa.h2), "+v"(fa.l3), "+v"(fa.h3) :: "memory"); __builtin_amdgcn_sched_barrier(0);
  pv_mma(o[0], fa, pa0, pa1, pa2, pa3); __builtin_amdgcn_sched_barrier(0);
  pv_read<2>(fa, vb);
  asm volatile("s_waitcnt lgkmcnt(8)" : "+v"(fb.l0), "+v"(fb.h0), "+v"(fb.l1), "+v"(fb.h1), "+v"(fb.l2), "+v"(fb.h2), "+v"(fb.l3), "+v"(fb.h3) :: "memory"); __builtin_amdgcn_sched_barrier(0);
  pv_mma(o[1], fb, pa0, pa1, pa2, pa3); __builtin_amdgcn_sched_barrier(0);
  pv_read<3>(fb, vb);
  asm volatile("s_waitcnt lgkmcnt(8)" : "+v"(fa.l0), "+v"(fa.h0), "+v"(fa.l1), "+v"(fa.h1), "+v"(fa.l2), "+v"(fa.h2), "+v"(fa.l3), "+v"(fa.h3) :: "memory"); __builtin_amdgcn_sched_barrier(0);
  pv_mma(o[2], fa, pa0, pa1, pa2, pa3); __builtin_amdgcn_sched_barrier(0);
  asm volatile("s_waitcnt lgkmcnt(0)" : "+v"(fb.l0), "+v"(fb.h0), "+v"(fb.l1), "+v"(fb.h1), "+v"(fb.l2), "+v"(fb.h2), "+v"(fb.l3), "+v"(fb.h3) :: "memory"); __builtin_amdgcn_sched_barrier(0);
  pv_mma(o[3], fb, pa0, pa1, pa2, pa3);
}

constexpr int ATT_V = 0, ATT_K = 32768, ATT_WS = 32768 + 49152;
__device__ __forceinline__ void attn_item(const bf16_t* __restrict__ Qb, const bf16_t* __restrict__ Kh, const bf16_t* __restrict__ Vh, int nkeys,
                          bf16_t* __restrict__ Ob, float* __restrict__ ml, char* lds) {
  constexpr float THR = 8.f;
  const int tid = otid(), wid = tid >> 6, lane = tid & 63, r32 = lane & 31, hi = lane >> 5;
  char* V_lds = lds + ATT_V; char* K_lds = lds + ATT_K;
  float* wsf = (float*)(lds + ATT_WS) + wid * 64; float* li_l = wsf; float* al_l = wsf + 32;
  float m_reg = 0.f, l_reg = 0.f;
  f32x16 o[4];
#pragma unroll
  for (int d = 0; d < 4; ++d)
#pragma unroll
    for (int r = 0; r < 16; ++r) o[d][r] = 0.f;
  bf16x8 qr[12];
  const bf16_t* Qw = Qb + (size_t)(wid * 32 + r32) * 192 + hi * 8;
#pragma unroll
  for (int d0 = 0; d0 < 12; ++d0) qr[d0] = *reinterpret_cast<const bf16x8*>(Qw + d0 * 16);
  const int sr = tid >> 4, sc = (tid & 15) * 8, vst0 = v_st(sr, sc), vst1 = v_st(32 + sr, sc);
  const int vb0 = (int)(uintptr_t)V_lds + v_rd_base(lane);
#define krow(i) ((tid + (i) * NTHR) / 24)
#define kch(i) ((tid + (i) * NTHR) % 24)
  int klow[4];
#pragma unroll
  for (int q = 0; q < 4; ++q) klow[q] = r32 * 384 + ((q * 32 + hi * 16) ^ (((r32 >> 1) & 7) << 4));
  const int wu = __builtin_amdgcn_readfirstlane(wid);
  unsigned koff[3], voff[2];
#pragma unroll
  for (int i = 0; i < 3; ++i) { const int ofs = (i * 8 + wid) * 1024 + lane * 16; const int row = ofs / 384, cpos = (ofs - row * 384) >> 4;
    const int c = (cpos & ~7) | ((cpos ^ (row >> 1)) & 7); koff[i] = (unsigned)(row * 192 + c * 8); }
#pragma unroll
  for (int i = 0; i < 2; ++i) { const int ofs = (i * 8 + wid) * 1024 + lane * 16; const int st = ofs >> 9, wv = ofs & 511;
    const int kk = (st >> 2) * 8 + (wv >> 6), c = (st & 3) * 32 + ((wv & 63) >> 1); const int k = (kk & ~0xC) | ((kk & 4) << 1) | ((kk & 8) >> 1);
    voff[i] = (unsigned)(k * 128 + c); }
#define SDMA(k0, b) do { const bf16_t* Vt = Vh + (size_t)(k0) * 128; const bf16_t* Kt = Kh + (size_t)(k0) * 192; \
    _Pragma("unroll") for (int i = 0; i < 2; ++i) __builtin_amdgcn_global_load_lds((const unsigned*)(Vt + voff[i]), (LAS unsigned*)(V_lds + (b) * 16384 + (i * 8 + wu) * 1024), 16, 0, 0); \
    _Pragma("unroll") for (int i = 0; i < 3; ++i) __builtin_amdgcn_global_load_lds((const unsigned*)(Kt + koff[i]), (LAS unsigned*)(K_lds + (b) * 24576 + (i * 8 + wu) * 1024), 16, 0, 0); } while (0)
#define SLOAD(k0) do { } while (0)
#define SWRITE(b) do { } while (0)
  const int NT = nkeys >> 6;
  __syncthreads();
  SDMA(0, 0); asm volatile("s_waitcnt vmcnt(0)" ::: "memory"); __syncthreads();
  for (int j = 0; j < NT; ++j) {
    if (j + 1 < NT) SDMA((j + 1) * 64, (j + 1) & 1);
    __builtin_amdgcn_sched_barrier(0);
    const char* Ks = K_lds + (j & 1) * 24576;
    f32x16 p0, p1;
#pragma unroll
    for (int r = 0; r < 16; ++r) { p0[r] = -m_reg; p1[r] = -m_reg; }
    bf16x8 kb0[3], kb1[3];
#define LDK_(D, SL) do { const char* kp_ = Ks + klow[(D) & 3] + ((D) >> 2) * 128; kb0[SL] = *reinterpret_cast<const bf16x8*>(kp_); kb1[SL] = *reinterpret_cast<const bf16x8*>(kp_ + 32 * 384); } while (0)
    LDK_(0, 0); LDK_(1, 1);
#pragma unroll
    for (int d0 = 0; d0 < 12; ++d0) {
      if (d0 + 2 < 12) LDK_(d0 + 2, (d0 + 2) % 3);
      __builtin_amdgcn_sched_barrier(0);
      p0 = mfma32(kb0[d0 % 3], qr[d0], p0); p1 = mfma32(kb1[d0 % 3], qr[d0], p1);
      __builtin_amdgcn_sched_barrier(0);
    }
#undef LDK_
    float pmax = p0[0];
#pragma unroll
    for (int r = 1; r < 16; ++r) pmax = fmaxf(pmax, p0[r]);
#pragma unroll
    for (int r = 0; r < 16; ++r) pmax = fmaxf(pmax, p1[r]);
    { auto rr = __builtin_amdgcn_permlane32_swap(__float_as_uint(pmax), __float_as_uint(pmax), false, false);
      pmax = fmaxf(__uint_as_float(rr[0]), __uint_as_float(rr[1])); }
    float alpha = 1.f;
    if (!__all(pmax <= THR)) {
      const float delta = fmaxf(pmax, 0.f); alpha = __builtin_amdgcn_exp2f(-delta); m_reg += delta;
#pragma unroll
      for (int r = 0; r < 16; ++r) { p0[r] -= delta; p1[r] -= delta; }
    }
    float ps = 0.f;
#pragma unroll
    for (int r = 0; r < 16; ++r) { p0[r] = __builtin_amdgcn_exp2f(p0[r]); ps += p0[r]; }
#pragma unroll
    for (int r = 0; r < 16; ++r) { p1[r] = __builtin_amdgcn_exp2f(p1[r]); ps += p1[r]; }
    { auto rr = __builtin_amdgcn_permlane32_swap(__float_as_uint(ps), __float_as_uint(ps), false, false);
      ps = __uint_as_float(rr[0]) + __uint_as_float(rr[1]); }
    l_reg = l_reg * alpha + ps;
    bf16x8 pa0, pa1, pa2, pa3;
#define PK4(P, BASE, OUT) do { unsigned a0 = cvtpk(P[BASE + 0], P[BASE + 1]), a1 = cvtpk(P[BASE + 2], P[BASE + 3]);   \
    unsigned b0_ = cvtpk(P[BASE + 4], P[BASE + 5]), b1_ = cvtpk(P[BASE + 6], P[BASE + 7]);                              \
    auto r0 = __builtin_amdgcn_permlane32_swap(a0, b0_, false, false); auto r1 = __builtin_amdgcn_permlane32_swap(a1, b1_, false, false); \
    u32x4 w = {r0[0], r1[0], r0[1], r1[1]}; OUT = *reinterpret_cast<bf16x8*>(&w); } while (0)
    PK4(p0, 0, pa0); PK4(p0, 8, pa1); PK4(p1, 0, pa2); PK4(p1, 8, pa3);
#undef PK4
    if (__any(alpha < 1.f)) {
      if (hi == 0) al_l[r32] = alpha;
      asm volatile("s_waitcnt lgkmcnt(0)" ::: "memory");
#pragma unroll
      for (int r = 0; r < 16; ++r) { const float a = al_l[crow(r, hi)];
#pragma unroll
        for (int d = 0; d < 4; ++d) o[d][r] *= a; }
    }
    const int vb = vb0 + (j & 1) * 16384;
    pv_all(o, vb, pa0, pa1, pa2, pa3);
    asm volatile("s_waitcnt vmcnt(0)" ::: "memory");
    __syncthreads();
  }
#undef SDMA
#undef SLOAD
#undef SWRITE
#undef krow
#undef kch
  if (hi == 0) { li_l[r32] = l_reg; float* mp = ml + (size_t)(wid * 32 + r32) * 16; mp[0] = m_reg; mp[1] = l_reg; }
  asm volatile("s_waitcnt lgkmcnt(0)" ::: "memory");
  bf16_t* Ow = Ob + (size_t)(wid * 32) * 1024;
#pragma unroll
  for (int r = 0; r < 16; ++r) {
    const int orow = crow(r, hi); const float rl = 1.f / li_l[orow];
#pragma unroll
    for (int d0 = 0; d0 < 4; ++d0) Ow[(size_t)orow * 1024 + d0 * 32 + r32] = f2bf(o[d0][r] * rl);
  }
}

constexpr int SS_CM = 0, SS_BM = 34816, SS_BW = 69632, SS_XV = 102400, SS_SB = 118784, SS_ACS = 136192, SS_DT = 136704, SS_RAW = 137216;
__device__ __forceinline__ int v_st2(int k, int c) { const int kk = (k & ~0xC) | ((k & 4) << 1) | ((k & 8) >> 1); return ((kk >> 3) * 2 + (c >> 5)) * 512 + ((kk & 7) * 32 + (c & 31)) * 2; }
__device__ __forceinline__ void ssd_item(const Params& p, int layer, int item, char* lds) {
  char* ws = p.ws;
  const int tid = otid(), wid = tid >> 6, lane = tid & 63, l31 = lane & 31, hi = lane >> 5;
  const int b = item >> 4, dir = (item >> 3) & 1, h = item & 7, grp = h >> 2;
  const float a_neg = -__expf(p.ssd_a_log[layer * 16 + dir * 8 + h]);
  const bf16_t* XBC = (const bf16_t*)(ws + WS_XBC); const float* DT = (const float*)(ws + WS_DT);
  bf16_t* Y = (bf16_t*)(ws + (dir ? WS_YB : WS_YF));
  float* sAcs = (float*)(lds + SS_ACS); float* sDt = (float*)(lds + SS_DT); float* sRaw = (float*)(lds + SS_RAW);
  f32x16 S;
#pragma unroll
  for (int r = 0; r < 16; ++r) S[r] = 0.f;
  const int s_pt = wid >> 2, s_nt = wid & 3;
  const int y_it = wid >> 1, y_pt = wid & 1;
  u32x4 rc[4], rbm[4], rx[2]; float rdt = 0.f;
#define SSD_BASE(K) ((K) < 2 ? T_LAT + b * CTXL + 128 * (dir ? (1 - (K)) : (K)) : b * SEQ + 128 * (dir ? (63 - ((K) - 2)) : ((K) - 2)))
#define SSD_LOAD(K) do { const int base_ = SSD_BASE(K); \
    _Pragma("unroll") for (int e = 0; e < 4; ++e) { int id = tid + e * NTHR; int it = id >> 4, c = id & 15; int prow = base_ + (dir ? 127 - it : it); \
      rbm[e] = *reinterpret_cast<const u32x4*>(XBC + (unsigned)(prow * 1024 + 512 + grp * 128 + c * 8)); \
      rc[e]  = *reinterpret_cast<const u32x4*>(XBC + (unsigned)(prow * 1024 + 768 + grp * 128 + c * 8)); } \
    _Pragma("unroll") for (int e = 0; e < 2; ++e) { int id = tid + e * NTHR; int it = id >> 3, c = id & 7; int prow = base_ + (dir ? 127 - it : it); \
      rx[e] = *reinterpret_cast<const u32x4*>(XBC + (unsigned)(prow * 1024 + h * 64 + c * 8)); } \
    if (tid < 128) { int prow = base_ + (dir ? 127 - tid : tid); rdt = DT[(unsigned)(prow * 16 + dir * 8 + h)]; } } while (0)
  for (int k = 0; k < 66; ++k) {
    const int base = SSD_BASE(k);
    __syncthreads();
    SSD_LOAD(k);
    if (tid < 128) { sDt[tid] = rdt; sRaw[tid] = rdt * a_neg; }
    __syncthreads();
    if (tid < 128) {
      float v = sRaw[tid];
#pragma unroll
      for (int o = 1; o < 64; o <<= 1) { float u = __shfl_up(v, o); if (lane >= o) v += u; }
      if (wid == 1) v += wave_sum(sRaw[lane]);
      sAcs[tid] = v;
    }
    __syncthreads();
    const float acs_last = sAcs[127];
#pragma unroll
    for (int e = 0; e < 4; ++e) { int id = tid + e * NTHR; int it = id >> 4, c = id & 15;
      *reinterpret_cast<u32x4*>(lds + SS_CM + it * 272 + c * 16) = rc[e];
      *reinterpret_cast<u32x4*>(lds + SS_BM + it * 272 + c * 16) = rbm[e];
      float f[8]; unpack8(rbm[e], f); const float w = __expf(acs_last - sAcs[it]);
#pragma unroll
      for (int q = 0; q < 8; ++q) f[q] *= w;
      *reinterpret_cast<u32x4*>(lds + SS_BW + (it >> 6) * 16384 + v_st(it & 63, c * 8)) = pack8(f); }
#pragma unroll
    for (int e = 0; e < 2; ++e) { int id = tid + e * NTHR; int it = id >> 3, c = id & 7;
      float f[8]; unpack8(rx[e], f); const float d = sDt[it];
#pragma unroll
      for (int q = 0; q < 8; ++q) f[q] *= d;
      *reinterpret_cast<u32x4*>(lds + SS_XV + (it >> 6) * 8192 + v_st2(it & 63, c * 8)) = pack8(f); }
    { bf16_t* sb = (bf16_t*)(lds + SS_SB);
#pragma unroll
      for (int r = 0; r < 16; ++r) sb[(s_pt * 32 + crow(r, hi)) * 136 + s_nt * 32 + l31] = f2bf(S[r]); }
    __syncthreads();
    f32x16 cbt[2], y;
#pragma unroll
    for (int r = 0; r < 16; ++r) { cbt[0][r] = 0.f; cbt[1][r] = 0.f; y[r] = 0.f; }
#pragma unroll
    for (int s = 0; s < 8; ++s) {
      const int co = (s * 16 + hi * 8) * 2;
      bf16x8 cmy = *reinterpret_cast<const bf16x8*>(lds + SS_CM + (y_it * 32 + l31) * 272 + co);
      bf16x8 sbv = *reinterpret_cast<const bf16x8*>(lds + SS_SB + (y_pt * 32 + l31) * 272 + co);
      y = mfma32(cmy, sbv, y);
#pragma unroll
      for (int u = 0; u < 2; ++u) { const int t_ = wid + u * 8; const int jt = t_ >> 2, it_ = t_ & 3;
        bf16x8 av = *reinterpret_cast<const bf16x8*>(lds + SS_BM + (jt * 32 + l31) * 272 + co);
        bf16x8 bv = *reinterpret_cast<const bf16x8*>(lds + SS_CM + (it_ * 32 + l31) * 272 + co);
        cbt[u] = mfma32(av, bv, cbt[u]); }
      __builtin_amdgcn_sched_barrier(0);
    }
#pragma unroll
    for (int r = 0; r < 16; ++r) y[r] *= __expf(sAcs[y_it * 32 + crow(r, hi)]);
    __syncthreads();
#pragma unroll
    for (int u = 0; u < 2; ++u) { const int t_ = wid + u * 8; const int jt = t_ >> 2, it_ = t_ & 3;
      const int i = it_ * 32 + l31; const float ai = sAcs[i];
#pragma unroll
      for (int q = 0; q < 4; ++q) {
        const int j0 = jt * 32 + 8 * q + 4 * hi; float g[4];
#pragma unroll
        for (int e = 0; e < 4; ++e) { const int j = j0 + e; g[e] = (j <= i) ? cbt[u][4 * q + e] * __expf(ai - sAcs[j]) : 0.f; }
        u32x2 w = {cvtpk(g[0], g[1]), cvtpk(g[2], g[3])};
        *reinterpret_cast<u32x2*>(lds + SS_BM + i * 272 + j0 * 2) = w;
      } }
    __syncthreads();
    const float dec = __expf(acs_last);
#pragma unroll
    for (int r = 0; r < 16; ++r) S[r] *= dec;
    { const int vrb = v_rd_base(lane);
      const int vbx_y = (int)(uintptr_t)(lds + SS_XV) + vrb + y_pt * 512, vbx_s = (int)(uintptr_t)(lds + SS_XV) + vrb + s_pt * 512, vbw_s = (int)(uintptr_t)(lds + SS_BW) + vrb + s_nt * 512;
#define PK_(L, H) (bf16x8){L[0], L[1], L[2], L[3], H[0], H[1], H[2], H[3]}
#define SSD_STEP(T, KS) do { \
      const bf16x8 gv = *reinterpret_cast<const bf16x8*>(lds + SS_BM + (y_it * 32 + l31) * 272 + (((T) * 4 + (KS)) * 16 + hi * 8) * 2); \
      const s16x4 xl = tr_read<(T) * 8192 + (KS) * 2048>(vbx_y), xh = tr_read<(T) * 8192 + (KS) * 2048 + 1024>(vbx_y); \
      const s16x4 al = tr_read<(T) * 8192 + (KS) * 2048>(vbx_s), ah = tr_read<(T) * 8192 + (KS) * 2048 + 1024>(vbx_s); \
      const s16x4 wl = tr_read<(T) * 16384 + (KS) * 4096>(vbw_s), wh = tr_read<(T) * 16384 + (KS) * 4096 + 2048>(vbw_s); \
      asm volatile("s_waitcnt lgkmcnt(0)" ::: "memory"); __builtin_amdgcn_sched_barrier(0); \
      y = mfma32(gv, PK_(xl, xh), y); S = mfma32(PK_(al, ah), PK_(wl, wh), S); } while (0)
      SSD_STEP(0, 0); SSD_STEP(0, 1); SSD_STEP(0, 2); SSD_STEP(0, 3); SSD_STEP(1, 0); SSD_STEP(1, 1); SSD_STEP(1, 2); SSD_STEP(1, 3);
#undef SSD_STEP
#undef PK_
    }
#pragma unroll
    for (int r = 0; r < 16; ++r) { const int i = y_it * 32 + crow(r, hi); const int prow = base + (dir ? 127 - i : i);
      Y[(unsigned)(prow * 512 + h * 64 + y_pt * 32 + l31)] = f2bf(y[r]); }
  }
#undef SSD_LOAD
#undef SSD_BASE
}

__device__ __forceinline__ void sgu_item(const Params& p, int layer, int chunk, char* lds) {
  char* ws = p.ws;
  const int tid = otid(), wid = tid >> 6, lane = tid & 63, l31 = lane & 31, hi = lane >> 5;
  const bf16_t* P = (const bf16_t*)(ws + WS_P); bf16_t* SG = (bf16_t*)(ws + WS_SGUO);
  const int r0 = chunk * 128;
  float* sR = (float*)(lds + 69632);
  __syncthreads();
  { const int row = tid >> 2, q = tid & 3; const bf16_t* pr = P + (size_t)(r0 + row) * PLD + OFF_SGU + 512 + q * 128; float ss = 0.f;
    for (int c = 0; c < 16; ++c) { float f[8]; unpack8(*reinterpret_cast<const u32x4*>(pr + c * 8), f);
#pragma unroll
      for (int e = 0; e < 8; ++e) { float g = gelu_f(f[e]); ss += g * g; } }
    ss += __shfl_xor(ss, 1); ss += __shfl_xor(ss, 2);
    if (q == 0) sR[row] = rsqrtf(ss * (1.f / 512.f) + EPS); }
  __syncthreads();
  const int it = wid >> 1, dt0 = (wid & 1) * 2;
  for (int g = 0; g < 4; ++g) {
    const float* wsrc = p.sgu_w + ((size_t)layer * 4 + g) * 128 * 128;
#pragma unroll
    for (int e = 0; e < 8; ++e) { int id = tid + e * NTHR; int i = id >> 5, j4 = (id & 31) * 4; float4 v = *reinterpret_cast<const float4*>(wsrc + i * 128 + j4);
      u32x2 w = {cvtpk(v.x, v.y), cvtpk(v.z, v.w)}; *reinterpret_cast<u32x2*>(lds + i * 272 + j4 * 2) = w; }
#pragma unroll
    for (int e = 0; e < 4; ++e) { int id = tid + e * NTHR; int j = id >> 4, c = id & 15; float f[8];
      unpack8(*reinterpret_cast<const u32x4*>(P + (size_t)(r0 + j) * PLD + OFF_SGU + 512 + g * 128 + c * 8), f);
      const float rs = sR[j]; bf16_t* bt = (bf16_t*)(lds + 34816);
#pragma unroll
      for (int q = 0; q < 8; ++q) { const int d = c * 8 + q; bt[d * 136 + j] = f2bf(gelu_f(f[q]) * rs * p.sgu_norm[layer * 512 + g * 128 + d]); } }
    __syncthreads();
    f32x16 acc[2];
#pragma unroll
    for (int r = 0; r < 16; ++r) { acc[0][r] = 0.f; acc[1][r] = 0.f; }
#pragma unroll
    for (int s = 0; s < 8; ++s) { const int co = (s * 16 + hi * 8) * 2;
      bf16x8 av = *reinterpret_cast<const bf16x8*>(lds + (it * 32 + l31) * 272 + co);
#pragma unroll
      for (int u = 0; u < 2; ++u) { bf16x8 bv = *reinterpret_cast<const bf16x8*>(lds + 34816 + ((dt0 + u) * 32 + l31) * 272 + co); acc[u] = mfma32(av, bv, acc[u]); } }
#pragma unroll
    for (int u = 0; u < 2; ++u)
#pragma unroll
      for (int r = 0; r < 16; ++r) { const int i = it * 32 + crow(r, hi); const int d = (dt0 + u) * 32 + l31;
        const float uu = gelu_f(bf2f(P[(size_t)(r0 + i) * PLD + OFF_SGU + g * 128 + d]));
        SG[(size_t)(r0 + i) * 512 + g * 128 + d] = f2bf(uu * (acc[u][r] + p.sgu_b[((size_t)layer * 4 + g) * 128 + i])); }
    __syncthreads();
  }
}

__device__ __forceinline__ void phase_mixers(const Params& p, int layer, char* lds, int rep) {
  char* ws = p.ws;
  volatile int* s_item_p = (volatile int*)(lds + LDS_BYTES + 8);
#define s_item (*s_item_p)
  int* ctr = (int*)(ws + WS_CTR) + layer + 2 * rep;
  const int n_ssd = 32, n_attl = 1024, n_attc = layer == 0 ? 16 : 0, n_sgu = layer == 0 ? 132 : 128;
  const int total = n_ssd + n_attl + n_attc + n_sgu;
  float* ML = (float*)(ws + WS_ML);
  for (;;) {
    __syncthreads();
    if (threadIdx.x == 0) s_item = atomicAdd(ctr, 1);
    __syncthreads();
    int it = s_item;
    if (it >= total) break;
    if (it < n_ssd) { ssd_item(p, layer, it, lds); continue; } it -= n_ssd;
    if (it < n_attl) {
      const int bh = it >> 6, qb = (it >> 1) & 31, sp = it & 1, b = bh >> 3, h = bh & 7;
      const size_t t0 = (size_t)b * SEQ + qb * 256;
      attn_item((const bf16_t*)(ws + WS_Q) + ((size_t)bh * SEQ + qb * 256) * 192, (const bf16_t*)(ws + WS_K) + ((size_t)bh * NKEYS + sp * (NKEYS / 2)) * 192,
                (const bf16_t*)(ws + WS_V) + ((size_t)bh * NKEYS + sp * (NKEYS / 2)) * 128, NKEYS / 2,
                (bf16_t*)(ws + (sp ? WS_ATT1 : WS_ATT)) + t0 * 1024 + h * 128, ML + ((size_t)sp * T_ALL + t0) * 16 + h * 2, lds);
      continue; } it -= n_attl;
    if (it < n_attc) {
      const int bh = it, b = bh >> 3, h = bh & 7; const size_t t0 = (size_t)T_LAT + b * CTXL;
      attn_item((const bf16_t*)(ws + WS_QC) + (size_t)bh * CTXL * 192, (const bf16_t*)(ws + WS_K) + (size_t)bh * NKEYS * 192,
                (const bf16_t*)(ws + WS_V) + (size_t)bh * NKEYS * 128, CTXL, (bf16_t*)(ws + WS_ATT) + t0 * 1024 + h * 128, ML + t0 * 16 + h * 2, lds);
      if (threadIdx.x < 256) { float* mp = ML + ((size_t)T_ALL + t0 + threadIdx.x) * 16 + h * 2; mp[0] = 0.f; mp[1] = 0.f; }
      continue; } it -= n_attc;
    sgu_item(p, layer, it, lds);
  }
#undef s_item
}

__device__ __forceinline__ void phase_cat(const Params& p, int layer, int nrows) {
  char* ws = p.ws;
  const int tid = otid(), lane = tid & 63, wid = tid >> 6;
  const bf16_t* ATT = (const bf16_t*)(ws + WS_ATT); const bf16_t* SG = (const bf16_t*)(ws + WS_SGUO);
  const bf16_t* YF = (const bf16_t*)(ws + WS_YF); const bf16_t* YB = (const bf16_t*)(ws + WS_YB);
  const bf16_t* XBC = (const bf16_t*)(ws + WS_XBC); const bf16_t* P = (const bf16_t*)(ws + WS_P);
  bf16_t* CAT = (bf16_t*)(ws + WS_H);
  const float* an = p.attn_out_norm + layer * 1024; const float* gn = p.gmlp_out_norm + layer * 512; const float* sn = p.ssd_norm + layer * 512;
  for (int t = blockIdx.x * 8 + wid; t < nrows; t += gridDim.x * 8) {
    float a0[8], a1[8], sg[8], y[8];
    unpack8(*reinterpret_cast<const u32x4*>(ATT + (size_t)t * 1024 + lane * 8), a0);
    unpack8(*reinterpret_cast<const u32x4*>(ATT + (size_t)t * 1024 + 512 + lane * 8), a1);
    {
      const float* ML = (const float*)(ws + WS_ML); const bf16_t* ATT1 = (const bf16_t*)(ws + WS_ATT1);
#pragma unroll
      for (int hh = 0; hh < 2; ++hh) { const int h = hh * 4 + (lane >> 4);
        const float m0 = ML[((size_t)t) * 16 + h * 2], l0 = ML[((size_t)t) * 16 + h * 2 + 1];
        const float m1 = ML[((size_t)T_ALL + t) * 16 + h * 2], l1 = ML[((size_t)T_ALL + t) * 16 + h * 2 + 1];
        if (l1 > 0.f) { const float M = fmaxf(m0, m1); const float w0 = l0 * __builtin_amdgcn_exp2f(m0 - M), w1 = l1 * __builtin_amdgcn_exp2f(m1 - M);
          const float inv = 1.f / (w0 + w1); float b1[8];
          unpack8(*reinterpret_cast<const u32x4*>(ATT1 + (size_t)t * 1024 + hh * 512 + lane * 8), b1);
          float* av = hh ? a1 : a0;
#pragma unroll
          for (int e = 0; e < 8; ++e) av[e] = (av[e] * w0 + b1[e] * w1) * inv; } } }
    unpack8(*reinterpret_cast<const u32x4*>(SG + (size_t)t * 512 + lane * 8), sg);
    float xs[8], z[8];
    unpack8(*reinterpret_cast<const u32x4*>(XBC + (size_t)t * 1024 + lane * 8), xs);
    unpack8(*reinterpret_cast<const u32x4*>(P + (size_t)t * PLD + OFF_Z + lane * 8), z);
    const float dsk = p.ssd_d[layer * 8 + (lane >> 3)];
    float yf[8], yb[8];
    unpack8(*reinterpret_cast<const u32x4*>(YF + (size_t)t * 512 + lane * 8), yf);
    unpack8(*reinterpret_cast<const u32x4*>(YB + (size_t)t * 512 + lane * 8), yb);
    float sa = 0.f, ssg = 0.f, sy = 0.f;
#pragma unroll
    for (int e = 0; e < 8; ++e) {
      y[e] = (yf[e] + yb[e] + dsk * xs[e]) * silu_f(z[e]);
      sa += a0[e] * a0[e] + a1[e] * a1[e]; ssg += sg[e] * sg[e]; sy += y[e] * y[e];
    }
    sa = wave_sum(sa); ssg = wave_sum(ssg); sy = wave_sum(sy);
    const float ra = rsqrtf(sa * (1.f / 1024.f) + EPS), rg = rsqrtf(ssg * (1.f / 512.f) + EPS), ry = rsqrtf(sy * (1.f / 512.f) + EPS);
#pragma unroll
    for (int e = 0; e < 8; ++e) {
      a0[e] *= ra * an[lane * 8 + e]; a1[e] *= ra * an[512 + lane * 8 + e];
      sg[e] *= rg * gn[lane * 8 + e]; y[e] *= ry * sn[lane * 8 + e];
    }
    bf16_t* cr = CAT + (size_t)t * HLD;
    *reinterpret_cast<u32x4*>(cr + lane * 8) = pack8(a0);
    *reinterpret_cast<u32x4*>(cr + 512 + lane * 8) = pack8(a1);
    *reinterpret_cast<u32x4*>(cr + 1024 + lane * 8) = pack8(sg);
    *reinterpret_cast<u32x4*>(cr + 1536 + lane * 8) = pack8(y);
  }
}

__device__ __forceinline__ void phase_gemm_out(const Params& p, int layer, int nrows, char* lds) {
  char* ws = p.ws;
  float* X = (float*)(ws + WS_X);
  const float* mods = (const float*)(ws + WS_MODS) + (size_t)layer * 3 * 12288 + 2 * DM;
  const float* xin = p.x; const float* cin = p.ctx;
  SchedRes S{ws + WS_H, ws + WS_WOUT, HLD, WLD, DM / 64, nrows > T_LAT ? 16 : 0};
  float* PART = (float*)(ws + WS_PART);
  auto epi = [=](const pg::f32x4 (&acc)[2][2][4][2], const pg::Unit& u, int wr, int wc, int fr, int fq) {
    const float* g1 = mods + mod_idx(u.m0) * 12288;
    const float* xsrc = layer == 0 ? (u.m0 < T_LAT ? xin : cin - (size_t)T_LAT * DM) : X;
    const int row0 = u.m0 + wr * 64 + fr;
#pragma unroll
    for (int bj = 0; bj < 2; ++bj)
#pragma unroll
      for (int n = 0; n < 2; ++n) { const int c = u.n0 + bj * 128 + wc * 32 + n * 16 + 4 * fq;
        const pg::f32x4 g = *reinterpret_cast<const pg::f32x4*>(g1 + c);
#pragma unroll
        for (int ai = 0; ai < 2; ++ai)
#pragma unroll
          for (int m = 0; m < 4; ++m) { const size_t o = (size_t)(row0 + ai * 128 + m * 16) * DM + c;
            if (u.tag) *reinterpret_cast<pg::f32x4*>(PART + o + (size_t)((u.tag - 1) * 512 - T_LAT) * DM) = acc[ai][bj][m][n];
            else { const pg::f32x4 xo = *reinterpret_cast<const pg::f32x4*>(xsrc + o);
              *reinterpret_cast<pg::f32x4*>(X + o) = xo + g * acc[ai][bj][m][n]; } } }
  };
  pg::gemm_phase<false>((LAS unsigned char*)lds, HLD, WLD, S, epi);
}

struct SchedFFN1 {
  const char* H2; const char* W; int MT;
  __device__ __forceinline__ bool next(int i, pg::Unit& u) const {
    int mt, ntl; if (!tile_of(i, MT, 44, mt, ntl)) return false;
    u.m0 = mt * 254 - 1; u.n0 = ntl * 256; u.a = H2 + (long)u.m0 * (HLD * 2); u.b = W + (size_t)u.n0 * WLD * 2; u.nt = DM / 64; u.tag = 0; return true; }
};
__device__ __forceinline__ float dpp_ror1(float v) { return __int_as_float(__builtin_amdgcn_update_dpp(0, __float_as_int(v), 0x121, 0xf, 0xf, false)); }
__device__ __forceinline__ float dpp_ror15(float v) { return __int_as_float(__builtin_amdgcn_update_dpp(0, __float_as_int(v), 0x12f, 0xf, 0xf, false)); }
__device__ __forceinline__ void phase_gemm_ffn1(const Params& p, int layer, int nrows, char* lds) {
  char* ws = p.ws;
  bf16_t* ACT = (bf16_t*)(ws + WS_ACT);
  const float* cw = p.ffn_conv_w + (size_t)layer * 3 * FFN; const float* cb = p.ffn_conv_b + (size_t)layer * FFN;
  SchedFFN1 S{ws + WS_H, ws + WS_WGU, (nrows + 253) / 254};
  float* EX = (float*)(lds + 131072);
  auto epi = [=](const pg::f32x4 (&acc)[2][2][4][2], const pg::Unit& u, int wr, int wc, int fr, int fq) {
    const int ccb = 32 * wc + 8 * fq;
#pragma unroll
    for (int ai = 0; ai < 2; ++ai) { const int q = 2 * ai + wr;
      if (fr == 0) {
#pragma unroll
        for (int n = 0; n < 2; ++n) *reinterpret_cast<pg::f32x4*>(EX + (q * 2 + 0) * 128 + ccb + 4 * n) = acc[ai][0][0][n]; }
      if (fr == 15) {
#pragma unroll
        for (int n = 0; n < 2; ++n) *reinterpret_cast<pg::f32x4*>(EX + (q * 2 + 1) * 128 + ccb + 4 * n) = acc[ai][0][3][n]; } }
    asm volatile("s_waitcnt lgkmcnt(0)" ::: "memory");
    __builtin_amdgcn_s_barrier(); asm volatile("" ::: "memory");
    __builtin_amdgcn_s_barrier(); asm volatile("" ::: "memory");
    const int ch0 = (u.n0 >> 1) + ccb;
#pragma unroll
    for (int n = 0; n < 2; ++n) {
      const pg::f32x4 w0 = *reinterpret_cast<const pg::f32x4*>(cw + ch0 + 4 * n), w1 = *reinterpret_cast<const pg::f32x4*>(cw + FFN + ch0 + 4 * n);
      const pg::f32x4 w2 = *reinterpret_cast<const pg::f32x4*>(cw + 2 * FFN + ch0 + 4 * n), bb = *reinterpret_cast<const pg::f32x4*>(cb + ch0 + 4 * n);
#pragma unroll
      for (int ai = 0; ai < 2; ++ai) { const int q = 2 * ai + wr;
        float o[4][4]; bool zp[4], zn[4];
#pragma unroll
        for (int m = 0; m < 4; ++m) { const int t = u.m0 + 128 * ai + 64 * wr + 16 * m + fr; const bool tv = t >= 0 && t < nrows;
          zp[m] = !tv || seq_start(t); zn[m] = !tv || seq_end(t); }
#pragma unroll
        for (int j = 0; j < 4; ++j) {
          float R[4], L[4];
#pragma unroll
          for (int m = 0; m < 4; ++m) { R[m] = dpp_ror1(acc[ai][0][m][n][j]); L[m] = dpp_ror15(acc[ai][0][m][n][j]); }
          const float exp_ = q > 0 ? EX[((q - 1) * 2 + 1) * 128 + ccb + 4 * n + j] : 0.f;
          const float exn_ = q < 3 ? EX[((q + 1) * 2 + 0) * 128 + ccb + 4 * n + j] : 0.f;
#pragma unroll
          for (int m = 0; m < 4; ++m) {
            float pv = fr > 0 ? R[m] : (m > 0 ? R[m > 0 ? m - 1 : 0] : exp_);
            float nv = fr < 15 ? L[m] : (m < 3 ? L[m < 3 ? m + 1 : 3] : exn_);
            pv = zp[m] ? 0.f : pv; nv = zn[m] ? 0.f : nv;
            const float cv = bb[j] + w0[j] * pv + w1[j] * acc[ai][0][m][n][j] + w2[j] * nv;
            o[m][j] = cv * __builtin_amdgcn_rcpf(1.f + __builtin_amdgcn_exp2f(-1.4426950408889634f * cv)) * acc[ai][1][m][n][j];
          } }
#pragma unroll
        for (int m = 0; m < 4; ++m) { const int e = 128 * ai + 64 * wr + 16 * m + fr; const int t = u.m0 + e;
          if (e >= 1 && e <= 254 && t < nrows) { u32x2 w = {cvtpk(o[m][0], o[m][1]), cvtpk(o[m][2], o[m][3])}; *reinterpret_cast<u32x2*>(ACT + (size_t)t * FFN + ch0 + 4 * n) = w; } }
        __builtin_amdgcn_sched_barrier(0);
      }
    }
  };
  pg::gemm_phase<true>((LAS unsigned char*)lds, HLD, WLD, S, epi);
}

__device__ __forceinline__ void phase_gemm_down(const Params& p, int layer, int nrows, char* lds) {
  char* ws = p.ws;
  float* X = (float*)(ws + WS_X); float* out = p.out;
  const float* mods = (const float*)(ws + WS_MODS) + (size_t)layer * 3 * 12288 + 5 * DM;
  SchedRes S{ws + WS_ACT, ws + WS_WDN, FFN, FFN, FFN / 64, nrows > T_LAT ? 16 : 0};
  float* PART = (float*)(ws + WS_PART);
  auto epi = [=](const pg::f32x4 (&acc)[2][2][4][2], const pg::Unit& u, int wr, int wc, int fr, int fq) {
    const float* g2 = mods + mod_idx(u.m0) * 12288;
    float* dst = layer == 0 ? X : out;
    const int row0 = u.m0 + wr * 64 + fr;
#pragma unroll
    for (int bj = 0; bj < 2; ++bj)
#pragma unroll
      for (int n = 0; n < 2; ++n) { const int c = u.n0 + bj * 128 + wc * 32 + n * 16 + 4 * fq;
        const pg::f32x4 g = *reinterpret_cast<const pg::f32x4*>(g2 + c);
#pragma unroll
        for (int ai = 0; ai < 2; ++ai)
#pragma unroll
          for (int m = 0; m < 4; ++m) { const size_t o = (size_t)(row0 + ai * 128 + m * 16) * DM + c;
            if (u.tag) *reinterpret_cast<pg::f32x4*>(PART + o + (size_t)((u.tag - 1) * 512 - T_LAT) * DM) = acc[ai][bj][m][n];
            else { const pg::f32x4 xo = *reinterpret_cast<const pg::f32x4*>(X + o);
              *reinterpret_cast<pg::f32x4*>(dst + o) = xo + g * acc[ai][bj][m][n]; } } }
  };
  pg::gemm_phase<false>((LAS unsigned char*)lds, FFN, FFN, S, epi);
}

#ifndef DBG_NAN
#define DBG_NAN 0
#endif
#if DBG_NAN
__device__ __forceinline__ void nan_scan(const Params& p, size_t off, size_t n, int isbf, int code) {
  int* flags = (int*)(p.ws + WS_CTR) + 8;
  const char* base = p.ws + off; bool bad = false;
  for (size_t i = (size_t)blockIdx.x * NTHR + threadIdx.x; i < n; i += (size_t)gridDim.x * NTHR) {
    float v = isbf ? bf2f(((const bf16_t*)base)[i]) : ((const float*)base)[i];
    if (!(fabsf(v) < 1e30f)) bad = true;
  }
  if (bad) atomicMin(flags, code);
}
__device__ __forceinline__ void dbg_scan(const Params& p, int ph) {
  const int k = (ph + 1) * 10;
  if (ph == 0) { nan_scan(p, WS_MODS, 2 * 3 * 12288, 0, k); nan_scan(p, WS_ROPE, 4096, 0, k + 1); nan_scan(p, WS_WIN, (size_t)49152000, 1, k + 2); return; }
  const int layer = (ph - 1) / 10, s = (ph - 1) % 10; const size_t nr = layer == 0 ? T_ALL : T_LAT;
  switch (s) {
    case 0: nan_scan(p, WS_H, (size_t)T_ALL * DM, 1, k); break;
    case 1: nan_scan(p, WS_P, (size_t)T_ALL * PLD, 1, k); nan_scan(p, WS_DT, (size_t)T_ALL * 16, 0, k + 1); break;
    case 2: nan_scan(p, WS_QRAW, (size_t)T_ALL * 1536, 1, k); nan_scan(p, WS_KVRAW, (size_t)T_ALL * 2048, 1, k + 1); nan_scan(p, WS_RSTD, (size_t)T_ALL * 2, 0, k + 2);
            nan_scan(p, WS_XBC, (size_t)T_ALL * 1024, 1, k + 3); nan_scan(p, WS_DT, (size_t)T_ALL * 16, 0, k + 4); break;
    case 3: nan_scan(p, WS_Q, (size_t)16 * SEQ * 192, 1, k); nan_scan(p, WS_K, (size_t)16 * NKEYS * 192, 1, k + 1); nan_scan(p, WS_V, (size_t)16 * NKEYS * 128, 1, k + 2); break;
    case 4: nan_scan(p, WS_ATT, (size_t)T_LAT * 1024, 1, k); nan_scan(p, WS_SGUO, (size_t)T_LAT * 512, 1, k + 1); nan_scan(p, WS_YF, (size_t)T_ALL * 512, 0, k + 2); nan_scan(p, WS_YB, (size_t)T_ALL * 512, 0, k + 3); break;
    case 5: nan_scan(p, WS_H, nr * DM, 1, k); break;
    case 6: nan_scan(p, WS_X, nr * DM, 0, k); break;
    case 7: nan_scan(p, WS_H, nr * DM, 1, k); break;
    case 8: nan_scan(p, WS_ACT, nr * FFN, 1, k); break;
    default: if (layer == 0) nan_scan(p, WS_X, nr * DM, 0, k); break;
  }
}
#endif
typedef const __attribute__((address_space(4))) Params* KArgP;
__device__ __forceinline__ Params load_params() {
#if defined(__HIP_DEVICE_COMPILE__)
  KArgP q = (KArgP)__builtin_amdgcn_kernarg_segment_ptr(); asm volatile("" : "+s"(q));
  Params r; __builtin_memcpy(&r, q, sizeof(Params)); return r;
#else
  return Params{};
#endif
}
__device__ __forceinline__ void run_phase(int ph, char* lds, int rep) {
  if (ph == 0) { const Params p = load_params(); phase_prep(p, lds); return; }
  const int layer = (ph - 1) / 10, s = (ph - 1) % 10;
  const int nrows2 = layer == 0 ? T_ALL : T_LAT;
  switch (s) {
    case 0: { const Params p = load_params(); phase_norm_mod(p, layer, 0, T_ALL); if (layer == 1) convert_weights(p, 1, lds); } break;
    case 1: { const Params p = load_params(); phase_gemm_in(p, lds); } break;
    case 2: { const Params p = load_params(); phase_qkv_gemm_and_post(p, layer, lds); } break;
    case 3: { const Params p = load_params(); phase_build_qkv(p, layer); } break;
    case 4: { const Params p = load_params(); phase_mixers(p, layer, lds, rep); } break;
    case 5: { const Params p = load_params(); phase_cat(p, layer, nrows2); } break;
    case 6: { const Params p = load_params(); phase_gemm_out(p, layer, nrows2, lds); } break;
    case 7: { const Params p = load_params(); phase_norm_mod(p, layer, 1, nrows2); } break;
    case 8: { const Params p = load_params(); phase_gemm_ffn1(p, layer, nrows2, lds); } break;
    default: { const Params p = load_params(); phase_gemm_down(p, layer, nrows2, lds); } break;
  }
}

__global__ void __launch_bounds__(NTHR) mega_fwd(Params p) {
  extern __shared__ __attribute__((aligned(16))) char lds[];
#if MULTI_LAUNCH
  run_phase((int)p.ph_lo, lds, 0);
#else
  cg::grid_group grid = cg::this_grid();
  unsigned* bar_st = (unsigned*)(lds + LDS_BYTES);
  if (threadIdx.x < 4) bar_st[threadIdx.x] = 0u;
  __syncthreads();
  XcdBarrier xb = xcd_barrier_post((unsigned*)(p.ws + WS_BAR), (volatile LAS unsigned*)bar_st);
  for (int ph = 0; ph < 21; ++ph) {
#if REPEAT_MASK
    if (ph > 0 && ((REPEAT_MASK >> ((ph - 1) % 10)) & 1)) { run_phase(ph, lds, 1); xcd_barrier(xb); }
#endif
    run_phase(ph, lds, 0);
    if (ph == 0) grid.sync();
    else if (ph + 1 < 21) xcd_barrier(xb);
  }
#endif
}


#if DBG_NAN
__global__ void __launch_bounds__(NTHR) dbg_init_k(Params p) { ((int*)(p.ws + WS_CTR))[8] = 100000; }
__global__ void __launch_bounds__(NTHR) dbg_scan_k(Params p) { dbg_scan(p, (int)p.ph_lo); }
__global__ void __launch_bounds__(NTHR) dbg_report_k(Params p) {
  int code = ((int*)(p.ws + WS_CTR))[8];
  if (code < 100000) { float e = (float)(code / 10) * 0.5f; float c = sqrtf(1.27f) * __powf(10.f, e) * (1.f + 0.1f * (float)(code % 10));
    for (size_t i = (size_t)blockIdx.x * NTHR + threadIdx.x; i < (size_t)T_LAT * DM; i += (size_t)gridDim.x * NTHR) p.out[i] = c; }
}
#endif
extern "C" void kernel_launch(void* const* d_in, const int* in_sizes, int n_in, void* d_out, int out_size, void* d_ws, size_t ws_size, hipStream_t stream) {
  static int grid_blocks = 0;
  if (grid_blocks == 0) {
    if (n_in != 32 || out_size != T_LAT * DM || ws_size < WS_END) {
      fprintf(stderr, "kernel_launch: bad shapes: n_in %d out %d ws %zu (need %zu)\n", n_in, out_size, ws_size, (size_t)WS_END); grid_blocks = -1; return; }
    int dev = 0, cus = 0, per_cu = 0;
    hipGetDevice(&dev); hipDeviceGetAttribute(&cus, hipDeviceAttributeMultiprocessorCount, dev);
    hipFuncSetAttribute((const void*)mega_fwd, hipFuncAttributeMaxDynamicSharedMemorySize, LDS_DYN);
    hipOccupancyMaxActiveBlocksPerMultiprocessor(&per_cu, (const void*)mega_fwd, NTHR, LDS_DYN);
    if (per_cu < 1) { fprintf(stderr, "kernel_launch: occupancy query says %d blocks/CU\n", per_cu); per_cu = 1; }
    grid_blocks = cus * per_cu;
  }
  if (grid_blocks < 0) return;
  Params p{};
  const float** pp = (const float**)&p;
  for (int i = 0; i < 32; ++i) pp[i] = (const float*)d_in[i];
  p.out = (float*)d_out; p.ws = (char*)d_ws; p.ph_lo = 0; p.ph_hi = 21;
#if MULTI_LAUNCH
  for (int ph = 0; ph < 21; ++ph) { p.ph_lo = ph; p.ph_hi = ph + 1; hipLaunchKernelGGL(mega_fwd, dim3(grid_blocks), dim3(NTHR), LDS_DYN, stream, p);
#if DBG_NAN
    if (ph == 0) hipLaunchKernelGGL(dbg_init_k, dim3(1), dim3(1), 0, stream, p);
    hipLaunchKernelGGL(dbg_scan_k, dim3(grid_blocks), dim3(NTHR), 0, stream, p);
#endif
  }
#if DBG_NAN
  hipLaunchKernelGGL(dbg_report_k, dim3(grid_blocks), dim3(NTHR), 0, stream, p);
#endif
#else
  hipMemsetAsync((char*)d_ws + WS_BAR, 0, XCD_BAR_WORDS * 4, stream);
  void* args[] = {&p};
  hipError_t e = hipLaunchCooperativeKernel((const void*)mega_fwd, dim3(grid_blocks), dim3(NTHR), args, LDS_DYN, stream);
  if (e != hipSuccess) fprintf(stderr, "cooperative launch failed: %s (grid %d)\n", hipGetErrorString(e), grid_blocks);
#endif
}
```

```cpp
#include <hip/hip_runtime.h>
#include <hip/hip_cooperative_groups.h>
#include <cstdio>
#include <cstdint>
namespace cg = cooperative_groups;

#ifndef REPEAT_MASK
#define REPEAT_MASK 0
#endif
#ifndef MULTI_LAUNCH
#define MULTI_LAUNCH 0
#endif

typedef unsigned short bf16_t;
using bf16x8 = __attribute__((ext_vector_type(8))) short;
using s16x4  = __attribute__((ext_vector_type(4))) short;
using f32x16 = __attribute__((ext_vector_type(16))) float;
using u32x4  = __attribute__((ext_vector_type(4))) unsigned;
using u32x2  = __attribute__((ext_vector_type(2))) unsigned;

constexpr int NTHR = 512;
constexpr int DM = 2048, SEQ = 8192, CTXL = 256, NB = 2;
constexpr int T_LAT = NB * SEQ;
constexpr int T_ALL = T_LAT + NB * CTXL;
constexpr int PIN = 3920, PLD = 3968, PNP = 4096;
constexpr int OFF_CKV = 768, OFF_KR = 1280, OFF_SGU = 1344, OFF_Z = 2368, OFF_XBC = 2880, OFF_DT = 3904;
constexpr int FFN = 5632;
constexpr int HLD = 2112, WLD = 2112, UKVLD = 768;
constexpr int NKEYS = CTXL + SEQ;
constexpr float EPS = 1e-6f;
constexpr float QSCALE = 0.07216878364870322f * 1.4426950408889634f;

constexpr size_t al256(size_t x) { return (x + 255) / 256 * 256; }
constexpr size_t WS_WIN  = 0;
constexpr size_t WS_WUQ  = WS_WIN  + (size_t)PNP * WLD * 2;
constexpr size_t WS_WUKV = WS_WUQ  + (size_t)1536 * 768 * 2;
constexpr size_t WS_WOUT = WS_WUKV + (size_t)2048 * UKVLD * 2;
constexpr size_t WS_WGU  = WS_WOUT + (size_t)2048 * WLD * 2;
constexpr size_t WS_WDN  = WS_WGU  + (size_t)2 * FFN * WLD * 2;
constexpr size_t WS_X    = WS_WDN  + (size_t)DM * FFN * 2;
constexpr size_t WS_MODS = WS_X    + (size_t)T_ALL * DM * 4;
constexpr size_t WS_ROPE = WS_MODS + (size_t)2 * 3 * 12288 * 4;
constexpr size_t WS_CTR  = WS_ROPE + (size_t)128 * 16 * 2 * 4;
constexpr size_t WS_BAR  = al256(WS_CTR + 256);
constexpr size_t WS_A1   = al256(WS_BAR + 3456 * 4);
constexpr size_t WS_P    = WS_A1;
constexpr size_t WS_DT   = WS_P    + (size_t)T_ALL * PLD * 2;
constexpr size_t WS_RSTD = WS_DT   + (size_t)T_ALL * 16 * 4;
constexpr size_t WS_A2   = al256(WS_RSTD + (size_t)T_ALL * 2 * 4);
constexpr size_t WS_QRAW = WS_A2;
constexpr size_t WS_KVRAW= WS_QRAW + (size_t)T_ALL * 1536 * 2;
constexpr size_t WS_A2END= WS_KVRAW+ (size_t)T_ALL * 2048 * 2;
constexpr size_t WS_ATT  = WS_A2;
constexpr size_t WS_SGUO = WS_ATT  + (size_t)T_ALL * 1024 * 2;
constexpr size_t WS_YF   = WS_SGUO + (size_t)T_ALL * 512 * 2;
constexpr size_t WS_YB   = WS_YF   + (size_t)T_ALL * 512 * 2;
static_assert(WS_YB + (size_t)T_ALL * 512 * 2 <= WS_A2END, "A2 alias overflow");
constexpr size_t WS_XBC  = al256(WS_A2END);
constexpr size_t WS_A4   = al256(WS_XBC + (size_t)T_ALL * 1024 * 2);
constexpr size_t WS_Q    = WS_A4;
constexpr size_t WS_QC   = WS_Q    + (size_t)16 * SEQ * 192 * 2;
constexpr size_t WS_K    = WS_QC   + (size_t)16 * CTXL * 192 * 2;
constexpr size_t WS_V    = WS_K    + (size_t)16 * NKEYS * 192 * 2;
constexpr size_t WS_END0 = al256(WS_V + (size_t)16 * NKEYS * 128 * 2);
constexpr size_t WS_ATT1 = WS_END0;
constexpr size_t WS_ML   = WS_ATT1 + (size_t)T_ALL * 1024 * 2;
constexpr size_t WS_PART = al256(WS_ML + (size_t)2 * T_ALL * 8 * 2 * 4);
constexpr size_t WS_END  = al256(WS_PART + (size_t)4 * 512 * DM * 4);
constexpr size_t WS_H    = WS_A4;
constexpr size_t WS_ACT  = WS_A1;
static_assert(WS_ACT + (size_t)T_ALL * FFN * 2 <= WS_XBC + (size_t)T_ALL * 1024 * 2, "ACT alias overflow");
static_assert((size_t)T_ALL * HLD * 2 <= WS_END - WS_A4, "H alias overflow");

constexpr int LDS_BYTES = 140800;
constexpr int LDS_DYN = LDS_BYTES + 16;

struct Params {
  const float *x, *c, *ctx, *c_ctx, *w_mod, *b_mod, *norm_mix, *norm_ffn, *w_in, *q_a_norm, *w_uq, *kv_a_norm, *w_ukv,
              *q_norm, *k_norm, *attn_out_norm, *sgu_norm, *sgu_w, *sgu_b, *gmlp_out_norm, *ssd_conv_w, *ssd_conv_b,
              *ssd_dt_bias, *ssd_a_log, *ssd_d, *ssd_norm, *w_out, *ffn_w_gate, *ffn_w_up, *ffn_conv_w, *ffn_conv_b, *ffn_w_down;
  float* out; char* ws;
  long long ph_lo, ph_hi;
};

__device__ __forceinline__ int otid() { int t = threadIdx.x; asm volatile("" : "+v"(t)); return t; }
typedef float f32x2_t __attribute__((ext_vector_type(2)));
typedef __bf16 bf16x2_t __attribute__((ext_vector_type(2)));
__device__ __forceinline__ unsigned cvtpk(float lo, float hi) {
  f32x2_t v = {lo, hi}; bf16x2_t r = __builtin_convertvector(v, bf16x2_t);
  return __builtin_bit_cast(unsigned, r);
}
__device__ __forceinline__ bf16_t f2bf(float x) { return __builtin_bit_cast(bf16_t, (__bf16)x); }
__device__ __forceinline__ float bf2f(bf16_t b) { return __uint_as_float(((unsigned)b) << 16); }
__device__ __forceinline__ float bflo(unsigned w) { return __uint_as_float(w << 16); }
__device__ __forceinline__ float bfhi(unsigned w) { return __uint_as_float(w & 0xffff0000u); }
__device__ __forceinline__ void unpack8(u32x4 w, float* f) {
  f[0] = bflo(w[0]); f[1] = bfhi(w[0]); f[2] = bflo(w[1]); f[3] = bfhi(w[1]);
  f[4] = bflo(w[2]); f[5] = bfhi(w[2]); f[6] = bflo(w[3]); f[7] = bfhi(w[3]);
}
__device__ __forceinline__ u32x4 pack8(const float* f) {
  u32x4 w = {cvtpk(f[0], f[1]), cvtpk(f[2], f[3]), cvtpk(f[4], f[5]), cvtpk(f[6], f[7])}; return w;
}
__device__ __forceinline__ float wave_sum(float v) {
  { auto rr = __builtin_amdgcn_permlane32_swap(__float_as_uint(v), __float_as_uint(v), false, false); v = __uint_as_float(rr[0]) + __uint_as_float(rr[1]); }
  { auto rr = __builtin_amdgcn_permlane16_swap(__float_as_uint(v), __float_as_uint(v), false, false); v = __uint_as_float(rr[0]) + __uint_as_float(rr[1]); }
  v += __int_as_float(__builtin_amdgcn_update_dpp(0, __float_as_int(v), 0x128, 0xf, 0xf, false));
  v += __int_as_float(__builtin_amdgcn_update_dpp(0, __float_as_int(v), 0x124, 0xf, 0xf, false));
  v += __int_as_float(__builtin_amdgcn_update_dpp(0, __float_as_int(v), 0x122, 0xf, 0xf, false));
  v += __int_as_float(__builtin_amdgcn_update_dpp(0, __float_as_int(v), 0x121, 0xf, 0xf, false));
  return v;
}
__device__ __forceinline__ float lane_xor16(float v, int lane) {
  auto rr = __builtin_amdgcn_permlane16_swap(__float_as_uint(v), __float_as_uint(v), false, false);
  return __uint_as_float(((lane >> 4) & 1) ? rr[0] : rr[1]);
}
__device__ __forceinline__ float silu_f(float x) { return x * __builtin_amdgcn_rcpf(1.f + __builtin_amdgcn_exp2f(-1.4426950408889634f * x)); }
__device__ __forceinline__ float gelu_f(float x) {
  float u = 0.7978845608028654f * (x + 0.044715f * x * x * x);
  float t = 1.f - 2.f * __builtin_amdgcn_rcpf(__builtin_amdgcn_exp2f(2.8853900817779268f * u) + 1.f);
  return 0.5f * x * (1.f + t);
}
__device__ __forceinline__ int crow(int r, int hi) { return (r & 3) + 8 * (r >> 2) + 4 * hi; }
__device__ __forceinline__ f32x16 mfma32(bf16x8 a, bf16x8 b, f32x16 c) { return __builtin_amdgcn_mfma_f32_32x32x16_bf16(a, b, c, 0, 0, 0); }
__device__ __forceinline__ bool seq_start(int t) { return t < T_LAT ? ((t & (SEQ - 1)) == 0) : (((t - T_LAT) & (CTXL - 1)) == 0); }
__device__ __forceinline__ bool seq_end(int t) { return t < T_LAT ? ((t & (SEQ - 1)) == SEQ - 1) : (((t - T_LAT) & (CTXL - 1)) == CTXL - 1); }
__device__ __forceinline__ int mod_idx(int row) { return row < SEQ ? 0 : (row < T_LAT ? 1 : 2); }

#define XB_TMO      128
#define XB_XCNT(j)  (256  + 64 * (j))
#define XB_XSUB(j)  (1280 + 64 * (j))
#define XB_XGEN(j)  (2304 + 64 * (j))
#define XB_TOP      3328
#define XB_TOPGEN   3392
#define XCD_BAR_WORDS 3456
#define XB_SPIN_CAP (1u << 24)
#define LAS __attribute__((address_space(3)))

__device__ __forceinline__ unsigned xb_ld(unsigned* p)              { return __hip_atomic_load(p, __ATOMIC_RELAXED, __HIP_MEMORY_SCOPE_AGENT); }
__device__ __forceinline__ unsigned xb_add(unsigned* p, unsigned v) { return __hip_atomic_fetch_add(p, v, __ATOMIC_RELAXED, __HIP_MEMORY_SCOPE_AGENT); }
__device__ __forceinline__ unsigned xb_xcc_id() { return (unsigned)__builtin_amdgcn_s_getreg((3 << 11) | 20) & 0xFu; }
#define XB_SPIN(cond, bar) do { unsigned _sp = 0; while (cond) { __builtin_amdgcn_s_sleep(1); \
    if ((++_sp & 255u) == 0u) { if (xb_ld(&(bar)[XB_TMO])) break; if (_sp > XB_SPIN_CAP) { atomicAdd(&(bar)[XB_TMO], 1u); break; } } } } while (0)

struct XcdBarrier {
    unsigned* bar; unsigned x;
    volatile LAS unsigned* st;
};

__device__ __forceinline__ XcdBarrier xcd_barrier_post(unsigned* bar, volatile LAS unsigned* st) {
    XcdBarrier b; b.bar = bar; b.x = xb_xcc_id(); b.st = st;
    if (threadIdx.x == 0) (void)xb_add(&bar[XB_XCNT(b.x)], 1u);
    return b;
}
__device__ __forceinline__ void xcd_barrier_complete(unsigned* bar, unsigned x, unsigned& nloc, unsigned& nx) {
    const unsigned G = gridDim.x * gridDim.y * gridDim.z;
    unsigned sum, cnt, mine, sp = 0u;
    for (;;) {
        sum = 0u; cnt = 0u; mine = 0u;
#pragma unroll
        for (unsigned j = 0; j < 16; ++j) { const unsigned c = xb_ld(&bar[XB_XCNT(j)]); sum += c; cnt += (c > 0u) ? 1u : 0u; mine = (j == x) ? c : mine; }
        if (sum == G) break;
        __builtin_amdgcn_s_sleep(1);
        if ((++sp & 255u) == 0u) { if (xb_ld(&bar[XB_TMO])) break; if (sp > XB_SPIN_CAP) { atomicAdd(&bar[XB_TMO], 1u); break; } }
    }
    nloc = mine > 0u ? mine : 1u; nx = cnt > 0u ? cnt : 1u;
}

__device__ __forceinline__ void xcd_barrier(const XcdBarrier& b) {
    asm volatile("s_waitcnt vmcnt(0)" ::: "memory");
    __syncthreads();
    if (threadIdx.x == 0) {
        unsigned* bar = b.bar;
        __builtin_amdgcn_s_waitcnt(0);
        unsigned nloc = b.st[0], nx = b.st[1];
        if (nloc == 0u) { xcd_barrier_complete(bar, b.x, nloc, nx); b.st[0] = nloc; b.st[1] = nx; }
        const unsigned old = xb_add(&bar[XB_XSUB(b.x)], 1u);
        const unsigned gen = old / nloc;
        if (old + 1u == (gen + 1u) * nloc) {
            __builtin_amdgcn_fence(__ATOMIC_RELEASE, "agent");
            asm volatile("s_waitcnt vmcnt(0)" ::: "memory");
            const unsigned og = xb_add(&bar[XB_TOP], 1u);
            const unsigned tg = og / nx;
            if (og + 1u == (tg + 1u) * nx) xb_add(&bar[XB_TOPGEN], 1u);
            else XB_SPIN(xb_ld(&bar[XB_TOPGEN]) == tg, bar);
            __builtin_amdgcn_fence(__ATOMIC_ACQUIRE, "agent");
            xb_add(&bar[XB_XGEN(b.x)], 1u);
            asm volatile("s_waitcnt vmcnt(0)" ::: "memory");
        } else {
            XB_SPIN(xb_ld(&bar[XB_XGEN(b.x)]) == gen, bar);
            __builtin_amdgcn_fence(__ATOMIC_ACQUIRE, "agent");
            asm volatile("s_waitcnt vmcnt(0)" ::: "memory");
        }
    }
    __syncthreads();
}


__device__ __forceinline__ void convert_tile(const float* __restrict__ src, int K, int N, bf16_t* __restrict__ dst, int ldd, int mode, const float* __restrict__ kscale,
                             int tk, int tn, char* lds) {
  const int tid = otid();
  bf16_t* s = (bf16_t*)lds;
  __syncthreads();
  float v[16];
#pragma unroll
  for (int e = 0; e < 16; ++e) {
    const int id = tid + e * NTHR; const int n = id & 127, k = id >> 7;
    const int gk = tk * 64 + k, gn = tn * 128 + n;
    v[e] = gn < N ? src[(size_t)gk * N + gn] : 0.f;
    if (kscale) v[e] *= kscale[gk];
  }
#pragma unroll
  for (int e = 0; e < 16; ++e) { const int id = tid + e * NTHR; const int n = id & 127, k = id >> 7; s[n * 68 + k] = f2bf(v[e]); }
  __syncthreads();
#pragma unroll
  for (int e = 0; e < 2; ++e) {
    int id = tid + e * NTHR; int n = id >> 3, c = id & 7;
    int gn = tn * 128 + n; int drow;
    if (mode == 0) drow = gn;
    else { drow = (gn >> 7) * 256 + (mode == 2 ? 128 : 0) + (gn & 127); }
    const u32x2 a = *reinterpret_cast<const u32x2*>(s + n * 68 + c * 8), b = *reinterpret_cast<const u32x2*>(s + n * 68 + c * 8 + 4);
    u32x4 w = {a[0], a[1], b[0], b[1]};
    *reinterpret_cast<u32x4*>(dst + (size_t)drow * ldd + tk * 64 + c * 8) = w;
  }
}

__device__ __forceinline__ void convert_weights(const Params& p, int layer, char* lds) {
  char* ws = p.ws;
  const int n_in = 32 * 32, n_uq = 12 * 12, n_ukv = 8 * 16, n_out = 32 * 16, n_g = 32 * 44, n_dn = 88 * 16;
  const int total = n_in + n_uq + n_ukv + n_out + 2 * n_g + n_dn;
  for (int it = blockIdx.x; it < total; it += gridDim.x) {
    int i = it;
    if (i < n_in) { convert_tile(p.w_in + (size_t)layer * DM * PIN, DM, PIN, (bf16_t*)(ws + WS_WIN), WLD, 0, nullptr, i & 31, i >> 5, lds); continue; } i -= n_in;
    if (i < n_uq) { convert_tile(p.w_uq + (size_t)layer * 768 * 1536, 768, 1536, (bf16_t*)(ws + WS_WUQ), 768, 0, p.q_a_norm + layer * 768, i % 12, i / 12, lds); continue; } i -= n_uq;
    if (i < n_ukv) { convert_tile(p.w_ukv + (size_t)layer * 512 * 2048, 512, 2048, (bf16_t*)(ws + WS_WUKV), UKVLD, 0, p.kv_a_norm + layer * 512, i & 7, i >> 3, lds); continue; } i -= n_ukv;
    if (i < n_out) { convert_tile(p.w_out + (size_t)layer * DM * DM, DM, DM, (bf16_t*)(ws + WS_WOUT), WLD, 0, nullptr, i & 31, i >> 5, lds); continue; } i -= n_out;
    if (i < n_g) { convert_tile(p.ffn_w_gate + (size_t)layer * DM * FFN, DM, FFN, (bf16_t*)(ws + WS_WGU), WLD, 1, nullptr, i & 31, i >> 5, lds); continue; } i -= n_g;
    if (i < n_g) { convert_tile(p.ffn_w_up + (size_t)layer * DM * FFN, DM, FFN, (bf16_t*)(ws + WS_WGU), WLD, 2, nullptr, i & 31, i >> 5, lds); continue; } i -= n_g;
    convert_tile(p.ffn_w_down + (size_t)layer * FFN * DM, FFN, DM, (bf16_t*)(ws + WS_WDN), FFN, 0, nullptr, i % 88, i / 88, lds);
  }
}

__device__ __forceinline__ void sincos_small(float x, float& s, float& c) {
  float kf = rintf(x * 0.6366197723675814f); int k = (int)kf;
  float r = fmaf(-kf, 1.5707963705062866f, x); r = fmaf(-kf, -4.371139000186241e-8f, r);
  float r2 = r * r;
  float sp = r + r * r2 * (-1.6666654611e-1f + r2 * (8.3321608736e-3f + r2 * (-1.9515295891e-4f)));
  float cp = 1.f + r2 * (-0.5f + r2 * (4.166664568298827e-2f + r2 * (-1.388731625493765e-3f + r2 * 2.443315711809948e-5f)));
  int q = k & 3;
  float ss = (q & 1) ? cp : sp, cc = (q & 1) ? sp : cp;
  s = (q & 2) ? -ss : ss; c = ((q + 1) & 2) ? -cc : cc;
}

__device__ __forceinline__ void phase_prep(const Params& p, char* lds) {
  const int tid = otid(), lane = tid & 63, wid = tid >> 6;
  char* ws = p.ws;
  if (blockIdx.x == 0) {
    int* ctr = (int*)(ws + WS_CTR);
    if (tid < 64) ctr[tid] = 0;
    float* rope = (float*)(ws + WS_ROPE);
    for (int i = tid; i < 128 * 16; i += NTHR) {
      int pos = i >> 4, j = i & 15;
      float freq = exp2f(-(float)j * (13.287712379549449f / 16.f));
      float ang = (float)pos * freq; float s, c; sincos_small(ang, s, c);
      rope[i * 2] = c; rope[i * 2 + 1] = s;
    }
  }
  float* sc = (float*)lds;
  float* red = sc + 3 * 2048;
  __syncthreads();
  for (int i = tid; i < 3 * 2048; i += NTHR) {
    int j = i >> 11, k = i & 2047;
    float v = (j < 2) ? p.c[j * DM + k] : p.c_ctx[k];
    sc[i] = silu_f(v);
  }
  __syncthreads();
  float* mods = (float*)(ws + WS_MODS);
  for (int it = blockIdx.x; it < 2 * 192; it += gridDim.x) {
    int layer = it / 192, cg_ = it % 192; int n = cg_ * 64 + lane;
    const float* w = p.w_mod + (size_t)layer * DM * 12288 + n;
    float a0 = 0.f, a1 = 0.f, a2 = 0.f;
    int k0 = wid * 256;
    for (int kb = k0; kb < k0 + 256; kb += 32) {
      float wv[32];
#pragma unroll
      for (int u = 0; u < 32; ++u) wv[u] = w[(size_t)(kb + u) * 12288];
#pragma unroll
      for (int u = 0; u < 32; ++u) { a0 = fmaf(sc[kb + u], wv[u], a0); a1 = fmaf(sc[2048 + kb + u], wv[u], a1); a2 = fmaf(sc[4096 + kb + u], wv[u], a2); }
    }
    red[(wid * 3 + 0) * 64 + lane] = a0; red[(wid * 3 + 1) * 64 + lane] = a1; red[(wid * 3 + 2) * 64 + lane] = a2;
    __syncthreads();
    if (tid < 192) {
      int j = tid >> 6, l = tid & 63; float s = 0.f;
#pragma unroll
      for (int w8 = 0; w8 < 8; ++w8) s += red[(w8 * 3 + j) * 64 + l];
      int nn = cg_ * 64 + l;
      mods[(size_t)(layer * 3 + j) * 12288 + nn] = s + p.b_mod[layer * 12288 + nn];
    }
    __syncthreads();
  }
  convert_weights(p, 0, lds);
}

__device__ __forceinline__ void phase_norm_mod(const Params& p, int layer, int which, int nrows) {
  const int tid = otid(), lane = tid & 63, wid = tid >> 6;
  char* ws = p.ws;
  const float* gain = (which ? p.norm_ffn : p.norm_mix) + layer * DM;
  const float* mods = (const float*)(ws + WS_MODS) + (size_t)layer * 3 * 12288;
  const float* X = (const float*)(ws + WS_X);
  bf16_t* H = (bf16_t*)(ws + WS_H);
  for (int row = blockIdx.x * 8 + wid; row < nrows; row += gridDim.x * 8) {
    const float* src = (layer == 0 && which == 0) ? (row < T_LAT ? p.x + (size_t)row * DM : p.ctx + (size_t)(row - T_LAT) * DM) : X + (size_t)row * DM;
    const float* sh = mods + mod_idx(row) * 12288 + (which ? 3 : 0) * DM; const float* scl = sh + DM;
    float4 v[8]; float ss = 0.f;
    const bool comb = row >= T_LAT && ((layer == 0 && which == 1) || (layer == 1 && which == 0));
    if (comb) { src = which ? p.ctx + (size_t)(row - T_LAT) * DM : X + (size_t)row * DM; }
    const float* gate = (const float*)(ws + WS_MODS) + 2 * 12288 + (which ? 2 : 5) * DM;
    const float* part = (const float*)(ws + WS_PART) + (size_t)(row - T_LAT) * DM;
#pragma unroll
    for (int i = 0; i < 8; ++i) { v[i] = reinterpret_cast<const float4*>(src)[i * 64 + lane];
      if (comb) { const int n4 = i * 64 + lane; const float4 g4 = reinterpret_cast<const float4*>(gate)[n4];
        float4 s4 = reinterpret_cast<const float4*>(part)[n4];
#pragma unroll
        for (int q = 1; q < 4; ++q) { const float4 t4 = reinterpret_cast<const float4*>(part + (size_t)q * 512 * DM)[n4]; s4.x += t4.x; s4.y += t4.y; s4.z += t4.z; s4.w += t4.w; }
        v[i].x += g4.x * s4.x; v[i].y += g4.y * s4.y; v[i].z += g4.z * s4.z; v[i].w += g4.w * s4.w;
        if (which) reinterpret_cast<float4*>((float*)(ws + WS_X) + (size_t)row * DM)[n4] = v[i]; }
      ss += v[i].x * v[i].x + v[i].y * v[i].y + v[i].z * v[i].z + v[i].w * v[i].w; }
    ss = wave_sum(ss);
    float rstd = rsqrtf(ss * (1.f / DM) + EPS);
#pragma unroll
    for (int i = 0; i < 8; ++i) {
      int n = (i * 64 + lane) * 4;
      float4 g = *reinterpret_cast<const float4*>(gain + n), s4 = *reinterpret_cast<const float4*>(scl + n), h4 = *reinterpret_cast<const float4*>(sh + n);
      float y0 = v[i].x * rstd * g.x * (1.f + s4.x) + h4.x, y1 = v[i].y * rstd * g.y * (1.f + s4.y) + h4.y;
      float y2 = v[i].z * rstd * g.z * (1.f + s4.z) + h4.z, y3 = v[i].w * rstd * g.w * (1.f + s4.w) + h4.w;
      u32x2 o = {cvtpk(y0, y1), cvtpk(y2, y3)};
      *reinterpret_cast<u32x2*>(H + (size_t)row * HLD + n) = o;
    }
  }
}

template <int NTW, class Epi>
__device__ __forceinline__ void gemm_tile(const bf16_t* __restrict__ A, int lda, int arow0, int amax,
                                          const bf16_t* __restrict__ Bt, int ldb, int K, char* lds, Epi epi) {
  constexpr int NBL = 2 * NTW;
  constexpr int ABYTES = 256 * 128, BBYTES = 128 * NTW * 128, STAGE = ABYTES + BBYTES;
  const int tid = otid(), lane = tid & 63, wid = tid >> 6, l31 = lane & 31, hi = lane >> 5;
  const int wm = wid >> 2, wn = wid & 3;
  f32x16 acc[4][NTW];
#pragma unroll
  for (int i = 0; i < 4; ++i)
#pragma unroll
    for (int j = 0; j < NTW; ++j)
#pragma unroll
      for (int r = 0; r < 16; ++r) acc[i][j][r] = 0.f;
  const int lc = tid & 7, lr = tid >> 3;
  unsigned aoff[4], boff[NBL];
#pragma unroll
  for (int i = 0; i < 4; ++i) { int gr = arow0 + lr + 64 * i; gr = gr < 0 ? 0 : (gr > amax ? amax : gr); aoff[i] = (unsigned)gr * (unsigned)lda + (unsigned)(lc * 8); }
#pragma unroll
  for (int i = 0; i < NBL; ++i) boff[i] = (unsigned)(lr + 64 * i) * (unsigned)ldb + (unsigned)(lc * 8);
  const int wofs = lr * 128 + ((lc ^ ((lr >> 1) & 7)) << 4);
  u32x4 ra[4], rb[NBL];
  const int nk = K >> 6;
#pragma unroll
  for (int i = 0; i < 4; ++i) ra[i] = *reinterpret_cast<const u32x4*>(A + aoff[i]);
#pragma unroll
  for (int i = 0; i < NBL; ++i) rb[i] = *reinterpret_cast<const u32x4*>(Bt + boff[i]);
  __syncthreads();
#pragma unroll
  for (int i = 0; i < 4; ++i) *reinterpret_cast<u32x4*>(lds + wofs + i * 8192) = ra[i];
#pragma unroll
  for (int i = 0; i < NBL; ++i) *reinterpret_cast<u32x4*>(lds + ABYTES + wofs + i * 8192) = rb[i];
  __syncthreads();
  const int rsw = (l31 >> 1) & 7;
  const int a_base = (wm * 128 + l31) * 128, b_base = ABYTES + (wn * 32 * NTW + l31) * 128;
  for (int kt = 0; kt < nk; ++kt) {
    if (kt + 1 < nk) {
      const int ko = (kt + 1) * 64;
#pragma unroll
      for (int i = 0; i < 4; ++i) ra[i] = *reinterpret_cast<const u32x4*>(A + ko + aoff[i]);
#pragma unroll
      for (int i = 0; i < NBL; ++i) rb[i] = *reinterpret_cast<const u32x4*>(Bt + ko + boff[i]);
    }
    __builtin_amdgcn_sched_barrier(0);
    const char* st = lds + (kt & 1) * STAGE;
    bf16x8 af[4], bfv[2][NTW];
#define CO_(S) ((((S) * 2 + hi) ^ rsw) << 4)
#define LDA_(MT, S) af[MT] = *reinterpret_cast<const bf16x8*>(st + a_base + (MT) * 4096 + CO_(S))
#define LDB_(BUF, S) do { _Pragma("unroll") for (int nt = 0; nt < NTW; ++nt) bfv[BUF][nt] = *reinterpret_cast<const bf16x8*>(st + b_base + nt * 4096 + CO_(S)); } while (0)
    LDB_(0, 0);
#pragma unroll
    for (int mt = 0; mt < 4; ++mt) LDA_(mt, 0);
#pragma unroll
    for (int s = 0; s < 4; ++s) {
      if (s < 3) LDB_((s + 1) & 1, s + 1);
#pragma unroll
      for (int mt = 0; mt < 4; ++mt) {
        __builtin_amdgcn_sched_barrier(0);
#pragma unroll
        for (int nt = 0; nt < NTW; ++nt) acc[mt][nt] = mfma32(af[mt], bfv[s & 1][nt], acc[mt][nt]);
        if (s < 3) LDA_(mt, s + 1);
      }
      __builtin_amdgcn_sched_barrier(0);
    }
#undef CO_
#undef LDA_
#undef LDB_
    if (kt + 1 < nk) {
      char* sw = lds + ((kt + 1) & 1) * STAGE;
#pragma unroll
      for (int i = 0; i < 4; ++i) *reinterpret_cast<u32x4*>(sw + wofs + i * 8192) = ra[i];
#pragma unroll
      for (int i = 0; i < NBL; ++i) *reinterpret_cast<u32x4*>(sw + ABYTES + wofs + i * 8192) = rb[i];
    }
    __syncthreads();
  }
  epi(acc, wm, wn, l31, hi);
}


__device__ __forceinline__ int block_L(int r) { const int G = gridDim.x, slots = G >> 3, b = blockIdx.x; return (r * 8 + (b & 7)) * slots + (b >> 3); }
__device__ __forceinline__ void grouped_mn(int L, int MT, int NT, int& mt, int& nt) {
  const int pg_ = 4 * NT; const int g = L / pg_, rem = L - g * pg_; const int gsz = (MT - 4 * g) < 4 ? (MT - 4 * g) : 4;
  nt = rem / gsz; mt = 4 * g + rem - nt * gsz;
}
__device__ __forceinline__ bool tile_of(int r, int MT, int NT, int& mt, int& nt) {
  const int G = gridDim.x, slots = G >> 3, b = blockIdx.x, x = b & 7, s = b >> 3;
  const int total = MT * NT, per = (total + 7) >> 3;
  const int start = x * per; int cnt = total - start; cnt = cnt > per ? per : cnt;
  const int idx = r * slots + s; if (idx >= cnt) return false;
  grouped_mn(start + idx, MT, NT, mt, nt); return true;
}

namespace pg {
using f32x4 = __attribute__((ext_vector_type(4))) float;
constexpr int HTB = 128 * 64 * 2;
__device__ __forceinline__ int lds_byte(int r, int c) { const int st = (r >> 4) * 2 + (c >> 5), rr = r & 15, cc = c & 31, ob = rr * 64 + cc * 2; return st * 1024 + (ob ^ (((ob >> 9) & 1) << 5)); }
__device__ __forceinline__ void stage_rc(int b, int& R, int& C) { const int st = b / 1024, sb = b % 1024, swz = sb ^ (((sb >> 9) & 1) << 5); R = (st >> 1) * 16 + swz / 64; C = (st & 1) * 32 + (swz % 64) / 2; }
__device__ __forceinline__ int perm32(int rho) { const int n = rho >> 4, i = rho & 15; return 8 * (i >> 2) + 4 * n + (i & 3); }
struct Unit { const char* a; const char* b; int nt, m0, n0, tag; };

template <bool PERM, class Sched, class Epi>
__device__ __forceinline__ void gemm_phase(LAS unsigned char* lds, int lda, int ldb, const Sched& S, const Epi& E) {
    const int tid = otid(), wid = __builtin_amdgcn_readfirstlane(tid >> 6), lane = tid & 63, wr = wid >> 2, wc = wid & 3, fr = lane & 15, fq = lane >> 4;
    unsigned voffA[2], voffB[2];
#pragma unroll
    for (int i = 0; i < 2; ++i) { int R, C; stage_rc(tid * 16 + i * 8192, R, C); const int Rb = PERM ? ((R & ~31) + perm32(R & 31)) : R;
        voffA[i] = (unsigned)(R * lda + C) * 2u; voffB[i] = (unsigned)(Rb * ldb + C) * 2u; }
    const size_t kstep = 128;
    const size_t hstepA = (size_t)128 * lda * 2, hstepB = (size_t)128 * ldb * 2;
    const unsigned ldsw = (unsigned)wid * 1024u;
    const int aoff = lds_byte(wr * 64 + fr, fq * 8), boff = lds_byte(wc * 32 + fr, fq * 8);
#define PG8_SA(b, h) (((b) * 2 + (h)) * HTB)
#define PG8_SB(b, h) ((4 + (b) * 2 + (h)) * HTB)
#define PG8_STAGE(bufoff, gbase, voff) do { _Pragma("unroll") for (int _i = 0; _i < 2; ++_i) \
        __builtin_amdgcn_global_load_lds((const unsigned*)((const char*)(gbase) + (voff)[_i]), (LAS unsigned*)(lds + (bufoff) + ldsw + _i * 8192), 16, 0, 0); } while (0)
#define PG8_LDA(dst, b, h) do { _Pragma("unroll") for (int m = 0; m < 4; ++m) _Pragma("unroll") for (int k = 0; k < 2; ++k) dst[m][k] = *(const LAS bf16x8*)(lds + PG8_SA(b, h) + aoff + m * 2048 + k * 1024); } while (0)
#define PG8_LDB(dst, b, h) do { _Pragma("unroll") for (int n = 0; n < 2; ++n) _Pragma("unroll") for (int k = 0; k < 2; ++k) dst[n][k] = *(const LAS bf16x8*)(lds + PG8_SB(b, h) + boff + n * 2048 + k * 1024); } while (0)
#define PG8_MMA(ai, bj, At, Bt) do { __builtin_amdgcn_s_setprio(1); _Pragma("unroll") for (int m = 0; m < 4; ++m) _Pragma("unroll") for (int n = 0; n < 2; ++n) _Pragma("unroll") for (int k = 0; k < 2; ++k) \
        acc[ai][bj][m][n] = __builtin_amdgcn_mfma_f32_16x16x32_bf16(Bt[n][k], At[m][k], acc[ai][bj][m][n], 0, 0, 0); __builtin_amdgcn_s_setprio(0); } while (0)
#define PG8_WAIT_V(n) asm volatile("s_waitcnt vmcnt(" #n ")" ::: "memory")
#define PG8_WAIT_L(n) asm volatile("s_waitcnt lgkmcnt(" #n ")" ::: "memory")
#define PG8_BAR __builtin_amdgcn_s_barrier()
#define PG8_SCHED __builtin_amdgcn_sched_barrier(0)
    Unit cur, nxt; int ui = 0;
    if (!S.next(0, cur)) return;
    f32x4 acc[2][2][4][2];
#pragma unroll
    for (int a = 0; a < 2; ++a)
#pragma unroll
        for (int b = 0; b < 2; ++b)
#pragma unroll
            for (int m = 0; m < 4; ++m)
#pragma unroll
                for (int n = 0; n < 2; ++n) acc[a][b][m][n] = (f32x4){0.f, 0.f, 0.f, 0.f};
    bf16x8 At[4][2], B0[2][2], B1[2][2];
    const char* cA = cur.a; const char* cB = cur.b;
    PG8_STAGE(PG8_SB(0, 0), cB, voffB); PG8_STAGE(PG8_SA(0, 0), cA, voffA); PG8_STAGE(PG8_SB(0, 1), cB + hstepB, voffB); PG8_STAGE(PG8_SA(0, 1), cA + hstepA, voffA);
    if (wr == 1) PG8_BAR;
    PG8_WAIT_V(4); PG8_BAR;
    PG8_STAGE(PG8_SB(1, 0), cB + kstep, voffB); PG8_STAGE(PG8_SA(1, 0), cA + kstep, voffA); PG8_STAGE(PG8_SB(1, 1), cB + hstepB + kstep, voffB);
    PG8_WAIT_V(6); PG8_BAR;
    for (;;) {
        const bool has_next = S.next(ui + 1, nxt);
        const char* nA = has_next ? nxt.a : cA; const char* nB = has_next ? nxt.b : cB;
        const int nt = cur.nt;
        for (int t = 0; t < nt; t += 2) {
            const bool last = (t == nt - 2);
            const char* a1 = cA + (size_t)(t + 1) * kstep;
            const char* a2 = last ? nA : cA + (size_t)(t + 2) * kstep; const char* b2 = last ? nB : cB + (size_t)(t + 2) * kstep;
            const char* a3 = a2 + kstep; const char* b3 = b2 + kstep;
            PG8_LDB(B0, 0, 0); PG8_SCHED; PG8_LDA(At, 0, 0); PG8_STAGE(PG8_SA(1, 1), a1 + hstepA, voffA);
            PG8_WAIT_L(8); PG8_BAR; PG8_WAIT_L(0); PG8_MMA(0, 0, At, B0); PG8_BAR; PG8_SCHED;
            PG8_LDB(B1, 0, 1); PG8_STAGE(PG8_SB(0, 0), b2, voffB);
            PG8_BAR; PG8_WAIT_L(0); PG8_MMA(0, 1, At, B1); PG8_BAR;
            PG8_LDA(At, 0, 1); PG8_STAGE(PG8_SA(0, 0), a2, voffA);
            PG8_BAR; PG8_WAIT_L(0); PG8_MMA(1, 0, At, B0); PG8_BAR; PG8_SCHED;
            PG8_STAGE(PG8_SB(0, 1), b2 + hstepB, voffB);
            PG8_WAIT_V(6); PG8_BAR; PG8_MMA(1, 1, At, B1); PG8_BAR;
            PG8_LDB(B0, 1, 0); PG8_SCHED; PG8_LDA(At, 1, 0); PG8_STAGE(PG8_SA(0, 1), a2 + hstepA, voffA);
            PG8_WAIT_L(8); PG8_BAR; PG8_WAIT_L(0); PG8_MMA(0, 0, At, B0); PG8_BAR; PG8_SCHED;
            PG8_LDB(B1, 1, 1); PG8_STAGE(PG8_SB(1, 0), b3, voffB);
            PG8_BAR; PG8_WAIT_L(0); PG8_MMA(0, 1, At, B1); PG8_BAR;
            PG8_LDA(At, 1, 1); PG8_STAGE(PG8_SA(1, 0), a3, voffA);
            PG8_BAR; PG8_WAIT_L(0); PG8_MMA(1, 0, At, B0); PG8_BAR; PG8_SCHED;
            PG8_STAGE(PG8_SB(1, 1), b3 + hstepB, voffB);
            PG8_WAIT_V(6); PG8_BAR; PG8_MMA(1, 1, At, B1); PG8_BAR;
        }
        E(acc, cur, wr, wc, fr, fq);
        if (!has_next) break;
#pragma unroll
        for (int a = 0; a < 2; ++a)
#pragma unroll
            for (int b = 0; b < 2; ++b)
#pragma unroll
                for (int m = 0; m < 4; ++m)
#pragma unroll
                    for (int n = 0; n < 2; ++n) acc[a][b][m][n] = (f32x4){0.f, 0.f, 0.f, 0.f};
        cur = nxt; cA = nA; cB = nB; ++ui;
    }
    PG8_WAIT_V(0);
    if (wr == 0) PG8_BAR;
    PG8_BAR;
#undef PG8_SA
#undef PG8_SB
#undef PG8_STAGE
#undef PG8_LDA
#undef PG8_LDB
#undef PG8_MMA
#undef PG8_WAIT_V
#undef PG8_WAIT_L
#undef PG8_BAR
#undef PG8_SCHED
}
}


struct SchedMN {
  const char* A; const char* B; int lda, ldb, MT, NT, nt;
  __device__ __forceinline__ bool next(int i, pg::Unit& u) const {
    int mt, ntl; if (!tile_of(i, MT, NT, mt, ntl)) return false;
    u.m0 = mt * 256; u.n0 = ntl * 256; u.a = A + (size_t)u.m0 * lda * 2; u.b = B + (size_t)u.n0 * ldb * 2; u.nt = nt; u.tag = 0; return true; }
};
struct SchedRes {
  const char* A; const char* B; int lda, ldb, ntk, nctx;
  __device__ __forceinline__ bool next(int i, pg::Unit& u) const {
    const int L = block_L(i);
    if (L < 512) { int mt, ntl; grouped_mn(L, 64, 8, mt, ntl); u.m0 = mt * 256; u.n0 = ntl * 256; u.a = A + (size_t)u.m0 * lda * 2; u.b = B + (size_t)u.n0 * ldb * 2; u.nt = ntk; u.tag = 0; return true; }
    const int s = L - 512; if (s >= nctx * 4) return false;
    const int cu = s >> 2, ks = s & 3, kt = ntk >> 2;
    u.m0 = (64 + (cu >> 3)) * 256; u.n0 = (cu & 7) * 256; u.nt = kt; u.tag = 1 + ks;
    u.a = A + ((size_t)u.m0 * lda + (size_t)ks * kt * 64) * 2; u.b = B + ((size_t)u.n0 * ldb + (size_t)ks * kt * 64) * 2; return true; }
};
struct SchedQKV {
  const char* P; const char* Wq; const char* Wkv; int MT;
  __device__ __forceinline__ bool next(int i, pg::Unit& u) const {
    int mt, ntv; if (!tile_of(i, MT, 14, mt, ntv)) return false;
    const bool isq = ntv < 6; const int ntl = isq ? ntv : ntv - 6;
    u.m0 = mt * 256; u.n0 = ntl * 256; u.tag = isq ? 0 : 1; u.nt = isq ? 12 : 8;
    u.a = P + ((size_t)u.m0 * PLD + (isq ? 0 : OFF_CKV)) * 2; u.b = (isq ? Wq : Wkv) + (size_t)u.n0 * 768 * 2; return true; }
};

__device__ __forceinline__ void phase_gemm_in(const Params& p, char* lds) {
  char* ws = p.ws;
  bf16_t* P = (bf16_t*)(ws + WS_P); float* DT = (float*)(ws + WS_DT);
  SchedMN S{ws + WS_H, ws + WS_WIN, HLD, WLD, T_ALL / 256, PNP / 256, DM / 64};
  auto epi = [=](const pg::f32x4 (&acc)[2][2][4][2], const pg::Unit& u, int wr, int wc, int fr, int fq) {
    const int row0 = u.m0 + wr * 64 + fr;
#pragma unroll
    for (int ai = 0; ai < 2; ++ai)
#pragma unroll
      for (int m = 0; m < 4; ++m) { const int row = row0 + ai * 128 + m * 16;
#pragma unroll
        for (int bj = 0; bj < 2; ++bj) { const int c = u.n0 + bj * 128 + wc * 32 + 8 * fq;
          const pg::f32x4 v0 = acc[ai][bj][m][0], v1 = acc[ai][bj][m][1];
          if (c < PLD) { u32x4 w = {cvtpk(v0[0], v0[1]), cvtpk(v0[2], v0[3]), cvtpk(v1[0], v1[1]), cvtpk(v1[2], v1[3])}; *reinterpret_cast<u32x4*>(P + (size_t)row * PLD + c) = w; }
          if (c >= OFF_DT && c < PIN) { *reinterpret_cast<pg::f32x4*>(DT + (size_t)row * 16 + (c - OFF_DT)) = v0; *reinterpret_cast<pg::f32x4*>(DT + (size_t)row * 16 + (c - OFF_DT) + 4) = v1; } } }
  };
  pg::gemm_phase<true>((LAS unsigned char*)lds, HLD, WLD, S, epi);
}

__device__ __forceinline__ void phase_qkv_gemm_and_post(const Params& p, int layer, char* lds) {
  char* ws = p.ws;
  const bf16_t* P = (const bf16_t*)(ws + WS_P);
  { SchedQKV S{ws + WS_P, ws + WS_WUQ, ws + WS_WUKV, T_ALL / 256};
    bf16_t* dq = (bf16_t*)(ws + WS_QRAW); bf16_t* dkv = (bf16_t*)(ws + WS_KVRAW);
    auto epi = [=](const pg::f32x4 (&acc)[2][2][4][2], const pg::Unit& u, int wr, int wc, int fr, int fq) {
      bf16_t* dst = u.tag ? dkv : dq; const int ldd = u.tag ? 2048 : 1536;
      const int row0 = u.m0 + wr * 64 + fr;
#pragma unroll
      for (int ai = 0; ai < 2; ++ai)
#pragma unroll
        for (int m = 0; m < 4; ++m) { const int row = row0 + ai * 128 + m * 16;
#pragma unroll
          for (int bj = 0; bj < 2; ++bj) { const int c = u.n0 + bj * 128 + wc * 32 + 8 * fq;
            const pg::f32x4 v0 = acc[ai][bj][m][0], v1 = acc[ai][bj][m][1];
            u32x4 w = {cvtpk(v0[0], v0[1]), cvtpk(v0[2], v0[3]), cvtpk(v1[0], v1[1]), cvtpk(v1[2], v1[3])};
            *reinterpret_cast<u32x4*>(dst + (size_t)row * ldd + c) = w; } }
    };
    pg::gemm_phase<true>((LAS unsigned char*)lds, PLD, 768, S, epi); }
  const int tid = otid(), lane = tid & 63, wid = tid >> 6;
  float* RSTD = (float*)(ws + WS_RSTD); float* DT = (float*)(ws + WS_DT); bf16_t* XBC = (bf16_t*)(ws + WS_XBC);
  const float* cw = p.ssd_conv_w + (size_t)layer * 3 * 1024; const float* cb = p.ssd_conv_b + layer * 1024;
  for (int t = blockIdx.x * 8 + wid; t < T_ALL; t += gridDim.x * 8) {
    const bf16_t* pr = P + (size_t)t * PLD;
    float sq = 0.f, skv = 0.f; float f[8];
    for (int c = lane; c < 96; c += 64) { unpack8(*reinterpret_cast<const u32x4*>(pr + c * 8), f);
#pragma unroll
      for (int e = 0; e < 8; ++e) sq += f[e] * f[e]; }
    { unpack8(*reinterpret_cast<const u32x4*>(pr + OFF_CKV + lane * 8), f);
#pragma unroll
      for (int e = 0; e < 8; ++e) skv += f[e] * f[e]; }
    sq = wave_sum(sq); skv = wave_sum(skv);
    if (lane == 0) { RSTD[t * 2] = rsqrtf(sq * (1.f / 768.f) + EPS); RSTD[t * 2 + 1] = rsqrtf(skv * (1.f / 512.f) + EPS); }
    if (lane < 16) { float v = DT[(size_t)t * 16 + lane] + p.ssd_dt_bias[layer * 16 + lane]; DT[(size_t)t * 16 + lane] = v > 20.f ? v : log1pf(__expf(v)); }
    const bool s0 = seq_start(t), s1 = seq_end(t);
#pragma unroll
    for (int cc = 0; cc < 2; ++cc) {
      const int c0 = (cc * 64 + lane) * 8;
      float fm[8], fc[8], fp[8];
      unpack8(*reinterpret_cast<const u32x4*>(pr + OFF_XBC + c0), fc);
      if (!s0) unpack8(*reinterpret_cast<const u32x4*>(pr - PLD + OFF_XBC + c0), fm);
      if (!s1) unpack8(*reinterpret_cast<const u32x4*>(pr + PLD + OFF_XBC + c0), fp);
      float o[8];
#pragma unroll
      for (int e = 0; e < 8; ++e) {
        float a = cb[c0 + e] + cw[1024 + c0 + e] * fc[e];
        if (!s0) a += cw[c0 + e] * fm[e];
        if (!s1) a += cw[2048 + c0 + e] * fp[e];
        o[e] = silu_f(a);
      }
      *reinterpret_cast<u32x4*>(XBC + (size_t)t * 1024 + c0) = pack8(o);
    }
  }
}

__device__ __forceinline__ void phase_build_qkv(const Params& p, int layer) {
  char* ws = p.ws;
  const int tid = otid(), lane = tid & 63, wid = tid >> 6;
  const bf16_t* P = (const bf16_t*)(ws + WS_P); const bf16_t* QR = (const bf16_t*)(ws + WS_QRAW); const bf16_t* KVR = (const bf16_t*)(ws + WS_KVRAW);
  const float* RSTD = (const float*)(ws + WS_RSTD); const float* rope = (const float*)(ws + WS_ROPE);
  bf16_t* Q = (bf16_t*)(ws + WS_Q); bf16_t* QC = (bf16_t*)(ws + WS_QC); bf16_t* Kb = (bf16_t*)(ws + WS_K); bf16_t* Vb = (bf16_t*)(ws + WS_V);
  const float* qn = p.q_norm + layer * 192; const float* kn = p.k_norm + layer * 192;
  const float qg0 = qn[lane], qg1 = qn[64 + lane], qg2 = qn[128 + lane];
  const float kg0 = kn[lane], kg1 = kn[64 + lane], kg2 = kn[128 + lane];
  const int ax = lane >> 5, jj = lane & 15, second = (lane >> 4) & 1;
  for (int t = blockIdx.x * 8 + wid; t < T_ALL; t += gridDim.x * 8) {
    const bool lat = t < T_LAT;
    const int b = lat ? (t >> 13) : ((t - T_LAT) >> 8);
    const int pos = lat ? (t & (SEQ - 1)) : ((t - T_LAT) & (CTXL - 1));
    const int kpos = lat ? (CTXL + pos) : pos;
    const float rq = RSTD[t * 2], rkv = RSTD[t * 2 + 1];
    float cs = 1.f, sn = 0.f;
    if (lat) { const int pa = ax ? (pos & 63) : (pos >> 6); cs = rope[(pa * 16 + jj) * 2]; sn = rope[(pa * 16 + jj) * 2 + 1]; }
    const float krv = bf2f(P[(size_t)t * PLD + OFF_KR + lane]);
    bf16_t qraw[8][3], kraw[8][4];
#pragma unroll
    for (int h = 0; h < 8; ++h) { const bf16_t* qs = QR + (size_t)t * 1536 + h * 192; const bf16_t* ks = KVR + (size_t)t * 2048 + h * 256;
      qraw[h][0] = qs[lane]; qraw[h][1] = qs[64 + lane]; qraw[h][2] = qs[128 + lane];
      kraw[h][0] = ks[lane]; kraw[h][1] = ks[64 + lane]; kraw[h][2] = ks[128 + lane]; kraw[h][3] = ks[192 + lane]; }
#pragma unroll
    for (int h = 0; h < 8; ++h) {
      float v0 = bf2f(qraw[h][0]) * rq, v1 = bf2f(qraw[h][1]) * rq, v2 = bf2f(qraw[h][2]) * rq;
      float ss = wave_sum(v0 * v0 + v1 * v1 + v2 * v2);
      float r = rsqrtf(ss * (1.f / 192.f) + EPS);
      v0 *= r * qg0; v1 *= r * qg1; v2 *= r * qg2;
      if (lat) { float pr = lane_xor16(v2, lane); v2 = second ? (v2 * cs + pr * sn) : (v2 * cs - pr * sn); }
      bf16_t* qd = lat ? Q + ((size_t)(b * 8 + h) * SEQ + pos) * 192 : QC + ((size_t)(b * 8 + h) * CTXL + pos) * 192;
      qd[lane] = f2bf(v0 * QSCALE); qd[64 + lane] = f2bf(v1 * QSCALE); qd[128 + lane] = f2bf(v2 * QSCALE);
      float k0 = bf2f(kraw[h][0]) * rkv, k1 = bf2f(kraw[h][1]) * rkv, k2 = krv;
      float vv0 = bf2f(kraw[h][2]) * rkv, vv1 = bf2f(kraw[h][3]) * rkv;
      float ks2 = wave_sum(k0 * k0 + k1 * k1 + k2 * k2);
      float rk = rsqrtf(ks2 * (1.f / 192.f) + EPS);
      k0 *= rk * kg0; k1 *= rk * kg1; k2 *= rk * kg2;
      if (lat) { float pr = lane_xor16(k2, lane); k2 = second ? (k2 * cs + pr * sn) : (k2 * cs - pr * sn); }
      bf16_t* kd = Kb + ((size_t)(b * 8 + h) * NKEYS + kpos) * 192;
      kd[lane] = f2bf(k0); kd[64 + lane] = f2bf(k1); kd[128 + lane] = f2bf(k2);
      bf16_t* vd = Vb + ((size_t)(b * 8 + h) * NKEYS + kpos) * 128;
      vd[lane] = f2bf(vv0); vd[64 + lane] = f2bf(vv1);
    }
  }
}

#define KSWZ(row, colB) ((row) * 384 + ((colB) ^ ((((row) >> 1) & 7) << 4)))
__device__ __forceinline__ int v_st(int k, int c) { const int kk = (k & ~0xC) | ((k & 4) << 1) | ((k & 8) >> 1); return ((kk >> 3) * 4 + (c >> 5)) * 512 + ((kk & 7) * 32 + (c & 31)) * 2; }
__device__ __forceinline__ int v_rd_base(int lane) { return ((lane & 3) << 3) | (((lane >> 2) & 3) << 6) | (((lane >> 4) & 1) << 5) | (((lane >> 5) & 1) << 8); }
constexpr int v_rd_off(int d0, int ks, int half) { return d0 * 512 + ks * 4096 + half * 2048; }
template <int OFF> __device__ __forceinline__ s16x4 tr_read(int vb) {
  s16x4 r; asm volatile("ds_read_b64_tr_b16 %0, %1 offset:%2" : "=&v"(r) : "v"(vb), "i"(OFF) : "memory"); return r;
}
struct VFrag { s16x4 l0, h0, l1, h1, l2, h2, l3, h3; };
template <int D0> __device__ __forceinline__ void pv_read(VFrag& f, int vb) {
  f.l0 = tr_read<v_rd_off(D0, 0, 0)>(vb); f.h0 = tr_read<v_rd_off(D0, 0, 1)>(vb); f.l1 = tr_read<v_rd_off(D0, 1, 0)>(vb); f.h1 = tr_read<v_rd_off(D0, 1, 1)>(vb);
  f.l2 = tr_read<v_rd_off(D0, 2, 0)>(vb); f.h2 = tr_read<v_rd_off(D0, 2, 1)>(vb); f.l3 = tr_read<v_rd_off(D0, 3, 0)>(vb); f.h3 = tr_read<v_rd_off(D0, 3, 1)>(vb);
}
__device__ __forceinline__ void pv_mma(f32x16& od, const VFrag& f, bf16x8 pa0, bf16x8 pa1, bf16x8 pa2, bf16x8 pa3) {
#define PK(L, H) (bf16x8){L[0], L[1], L[2], L[3], H[0], H[1], H[2], H[3]}
  od = mfma32(pa0, PK(f.l0, f.h0), od); od = mfma32(pa1, PK(f.l1, f.h1), od); od = mfma32(pa2, PK(f.l2, f.h2), od); od = mfma32(pa3, PK(f.l3, f.h3), od);
#undef PK
}
__device__ __forceinline__ void pv_all(f32x16* o, int vb, bf16x8 pa0, bf16x8 pa1, bf16x8 pa2, bf16x8 pa3) {
  VFrag fa, fb;
  pv_read<0>(fa, vb); pv_read<1>(fb, vb);
  asm volatile("s_waitcnt lgkmcnt(8)" : "+v"(fa.l0), "+v"(fa.h0), "+v"(fa.l1), "+v"(fa.h1), "+v"(fa.l2), "+v"(fa.h2), "+v"(fa.l3), "+v"(fa.h3) :: "memory"); __builtin_amdgcn_sched_barrier(0);
  pv_mma(o[0], fa, pa0, pa1, pa2, pa3); __builtin_amdgcn_sched_barrier(0);
  pv_read<2>(fa, vb);
  asm volatile("s_waitcnt lgkmcnt(8)" : "+v"(fb.l0), "+v"(fb.h0), "+v"(fb.l1), "+v"(fb.h1), "+v"(fb.l2), "+v"(fb.h2), "+v"(fb.l3), "+v"(fb.h3) :: "memory"); __builtin_amdgcn_sched_barrier(0);
  pv_mma(o[1], fb, pa0, pa1, pa2, pa3); __builtin_amdgcn_sched_barrier(0);
  pv_read<3>(fb, vb);
  asm volatile("s_waitcnt lgkmcnt(8)" : "+v"(fa.l0), "+v"(fa.h0), "+v"(fa.l1), "+v"(fa.h1), "+v"(fa.l2), "+v"(fa.h2), "+v"(fa.l3), "+v"(fa.h3) :: "memory"); __builtin_amdgcn_sched_barrier(0);
  pv_mma(o[2], fa, pa0, pa1, pa2, pa3); __builtin_amdgcn_sched_barrier(0);
  asm volatile("s_waitcnt lgkmcnt(0)" : "+v"(fb.l0), "+v"(fb.h0), "+v"(fb.l1), "+v"(fb.h1), "+v"(fb.l2), "+v"(fb.h2), "+v"(fb.l3), "+v"(fb.h3) :: "memory"); __builtin_amdgcn_sched_barrier(0);
  pv_mma(o[3], fb, pa0, pa1, pa2, pa3);
}

constexpr int ATT_V = 0, ATT_K = 32768, ATT_WS = 32768 + 49152;
__device__ __forceinline__ void attn_item(const bf16_t* __restrict__ Qb, const bf16_t* __restrict__ Kh, const bf16_t* __restrict__ Vh, int nkeys,
                          bf16_t* __restrict__ Ob, float* __restrict__ ml, char* lds) {
  constexpr float THR = 8.f;
  const int tid = otid(), wid = tid >> 6, lane = tid & 63, r32 = lane & 31, hi = lane >> 5;
  char* V_lds = lds + ATT_V; char* K_lds = lds + ATT_K;
  float* wsf = (float*)(lds + ATT_WS) + wid * 64; float* li_l = wsf; float* al_l = wsf + 32;
  float m_reg = 0.f, l_reg = 0.f;
  f32x16 o[4];
#pragma unroll
  for (int d = 0; d < 4; ++d)
#pragma unroll
    for (int r = 0; r < 16; ++r) o[d][r] = 0.f;
  bf16x8 qr[12];
  const bf16_t* Qw = Qb + (size_t)(wid * 32 + r32) * 192 + hi * 8;
#pragma unroll
  for (int d0 = 0; d0 < 12; ++d0) qr[d0] = *reinterpret_cast<const bf16x8*>(Qw + d0 * 16);
  const int sr = tid >> 4, sc = (tid & 15) * 8, vst0 = v_st(sr, sc), vst1 = v_st(32 + sr, sc);
  const int vb0 = (int)(uintptr_t)V_lds + v_rd_base(lane);
#define krow(i) ((tid + (i) * NTHR) / 24)
#define kch(i) ((tid + (i) * NTHR) % 24)
  int klow[4];
#pragma unroll
  for (int q = 0; q < 4; ++q) klow[q] = r32 * 384 + ((q * 32 + hi * 16) ^ (((r32 >> 1) & 7) << 4));
  const int wu = __builtin_amdgcn_readfirstlane(wid);
  unsigned koff[3], voff[2];
#pragma unroll
  for (int i = 0; i < 3; ++i) { const int ofs = (i * 8 + wid) * 1024 + lane * 16; const int row = ofs / 384, cpos = (ofs - row * 384) >> 4;
    const int c = (cpos & ~7) | ((cpos ^ (row >> 1)) & 7); koff[i] = (unsigned)(row * 192 + c * 8); }
#pragma unroll
  for (int i = 0; i < 2; ++i) { const int ofs = (i * 8 + wid) * 1024 + lane * 16; const int st = ofs >> 9, wv = ofs & 511;
    const int kk = (st >> 2) * 8 + (wv >> 6), c = (st & 3) * 32 + ((wv & 63) >> 1); const int k = (kk & ~0xC) | ((kk & 4) << 1) | ((kk & 8) >> 1);
    voff[i] = (unsigned)(k * 128 + c); }
#define SDMA(k0, b) do { const bf16_t* Vt = Vh + (size_t)(k0) * 128; const bf16_t* Kt = Kh + (size_t)(k0) * 192; \
    _Pragma("unroll") for (int i = 0; i < 2; ++i) __builtin_amdgcn_global_load_lds((const unsigned*)(Vt + voff[i]), (LAS unsigned*)(V_lds + (b) * 16384 + (i * 8 + wu) * 1024), 16, 0, 0); \
    _Pragma("unroll") for (int i = 0; i < 3; ++i) __builtin_amdgcn_global_load_lds((const unsigned*)(Kt + koff[i]), (LAS unsigned*)(K_lds + (b) * 24576 + (i * 8 + wu) * 1024), 16, 0, 0); } while (0)
#define SLOAD(k0) do { } while (0)
#define SWRITE(b) do { } while (0)
  const int NT = nkeys >> 6;
  __syncthreads();
  SDMA(0, 0); asm volatile("s_waitcnt vmcnt(0)" ::: "memory"); __syncthreads();
  for (int j = 0; j < NT; ++j) {
    if (j + 1 < NT) SDMA((j + 1) * 64, (j + 1) & 1);
    __builtin_amdgcn_sched_barrier(0);
    const char* Ks = K_lds + (j & 1) * 24576;
    f32x16 p0, p1;
#pragma unroll
    for (int r = 0; r < 16; ++r) { p0[r] = -m_reg; p1[r] = -m_reg; }
    bf16x8 kb0[3], kb1[3];
#define LDK_(D, SL) do { const char* kp_ = Ks + klow[(D) & 3] + ((D) >> 2) * 128; kb0[SL] = *reinterpret_cast<const bf16x8*>(kp_); kb1[SL] = *reinterpret_cast<const bf16x8*>(kp_ + 32 * 384); } while (0)
    LDK_(0, 0); LDK_(1, 1);
#pragma unroll
    for (int d0 = 0; d0 < 12; ++d0) {
      if (d0 + 2 < 12) LDK_(d0 + 2, (d0 + 2) % 3);
      __builtin_amdgcn_sched_barrier(0);
      p0 = mfma32(kb0[d0 % 3], qr[d0], p0); p1 = mfma32(kb1[d0 % 3], qr[d0], p1);
      __builtin_amdgcn_sched_barrier(0);
    }
#undef LDK_
    float pmax = p0[0];
#pragma unroll
    for (int r = 1; r < 16; ++r) pmax = fmaxf(pmax, p0[r]);
#pragma unroll
    for (int r = 0; r < 16; ++r) pmax = fmaxf(pmax, p1[r]);
    { auto rr = __builtin_amdgcn_permlane32_swap(__float_as_uint(pmax), __float_as_uint(pmax), false, false);
      pmax = fmaxf(__uint_as_float(rr[0]), __uint_as_float(rr[1])); }
    float alpha = 1.f;
    if (!__all(pmax <= THR)) {
      const float delta = fmaxf(pmax, 0.f); alpha = __builtin_amdgcn_exp2f(-delta); m_reg += delta;
#pragma unroll
      for (int r = 0; r < 16; ++r) { p0[r] -= delta; p1[r] -= delta; }
    }
    float ps = 0.f;
#pragma unroll
    for (int r = 0; r < 16; ++r) { p0[r] = __builtin_amdgcn_exp2f(p0[r]); ps += p0[r]; }
#pragma unroll
    for (int r = 0; r < 16; ++r) { p1[r] = __builtin_amdgcn_exp2f(p1[r]); ps += p1[r]; }
    { auto rr = __builtin_amdgcn_permlane32_swap(__float_as_uint(ps), __float_as_uint(ps), false, false);
      ps = __uint_as_float(rr[0]) + __uint_as_float(rr[1]); }
    l_reg = l_reg * alpha + ps;
    bf16x8 pa0, pa1, pa2, pa3;
#define PK4(P, BASE, OUT) do { unsigned a0 = cvtpk(P[BASE + 0], P[BASE + 1]), a1 = cvtpk(P[BASE + 2], P[BASE + 3]);   \
    unsigned b0_ = cvtpk(P[BASE + 4], P[BASE + 5]), b1_ = cvtpk(P[BASE + 6], P[BASE + 7]);                              \
    auto r0 = __builtin_amdgcn_permlane32_swap(a0, b0_, false, false); auto r1 = __builtin_amdgcn_permlane32_swap(a1, b1_, false, false); \
    u32x4 w = {r0[0], r1[0], r0[1], r1[1]}; OUT = *reinterpret_cast<bf16x8*>(&w); } while (0)
    PK4(p0, 0, pa0); PK4(p0, 8, pa1); PK4(p1, 0, pa2); PK4(p1, 8, pa3);
#undef PK4
    if (__any(alpha < 1.f)) {
      if (hi == 0) al_l[r32] = alpha;
      asm volatile("s_waitcnt lgkmcnt(0)" ::: "memory");
#pragma unroll
      for (int r = 0; r < 16; ++r) { const float a = al_l[crow(r, hi)];
#pragma unroll
        for (int d = 0; d < 4; ++d) o[d][r] *= a; }
    }
    const int vb = vb0 + (j & 1) * 16384;
    pv_all(o, vb, pa0, pa1, pa2, pa3);
    asm volatile("s_waitcnt vmcnt(0)" ::: "memory");
    __syncthreads();
  }
#undef SDMA
#undef SLOAD
#undef SWRITE
#undef krow
#undef kch
  if (hi == 0) { li_l[r32] = l_reg; float* mp = ml + (size_t)(wid * 32 + r32) * 16; mp[0] = m_reg; mp[1] = l_reg; }
  asm volatile("s_waitcnt lgkmcnt(0)" ::: "memory");
  bf16_t* Ow = Ob + (size_t)(wid * 32) * 1024;
#pragma unroll
  for (int r = 0; r < 16; ++r) {
    const int orow = crow(r, hi); const float rl = 1.f / li_l[orow];
#pragma unroll
    for (int d0 = 0; d0 < 4; ++d0) Ow[(size_t)orow * 1024 + d0 * 32 + r32] = f2bf(o[d0][r] * rl);
  }
}

constexpr int SS_CM = 0, SS_BM = 34816, SS_BW = 69632, SS_XV = 102400, SS_SB = 118784, SS_ACS = 136192, SS_DT = 136704, SS_RAW = 137216;
__device__ __forceinline__ int v_st2(int k, int c) { const int kk = (k & ~0xC) | ((k & 4) << 1) | ((k & 8) >> 1); return ((kk >> 3) * 2 + (c >> 5)) * 512 + ((kk & 7) * 32 + (c & 31)) * 2; }
__device__ __forceinline__ void ssd_item(const Params& p, int layer, int item, char* lds) {
  char* ws = p.ws;
  const int tid = otid(), wid = tid >> 6, lane = tid & 63, l31 = lane & 31, hi = lane >> 5;
  const int b = item >> 4, dir = (item >> 3) & 1, h = item & 7, grp = h >> 2;
  const float a_neg = -__expf(p.ssd_a_log[layer * 16 + dir * 8 + h]);
  const bf16_t* XBC = (const bf16_t*)(ws + WS_XBC); const float* DT = (const float*)(ws + WS_DT);
  bf16_t* Y = (bf16_t*)(ws + (dir ? WS_YB : WS_YF));
  float* sAcs = (float*)(lds + SS_ACS); float* sDt = (float*)(lds + SS_DT); float* sRaw = (float*)(lds + SS_RAW);
  f32x16 S;
#pragma unroll
  for (int r = 0; r < 16; ++r) S[r] = 0.f;
  const int s_pt = wid >> 2, s_nt = wid & 3;
  const int y_it = wid >> 1, y_pt = wid & 1;
  u32x4 rc[4], rbm[4], rx[2]; float rdt = 0.f;
#define SSD_BASE(K) ((K) < 2 ? T_LAT + b * CTXL + 128 * (dir ? (1 - (K)) : (K)) : b * SEQ + 128 * (dir ? (63 - ((K) - 2)) : ((K) - 2)))
#define SSD_LOAD(K) do { const int base_ = SSD_BASE(K); \
    _Pragma("unroll") for (int e = 0; e < 4; ++e) { int id = tid + e * NTHR; int it = id >> 4, c = id & 15; int prow = base_ + (dir ? 127 - it : it); \
      rbm[e] = *reinterpret_cast<const u32x4*>(XBC + (unsigned)(prow * 1024 + 512 + grp * 128 + c * 8)); \
      rc[e]  = *reinterpret_cast<const u32x4*>(XBC + (unsigned)(prow * 1024 + 768 + grp * 128 + c * 8)); } \
    _Pragma("unroll") for (int e = 0; e < 2; ++e) { int id = tid + e * NTHR; int it = id >> 3, c = id & 7; int prow = base_ + (dir ? 127 - it : it); \
      rx[e] = *reinterpret_cast<const u32x4*>(XBC + (unsigned)(prow * 1024 + h * 64 + c * 8)); } \
    if (tid < 128) { int prow = base_ + (dir ? 127 - tid : tid); rdt = DT[(unsigned)(prow * 16 + dir * 8 + h)]; } } while (0)
  for (int k = 0; k < 66; ++k) {
    const int base = SSD_BASE(k);
    __syncthreads();
    SSD_LOAD(k);
    if (tid < 128) { sDt[tid] = rdt; sRaw[tid] = rdt * a_neg; }
    __syncthreads();
    if (tid < 128) {
      float v = sRaw[tid];
#pragma unroll
      for (int o = 1; o < 64; o <<= 1) { float u = __shfl_up(v, o); if (lane >= o) v += u; }
      if (wid == 1) v += wave_sum(sRaw[lane]);
      sAcs[tid] = v;
    }
    __syncthreads();
    const float acs_last = sAcs[127];
#pragma unroll
    for (int e = 0; e < 4; ++e) { int id = tid + e * NTHR; int it = id >> 4, c = id & 15;
      *reinterpret_cast<u32x4*>(lds + SS_CM + it * 272 + c * 16) = rc[e];
      *reinterpret_cast<u32x4*>(lds + SS_BM + it * 272 + c * 16) = rbm[e];
      float f[8]; unpack8(rbm[e], f); const float w = __expf(acs_last - sAcs[it]);
#pragma unroll
      for (int q = 0; q < 8; ++q) f[q] *= w;
      *reinterpret_cast<u32x4*>(lds + SS_BW + (it >> 6) * 16384 + v_st(it & 63, c * 8)) = pack8(f); }
#pragma unroll
    for (int e = 0; e < 2; ++e) { int id = tid + e * NTHR; int it = id >> 3, c = id & 7;
      float f[8]; unpack8(rx[e], f); const float d = sDt[it];
#pragma unroll
      for (int q = 0; q < 8; ++q) f[q] *= d;
      *reinterpret_cast<u32x4*>(lds + SS_XV + (it >> 6) * 8192 + v_st2(it & 63, c * 8)) = pack8(f); }
    { bf16_t* sb = (bf16_t*)(lds + SS_SB);
#pragma unroll
      for (int r = 0; r < 16; ++r) sb[(s_pt * 32 + crow(r, hi)) * 136 + s_nt * 32 + l31] = f2bf(S[r]); }
    __syncthreads();
    f32x16 cbt[2], y;
#pragma unroll
    for (int r = 0; r < 16; ++r) { cbt[0][r] = 0.f; cbt[1][r] = 0.f; y[r] = 0.f; }
#pragma unroll
    for (int s = 0; s < 8; ++s) {
      const int co = (s * 16 + hi * 8) * 2;
      bf16x8 cmy = *reinterpret_cast<const bf16x8*>(lds + SS_CM + (y_it * 32 + l31) * 272 + co);
      bf16x8 sbv = *reinterpret_cast<const bf16x8*>(lds + SS_SB + (y_pt * 32 + l31) * 272 + co);
      y = mfma32(cmy, sbv, y);
#pragma unroll
      for (int u = 0; u < 2; ++u) { const int t_ = wid + u * 8; const int jt = t_ >> 2, it_ = t_ & 3;
        bf16x8 av = *reinterpret_cast<const bf16x8*>(lds + SS_BM + (jt * 32 + l31) * 272 + co);
        bf16x8 bv = *reinterpret_cast<const bf16x8*>(lds + SS_CM + (it_ * 32 + l31) * 272 + co);
        cbt[u] = mfma32(av, bv, cbt[u]); }
      __builtin_amdgcn_sched_barrier(0);
    }
#pragma unroll
    for (int r = 0; r < 16; ++r) y[r] *= __expf(sAcs[y_it * 32 + crow(r, hi)]);
    __syncthreads();
#pragma unroll
    for (int u = 0; u < 2; ++u) { const int t_ = wid + u * 8; const int jt = t_ >> 2, it_ = t_ & 3;
      const int i = it_ * 32 + l31; const float ai = sAcs[i];
#pragma unroll
      for (int q = 0; q < 4; ++q) {
        const int j0 = jt * 32 + 8 * q + 4 * hi; float g[4];
#pragma unroll
        for (int e = 0; e < 4; ++e) { const int j = j0 + e; g[e] = (j <= i) ? cbt[u][4 * q + e] * __expf(ai - sAcs[j]) : 0.f; }
        u32x2 w = {cvtpk(g[0], g[1]), cvtpk(g[2], g[3])};
        *reinterpret_cast<u32x2*>(lds + SS_BM + i * 272 + j0 * 2) = w;
      } }
    __syncthreads();
    const float dec = __expf(acs_last);
#pragma unroll
    for (int r = 0; r < 16; ++r) S[r] *= dec;
    { const int vrb = v_rd_base(lane);
      const int vbx_y = (int)(uintptr_t)(lds + SS_XV) + vrb + y_pt * 512, vbx_s = (int)(uintptr_t)(lds + SS_XV) + vrb + s_pt * 512, vbw_s = (int)(uintptr_t)(lds + SS_BW) + vrb + s_nt * 512;
#define PK_(L, H) (bf16x8){L[0], L[1], L[2], L[3], H[0], H[1], H[2], H[3]}
#define SSD_STEP(T, KS) do { \
      const bf16x8 gv = *reinterpret_cast<const bf16x8*>(lds + SS_BM + (y_it * 32 + l31) * 272 + (((T) * 4 + (KS)) * 16 + hi * 8) * 2); \
      const s16x4 xl = tr_read<(T) * 8192 + (KS) * 2048>(vbx_y), xh = tr_read<(T) * 8192 + (KS) * 2048 + 1024>(vbx_y); \
      const s16x4 al = tr_read<(T) * 8192 + (KS) * 2048>(vbx_s), ah = tr_read<(T) * 8192 + (KS) * 2048 + 1024>(vbx_s); \
      const s16x4 wl = tr_read<(T) * 16384 + (KS) * 4096>(vbw_s), wh = tr_read<(T) * 16384 + (KS) * 4096 + 2048>(vbw_s); \
      asm volatile("s_waitcnt lgkmcnt(0)" ::: "memory"); __builtin_amdgcn_sched_barrier(0); \
      y = mfma32(gv, PK_(xl, xh), y); S = mfma32(PK_(al, ah), PK_(wl, wh), S); } while (0)
      SSD_STEP(0, 0); SSD_STEP(0, 1); SSD_STEP(0, 2); SSD_STEP(0, 3); SSD_STEP(1, 0); SSD_STEP(1, 1); SSD_STEP(1, 2); SSD_STEP(1, 3);
#undef SSD_STEP
#undef PK_
    }
#pragma unroll
    for (int r = 0; r < 16; ++r) { const int i = y_it * 32 + crow(r, hi); const int prow = base + (dir ? 127 - i : i);
      Y[(unsigned)(prow * 512 + h * 64 + y_pt * 32 + l31)] = f2bf(y[r]); }
  }
#undef SSD_LOAD
#undef SSD_BASE
}

__device__ __forceinline__ void sgu_item(const Params& p, int layer, int chunk, char* lds) {
  char* ws = p.ws;
  const int tid = otid(), wid = tid >> 6, lane = tid & 63, l31 = lane & 31, hi = lane >> 5;
  const bf16_t* P = (const bf16_t*)(ws + WS_P); bf16_t* SG = (bf16_t*)(ws + WS_SGUO);
  const int r0 = chunk * 128;
  float* sR = (float*)(lds + 69632);
  __syncthreads();
  { const int row = tid >> 2, q = tid & 3; const bf16_t* pr = P + (size_t)(r0 + row) * PLD + OFF_SGU + 512 + q * 128; float ss = 0.f;
    for (int c = 0; c < 16; ++c) { float f[8]; unpack8(*reinterpret_cast<const u32x4*>(pr + c * 8), f);
#pragma unroll
      for (int e = 0; e < 8; ++e) { float g = gelu_f(f[e]); ss += g * g; } }
    ss += __shfl_xor(ss, 1); ss += __shfl_xor(ss, 2);
    if (q == 0) sR[row] = rsqrtf(ss * (1.f / 512.f) + EPS); }
  __syncthreads();
  const int it = wid >> 1, dt0 = (wid & 1) * 2;
  for (int g = 0; g < 4; ++g) {
    const float* wsrc = p.sgu_w + ((size_t)layer * 4 + g) * 128 * 128;
#pragma unroll
    for (int e = 0; e < 8; ++e) { int id = tid + e * NTHR; int i = id >> 5, j4 = (id & 31) * 4; float4 v = *reinterpret_cast<const float4*>(wsrc + i * 128 + j4);
      u32x2 w = {cvtpk(v.x, v.y), cvtpk(v.z, v.w)}; *reinterpret_cast<u32x2*>(lds + i * 272 + j4 * 2) = w; }
#pragma unroll
    for (int e = 0; e < 4; ++e) { int id = tid + e * NTHR; int j = id >> 4, c = id & 15; float f[8];
      unpack8(*reinterpret_cast<const u32x4*>(P + (size_t)(r0 + j) * PLD + OFF_SGU + 512 + g * 128 + c * 8), f);
      const float rs = sR[j]; bf16_t* bt = (bf16_t*)(lds + 34816);
#pragma unroll
      for (int q = 0; q < 8; ++q) { const int d = c * 8 + q; bt[d * 136 + j] = f2bf(gelu_f(f[q]) * rs * p.sgu_norm[layer * 512 + g * 128 + d]); } }
    __syncthreads();
    f32x16 acc[2];
#pragma unroll
    for (int r = 0; r < 16; ++r) { acc[0][r] = 0.f; acc[1][r] = 0.f; }
#pragma unroll
    for (int s = 0; s < 8; ++s) { const int co = (s * 16 + hi * 8) * 2;
      bf16x8 av = *reinterpret_cast<const bf16x8*>(lds + (it * 32 + l31) * 272 + co);
#pragma unroll
      for (int u = 0; u < 2; ++u) { bf16x8 bv = *reinterpret_cast<const bf16x8*>(lds + 34816 + ((dt0 + u) * 32 + l31) * 272 + co); acc[u] = mfma32(av, bv, acc[u]); } }
#pragma unroll
    for (int u = 0; u < 2; ++u)
#pragma unroll
      for (int r = 0; r < 16; ++r) { const int i = it * 32 + crow(r, hi); const int d = (dt0 + u) * 32 + l31;
        const float uu = gelu_f(bf2f(P[(size_t)(r0 + i) * PLD + OFF_SGU + g * 128 + d]));
        SG[(size_t)(r0 + i) * 512 + g * 128 + d] = f2bf(uu * (acc[u][r] + p.sgu_b[((size_t)layer * 4 + g) * 128 + i])); }
    __syncthreads();
  }
}

__device__ __forceinline__ void phase_mixers(const Params& p, int layer, char* lds, int rep) {
  char* ws = p.ws;
  volatile int* s_item_p = (volatile int*)(lds + LDS_BYTES + 8);
#define s_item (*s_item_p)
  int* ctr = (int*)(ws + WS_CTR) + layer + 2 * rep;
  const int n_ssd = 32, n_attl = 1024, n_attc = layer == 0 ? 16 : 0, n_sgu = layer == 0 ? 132 : 128;
  const int total = n_ssd + n_attl + n_attc + n_sgu;
  float* ML = (float*)(ws + WS_ML);
  for (;;) {
    __syncthreads();
    if (threadIdx.x == 0) s_item = atomicAdd(ctr, 1);
    __syncthreads();
    int it = s_item;
    if (it >= total) break;
    if (it < n_ssd) { ssd_item(p, layer, it, lds); continue; } it -= n_ssd;
    if (it < n_attl) {
      const int bh = it >> 6, qb = (it >> 1) & 31, sp = it & 1, b = bh >> 3, h = bh & 7;
      const size_t t0 = (size_t)b * SEQ + qb * 256;
      attn_item((const bf16_t*)(ws + WS_Q) + ((size_t)bh * SEQ + qb * 256) * 192, (const bf16_t*)(ws + WS_K) + ((size_t)bh * NKEYS + sp * (NKEYS / 2)) * 192,
                (const bf16_t*)(ws + WS_V) + ((size_t)bh * NKEYS + sp * (NKEYS / 2)) * 128, NKEYS / 2,
                (bf16_t*)(ws + (sp ? WS_ATT1 : WS_ATT)) + t0 * 1024 + h * 128, ML + ((size_t)sp * T_ALL + t0) * 16 + h * 2, lds);
      continue; } it -= n_attl;
    if (it < n_attc) {
      const int bh = it, b = bh >> 3, h = bh & 7; const size_t t0 = (size_t)T_LAT + b * CTXL;
      attn_item((const bf16_t*)(ws + WS_QC) + (size_t)bh * CTXL * 192, (const bf16_t*)(ws + WS_K) + (size_t)bh * NKEYS * 192,
                (const bf16_t*)(ws + WS_V) + (size_t)bh * NKEYS * 128, CTXL, (bf16_t*)(ws + WS_ATT) + t0 * 1024 + h * 128, ML + t0 * 16 + h * 2, lds);
      if (threadIdx.x < 256) { float* mp = ML + ((size_t)T_ALL + t0 + threadIdx.x) * 16 + h * 2; mp[0] = 0.f; mp[1] = 0.f; }
      continue; } it -= n_attc;
    sgu_item(p, layer, it, lds);
  }
#undef s_item
}

__device__ __forceinline__ void phase_cat(const Params& p, int layer, int nrows) {
  char* ws = p.ws;
  const int tid = otid(), lane = tid & 63, wid = tid >> 6;
  const bf16_t* ATT = (const bf16_t*)(ws + WS_ATT); const bf16_t* SG = (const bf16_t*)(ws + WS_SGUO);
  const bf16_t* YF = (const bf16_t*)(ws + WS_YF); const bf16_t* YB = (const bf16_t*)(ws + WS_YB);
  const bf16_t* XBC = (const bf16_t*)(ws + WS_XBC); const bf16_t* P = (const bf16_t*)(ws + WS_P);
  bf16_t* CAT = (bf16_t*)(ws + WS_H);
  const float* an = p.attn_out_norm + layer * 1024; const float* gn = p.gmlp_out_norm + layer * 512; const float* sn = p.ssd_norm + layer * 512;
  for (int t = blockIdx.x * 8 + wid; t < nrows; t += gridDim.x * 8) {
    float a0[8], a1[8], sg[8], y[8];
    unpack8(*reinterpret_cast<const u32x4*>(ATT + (size_t)t * 1024 + lane * 8), a0);
    unpack8(*reinterpret_cast<const u32x4*>(ATT + (size_t)t * 1024 + 512 + lane * 8), a1);
    {
      const float* ML = (const float*)(ws + WS_ML); const bf16_t* ATT1 = (const bf16_t*)(ws + WS_ATT1);
#pragma unroll
      for (int hh = 0; hh < 2; ++hh) { const int h = hh * 4 + (lane >> 4);
        const float m0 = ML[((size_t)t) * 16 + h * 2], l0 = ML[((size_t)t) * 16 + h * 2 + 1];
        const float m1 = ML[((size_t)T_ALL + t) * 16 + h * 2], l1 = ML[((size_t)T_ALL + t) * 16 + h * 2 + 1];
        if (l1 > 0.f) { const float M = fmaxf(m0, m1); const float w0 = l0 * __builtin_amdgcn_exp2f(m0 - M), w1 = l1 * __builtin_amdgcn_exp2f(m1 - M);
          const float inv = 1.f / (w0 + w1); float b1[8];
          unpack8(*reinterpret_cast<const u32x4*>(ATT1 + (size_t)t * 1024 + hh * 512 + lane * 8), b1);
          float* av = hh ? a1 : a0;
#pragma unroll
          for (int e = 0; e < 8; ++e) av[e] = (av[e] * w0 + b1[e] * w1) * inv; } } }
    unpack8(*reinterpret_cast<const u32x4*>(SG + (size_t)t * 512 + lane * 8), sg);
    float xs[8], z[8];
    unpack8(*reinterpret_cast<const u32x4*>(XBC + (size_t)t * 1024 + lane * 8), xs);
    unpack8(*reinterpret_cast<const u32x4*>(P + (size_t)t * PLD + OFF_Z + lane * 8), z);
    const float dsk = p.ssd_d[layer * 8 + (lane >> 3)];
    float yf[8], yb[8];
    unpack8(*reinterpret_cast<const u32x4*>(YF + (size_t)t * 512 + lane * 8), yf);
    unpack8(*reinterpret_cast<const u32x4*>(YB + (size_t)t * 512 + lane * 8), yb);
    float sa = 0.f, ssg = 0.f, sy = 0.f;
#pragma unroll
    for (int e = 0; e < 8; ++e) {
      y[e] = (yf[e] + yb[e] + dsk * xs[e]) * silu_f(z[e]);
      sa += a0[e] * a0[e] + a1[e] * a1[e]; ssg += sg[e] * sg[e]; sy += y[e] * y[e];
    }
    sa = wave_sum(sa); ssg = wave_sum(ssg); sy = wave_sum(sy);
    const float ra = rsqrtf(sa * (1.f / 1024.f) + EPS), rg = rsqrtf(ssg * (1.f / 512.f) + EPS), ry = rsqrtf(sy * (1.f / 512.f) + EPS);
#pragma unroll
    for (int e = 0; e < 8; ++e) {
      a0[e] *= ra * an[lane * 8 + e]; a1[e] *= ra * an[512 + lane * 8 + e];
      sg[e] *= rg * gn[lane * 8 + e]; y[e] *= ry * sn[lane * 8 + e];
    }
    bf16_t* cr = CAT + (size_t)t * HLD;
    *reinterpret_cast<u32x4*>(cr + lane * 8) = pack8(a0);
    *reinterpret_cast<u32x4*>(cr + 512 + lane * 8) = pack8(a1);
    *reinterpret_cast<u32x4*>(cr + 1024 + lane * 8) = pack8(sg);
    *reinterpret_cast<u32x4*>(cr + 1536 + lane * 8) = pack8(y);
  }
}

__device__ __forceinline__ void phase_gemm_out(const Params& p, int layer, int nrows, char* lds) {
  char* ws = p.ws;
  float* X = (float*)(ws + WS_X);
  const float* mods = (const float*)(ws + WS_MODS) + (size_t)layer * 3 * 12288 + 2 * DM;
  const float* xin = p.x; const float* cin = p.ctx;
  SchedRes S{ws + WS_H, ws + WS_WOUT, HLD, WLD, DM / 64, nrows > T_LAT ? 16 : 0};
  float* PART = (float*)(ws + WS_PART);
  auto epi = [=](const pg::f32x4 (&acc)[2][2][4][2], const pg::Unit& u, int wr, int wc, int fr, int fq) {
    const float* g1 = mods + mod_idx(u.m0) * 12288;
    const float* xsrc = layer == 0 ? (u.m0 < T_LAT ? xin : cin - (size_t)T_LAT * DM) : X;
    const int row0 = u.m0 + wr * 64 + fr;
#pragma unroll
    for (int bj = 0; bj < 2; ++bj)
#pragma unroll
      for (int n = 0; n < 2; ++n) { const int c = u.n0 + bj * 128 + wc * 32 + n * 16 + 4 * fq;
        const pg::f32x4 g = *reinterpret_cast<const pg::f32x4*>(g1 + c);
        if (u.tag) {
#pragma unroll
          for (int ai = 0; ai < 2; ++ai)
#pragma unroll
            for (int m = 0; m < 4; ++m) { const size_t o = (size_t)(row0 + ai * 128 + m * 16) * DM + c;
              *reinterpret_cast<pg::f32x4*>(PART + o + (size_t)((u.tag - 1) * 512 - T_LAT) * DM) = acc[ai][bj][m][n]; }
        } else {
          pg::f32x4 xo[2][4];
#pragma unroll
          for (int ai = 0; ai < 2; ++ai)
#pragma unroll
            for (int m = 0; m < 4; ++m) xo[ai][m] = *reinterpret_cast<const pg::f32x4*>(xsrc + (size_t)(row0 + ai * 128 + m * 16) * DM + c);
#pragma unroll
          for (int ai = 0; ai < 2; ++ai)
#pragma unroll
            for (int m = 0; m < 4; ++m) *reinterpret_cast<pg::f32x4*>(X + (size_t)(row0 + ai * 128 + m * 16) * DM + c) = xo[ai][m] + g * acc[ai][bj][m][n];
        } }
  };
  pg::gemm_phase<false>((LAS unsigned char*)lds, HLD, WLD, S, epi);
}

struct SchedFFN1 {
  const char* H2; const char* W; int MT;
  __device__ __forceinline__ bool next(int i, pg::Unit& u) const {
    int mt, ntl; if (!tile_of(i, MT, 44, mt, ntl)) return false;
    u.m0 = mt * 254 - 1; u.n0 = ntl * 256; u.a = H2 + (long)u.m0 * (HLD * 2); u.b = W + (size_t)u.n0 * WLD * 2; u.nt = DM / 64; u.tag = 0; return true; }
};
__device__ __forceinline__ float dpp_ror1(float v) { return __int_as_float(__builtin_amdgcn_update_dpp(0, __float_as_int(v), 0x121, 0xf, 0xf, false)); }
__device__ __forceinline__ float dpp_ror15(float v) { return __int_as_float(__builtin_amdgcn_update_dpp(0, __float_as_int(v), 0x12f, 0xf, 0xf, false)); }
__device__ __forceinline__ void phase_gemm_ffn1(const Params& p, int layer, int nrows, char* lds) {
  char* ws = p.ws;
  bf16_t* ACT = (bf16_t*)(ws + WS_ACT);
  const float* cw = p.ffn_conv_w + (size_t)layer * 3 * FFN; const float* cb = p.ffn_conv_b + (size_t)layer * FFN;
  SchedFFN1 S{ws + WS_H, ws + WS_WGU, (nrows + 253) / 254};
  float* EX = (float*)(lds + 131072);
  auto epi = [=](const pg::f32x4 (&acc)[2][2][4][2], const pg::Unit& u, int wr, int wc, int fr, int fq) {
    const int ccb = 32 * wc + 8 * fq;
#pragma unroll
    for (int ai = 0; ai < 2; ++ai) { const int q = 2 * ai + wr;
      if (fr == 0) {
#pragma unroll
        for (int n = 0; n < 2; ++n) *reinterpret_cast<pg::f32x4*>(EX + (q * 2 + 0) * 128 + ccb + 4 * n) = acc[ai][0][0][n]; }
      if (fr == 15) {
#pragma unroll
        for (int n = 0; n < 2; ++n) *reinterpret_cast<pg::f32x4*>(EX + (q * 2 + 1) * 128 + ccb + 4 * n) = acc[ai][0][3][n]; } }
    asm volatile("s_waitcnt lgkmcnt(0)" ::: "memory");
    __builtin_amdgcn_s_barrier(); asm volatile("" ::: "memory");
    __builtin_amdgcn_s_barrier(); asm volatile("" ::: "memory");
    const int ch0 = (u.n0 >> 1) + ccb;
#pragma unroll
    for (int n = 0; n < 2; ++n) {
      const pg::f32x4 w0 = *reinterpret_cast<const pg::f32x4*>(cw + ch0 + 4 * n), w1 = *reinterpret_cast<const pg::f32x4*>(cw + FFN + ch0 + 4 * n);
      const pg::f32x4 w2 = *reinterpret_cast<const pg::f32x4*>(cw + 2 * FFN + ch0 + 4 * n), bb = *reinterpret_cast<const pg::f32x4*>(cb + ch0 + 4 * n);
#pragma unroll
      for (int ai = 0; ai < 2; ++ai) { const int q = 2 * ai + wr;
        float o[4][4]; bool zp[4], zn[4];
#pragma unroll
        for (int m = 0; m < 4; ++m) { const int t = u.m0 + 128 * ai + 64 * wr + 16 * m + fr; const bool tv = t >= 0 && t < nrows;
          zp[m] = !tv || seq_start(t); zn[m] = !tv || seq_end(t); }
#pragma unroll
        for (int j = 0; j < 4; ++j) {
          float R[4], L[4];
#pragma unroll
          for (int m = 0; m < 4; ++m) { R[m] = dpp_ror1(acc[ai][0][m][n][j]); L[m] = dpp_ror15(acc[ai][0][m][n][j]); }
          const float exp_ = q > 0 ? EX[((q - 1) * 2 + 1) * 128 + ccb + 4 * n + j] : 0.f;
          const float exn_ = q < 3 ? EX[((q + 1) * 2 + 0) * 128 + ccb + 4 * n + j] : 0.f;
#pragma unroll
          for (int m = 0; m < 4; ++m) {
            float pv = fr > 0 ? R[m] : (m > 0 ? R[m > 0 ? m - 1 : 0] : exp_);
            float nv = fr < 15 ? L[m] : (m < 3 ? L[m < 3 ? m + 1 : 3] : exn_);
            pv = zp[m] ? 0.f : pv; nv = zn[m] ? 0.f : nv;
            const float cv = bb[j] + w0[j] * pv + w1[j] * acc[ai][0][m][n][j] + w2[j] * nv;
            o[m][j] = cv * __builtin_amdgcn_rcpf(1.f + __builtin_amdgcn_exp2f(-1.4426950408889634f * cv)) * acc[ai][1][m][n][j];
          } }
#pragma unroll
        for (int m = 0; m < 4; ++m) { const int e = 128 * ai + 64 * wr + 16 * m + fr; const int t = u.m0 + e;
          if (e >= 1 && e <= 254 && t < nrows) { u32x2 w = {cvtpk(o[m][0], o[m][1]), cvtpk(o[m][2], o[m][3])}; *reinterpret_cast<u32x2*>(ACT + (size_t)t * FFN + ch0 + 4 * n) = w; } }
        __builtin_amdgcn_sched_barrier(0);
      }
    }
  };
  pg::gemm_phase<true>((LAS unsigned char*)lds, HLD, WLD, S, epi);
}

__device__ __forceinline__ void phase_gemm_down(const Params& p, int layer, int nrows, char* lds) {
  char* ws = p.ws;
  float* X = (float*)(ws + WS_X); float* out = p.out;
  const float* mods = (const float*)(ws + WS_MODS) + (size_t)layer * 3 * 12288 + 5 * DM;
  SchedRes S{ws + WS_ACT, ws + WS_WDN, FFN, FFN, FFN / 64, nrows > T_LAT ? 16 : 0};
  float* PART = (float*)(ws + WS_PART);
  auto epi = [=](const pg::f32x4 (&acc)[2][2][4][2], const pg::Unit& u, int wr, int wc, int fr, int fq) {
    const float* g2 = mods + mod_idx(u.m0) * 12288;
    float* dst = layer == 0 ? X : out;
    const int row0 = u.m0 + wr * 64 + fr;
#pragma unroll
    for (int bj = 0; bj < 2; ++bj)
#pragma unroll
      for (int n = 0; n < 2; ++n) { const int c = u.n0 + bj * 128 + wc * 32 + n * 16 + 4 * fq;
        const pg::f32x4 g = *reinterpret_cast<const pg::f32x4*>(g2 + c);
        if (u.tag) {
#pragma unroll
          for (int ai = 0; ai < 2; ++ai)
#pragma unroll
            for (int m = 0; m < 4; ++m) { const size_t o = (size_t)(row0 + ai * 128 + m * 16) * DM + c;
              *reinterpret_cast<pg::f32x4*>(PART + o + (size_t)((u.tag - 1) * 512 - T_LAT) * DM) = acc[ai][bj][m][n]; }
        } else {
          pg::f32x4 xo[2][4];
#pragma unroll
          for (int ai = 0; ai < 2; ++ai)
#pragma unroll
            for (int m = 0; m < 4; ++m) xo[ai][m] = *reinterpret_cast<const pg::f32x4*>(X + (size_t)(row0 + ai * 128 + m * 16) * DM + c);
#pragma unroll
          for (int ai = 0; ai < 2; ++ai)
#pragma unroll
            for (int m = 0; m < 4; ++m) *reinterpret_cast<pg::f32x4*>(dst + (size_t)(row0 + ai * 128 + m * 16) * DM + c) = xo[ai][m] + g * acc[ai][bj][m][n];
        } }
  };
  pg::gemm_phase<false>((LAS unsigned char*)lds, FFN, FFN, S, epi);
}

#ifndef DBG_NAN
#define DBG_NAN 0
#endif
#if DBG_NAN
__device__ __forceinline__ void nan_scan(const Params& p, size_t off, size_t n, int isbf, int code) {
  int* flags = (int*)(p.ws + WS_CTR) + 8;
  const char* base = p.ws + off; bool bad = false;
  for (size_t i = (size_t)blockIdx.x * NTHR + threadIdx.x; i < n; i += (size_t)gridDim.x * NTHR) {
    float v = isbf ? bf2f(((const bf16_t*)base)[i]) : ((const float*)base)[i];
    if (!(fabsf(v) < 1e30f)) bad = true;
  }
  if (bad) atomicMin(flags, code);
}
__device__ __forceinline__ void dbg_scan(const Params& p, int ph) {
  const int k = (ph + 1) * 10;
  if (ph == 0) { nan_scan(p, WS_MODS, 2 * 3 * 12288, 0, k); nan_scan(p, WS_ROPE, 4096, 0, k + 1); nan_scan(p, WS_WIN, (size_t)49152000, 1, k + 2); return; }
  const int layer = (ph - 1) / 10, s = (ph - 1) % 10; const size_t nr = layer == 0 ? T_ALL : T_LAT;
  switch (s) {
    case 0: nan_scan(p, WS_H, (size_t)T_ALL * DM, 1, k); break;
    case 1: nan_scan(p, WS_P, (size_t)T_ALL * PLD, 1, k); nan_scan(p, WS_DT, (size_t)T_ALL * 16, 0, k + 1); break;
    case 2: nan_scan(p, WS_QRAW, (size_t)T_ALL * 1536, 1, k); nan_scan(p, WS_KVRAW, (size_t)T_ALL * 2048, 1, k + 1); nan_scan(p, WS_RSTD, (size_t)T_ALL * 2, 0, k + 2);
            nan_scan(p, WS_XBC, (size_t)T_ALL * 1024, 1, k + 3); nan_scan(p, WS_DT, (size_t)T_ALL * 16, 0, k + 4); break;
    case 3: nan_scan(p, WS_Q, (size_t)16 * SEQ * 192, 1, k); nan_scan(p, WS_K, (size_t)16 * NKEYS * 192, 1, k + 1); nan_scan(p, WS_V, (size_t)16 * NKEYS * 128, 1, k + 2); break;
    case 4: nan_scan(p, WS_ATT, (size_t)T_LAT * 1024, 1, k); nan_scan(p, WS_SGUO, (size_t)T_LAT * 512, 1, k + 1); nan_scan(p, WS_YF, (size_t)T_ALL * 512, 0, k + 2); nan_scan(p, WS_YB, (size_t)T_ALL * 512, 0, k + 3); break;
    case 5: nan_scan(p, WS_H, nr * DM, 1, k); break;
    case 6: nan_scan(p, WS_X, nr * DM, 0, k); break;
    case 7: nan_scan(p, WS_H, nr * DM, 1, k); break;
    case 8: nan_scan(p, WS_ACT, nr * FFN, 1, k); break;
    default: if (layer == 0) nan_scan(p, WS_X, nr * DM, 0, k); break;
  }
}
#endif
typedef const __attribute__((address_space(4))) Params* KArgP;
__device__ __forceinline__ Params load_params() {
#if defined(__HIP_DEVICE_COMPILE__)
  KArgP q = (KArgP)__builtin_amdgcn_kernarg_segment_ptr(); asm volatile("" : "+s"(q));
  Params r; __builtin_memcpy(&r, q, sizeof(Params)); return r;
#else
  return Params{};
#endif
}
__device__ __forceinline__ void run_phase(int ph, char* lds, int rep) {
  if (ph == 0) { const Params p = load_params(); phase_prep(p, lds); return; }
  const int layer = (ph - 1) / 10, s = (ph - 1) % 10;
  const int nrows2 = layer == 0 ? T_ALL : T_LAT;
  switch (s) {
    case 0: { const Params p = load_params(); phase_norm_mod(p, layer, 0, T_ALL); if (layer == 1) convert_weights(p, 1, lds); } break;
    case 1: { const Params p = load_params(); phase_gemm_in(p, lds); } break;
    case 2: { const Params p = load_params(); phase_qkv_gemm_and_post(p, layer, lds); } break;
    case 3: { const Params p = load_params(); phase_build_qkv(p, layer); } break;
    case 4: { const Params p = load_params(); phase_mixers(p, layer, lds, rep); } break;
    case 5: { const Params p = load_params(); phase_cat(p, layer, nrows2); } break;
    case 6: { const Params p = load_params(); phase_gemm_out(p, layer, nrows2, lds); } break;
    case 7: { const Params p = load_params(); phase_norm_mod(p, layer, 1, nrows2); } break;
    case 8: { const Params p = load_params(); phase_gemm_ffn1(p, layer, nrows2, lds); } break;
    default: { const Params p = load_params(); phase_gemm_down(p, layer, nrows2, lds); } break;
  }
}

__global__ void __launch_bounds__(NTHR) mega_fwd(Params p) {
  extern __shared__ __attribute__((aligned(16))) char lds[];
#if MULTI_LAUNCH
  run_phase((int)p.ph_lo, lds, 0);
#else
  cg::grid_group grid = cg::this_grid();
  unsigned* bar_st = (unsigned*)(lds + LDS_BYTES);
  if (threadIdx.x < 4) bar_st[threadIdx.x] = 0u;
  __syncthreads();
  XcdBarrier xb = xcd_barrier_post((unsigned*)(p.ws + WS_BAR), (volatile LAS unsigned*)bar_st);
  for (int ph = 0; ph < 21; ++ph) {
#if REPEAT_MASK
    if (ph > 0 && ((REPEAT_MASK >> ((ph - 1) % 10)) & 1)) { run_phase(ph, lds, 1); xcd_barrier(xb); }
#endif
    run_phase(ph, lds, 0);
    if (ph == 0) grid.sync();
    else if (ph + 1 < 21) xcd_barrier(xb);
  }
#endif
}


#if DBG_NAN
__global__ void __launch_bounds__(NTHR) dbg_init_k(Params p) { ((int*)(p.ws + WS_CTR))[8] = 100000; }
__global__ void __launch_bounds__(NTHR) dbg_scan_k(Params p) { dbg_scan(p, (int)p.ph_lo); }
__global__ void __launch_bounds__(NTHR) dbg_report_k(Params p) {
  int code = ((int*)(p.ws + WS_CTR))[8];
  if (code < 100000) { float e = (float)(code / 10) * 0.5f; float c = sqrtf(1.27f) * __powf(10.f, e) * (1.f + 0.1f * (float)(code % 10));
    for (size_t i = (size_t)blockIdx.x * NTHR + threadIdx.x; i < (size_t)T_LAT * DM; i += (size_t)gridDim.x * NTHR) p.out[i] = c; }
}
#endif
extern "C" void kernel_launch(void* const* d_in, const int* in_sizes, int n_in, void* d_out, int out_size, void* d_ws, size_t ws_size, hipStream_t stream) {
  static int grid_blocks = 0;
  if (grid_blocks == 0) {
    if (n_in != 32 || out_size != T_LAT * DM || ws_size < WS_END) {
      fprintf(stderr, "kernel_launch: bad shapes: n_in %d out %d ws %zu (need %zu)\n", n_in, out_size, ws_size, (size_t)WS_END); grid_blocks = -1; return; }
    int dev = 0, cus = 0, per_cu = 0;
    hipGetDevice(&dev); hipDeviceGetAttribute(&cus, hipDeviceAttributeMultiprocessorCount, dev);
    hipFuncSetAttribute((const void*)mega_fwd, hipFuncAttributeMaxDynamicSharedMemorySize, LDS_DYN);
    hipOccupancyMaxActiveBlocksPerMultiprocessor(&per_cu, (const void*)mega_fwd, NTHR, LDS_DYN);
    if (per_cu < 1) { fprintf(stderr, "kernel_launch: occupancy query says %d blocks/CU\n", per_cu); per_cu = 1; }
    grid_blocks = cus * per_cu;
  }
  if (grid_blocks < 0) return;
  Params p{};
  const float** pp = (const float**)&p;
  for (int i = 0; i < 32; ++i) pp[i] = (const float*)d_in[i];
  p.out = (float*)d_out; p.ws = (char*)d_ws; p.ph_lo = 0; p.ph_hi = 21;
#if MULTI_LAUNCH
  for (int ph = 0; ph < 21; ++ph) { p.ph_lo = ph; p.ph_hi = ph + 1; hipLaunchKernelGGL(mega_fwd, dim3(grid_blocks), dim3(NTHR), LDS_DYN, stream, p);
#if DBG_NAN
    if (ph == 0) hipLaunchKernelGGL(dbg_init_k, dim3(1), dim3(1), 0, stream, p);
    hipLaunchKernelGGL(dbg_scan_k, dim3(grid_blocks), dim3(NTHR), 0, stream, p);
#endif
  }
#if DBG_NAN
  hipLaunchKernelGGL(dbg_report_k, dim3(grid_blocks), dim3(NTHR), 0, stream, p);
#endif
#else
  hipMemsetAsync((char*)d_ws + WS_BAR, 0, XCD_BAR_WORDS * 4, stream);
  void* args[] = {&p};
  hipError_t e = hipLaunchCooperativeKernel((const void*)mega_fwd, dim3(grid_blocks), dim3(NTHR), args, LDS_DYN, stream);
  if (e != hipSuccess) fprintf(stderr, "cooperative launch failed: %s (grid %d)\n", hipGetErrorString(e), grid_blocks);
#endif
}
```
